# Optimizing an MI355X kernel written in HIP

```python
import jax, jax.numpy as jnp
from jax import lax
import numpy as np

D_MODEL = 1024
BATCH = 8
SEQ = 4096
DEPTH = 2

GRID_W = 64
CTX_LEN = 256
EPS = 1e-6
N_Q_HEADS = 8
N_KV_HEADS = 2
HEAD_DIM = 64
Q_PER_KV = N_Q_HEADS // N_KV_HEADS
ATTN_WIDTH = N_Q_HEADS * HEAD_DIM
KV_WIDTH = N_KV_HEADS * HEAD_DIM
Q_BLOCK = 128
ROPE_THETA = 10000.0
POOL_WINDOWS = (2, 4, 8, 16)
POOL_GROUP = 128
POOL_WIDTH = POOL_GROUP * len(POOL_WINDOWS)
SG_GROUPS = 4
SG_GROUP_WIDTH = 128
SG_CHUNK = 128
SG_WIDTH = SG_GROUPS * SG_GROUP_WIDTH
CONV_WIDTH = 512
CONV_K = 3
EVEN_IN = ATTN_WIDTH + 2 * KV_WIDTH + POOL_WIDTH
ODD_IN = 2 * SG_WIDTH + 3 * CONV_WIDTH
MIX_WIDTH = ATTN_WIDTH + POOL_WIDTH
N_GROUPS = 4
EXPERTS_PER_GROUP = 4
N_EXPERTS = N_GROUPS * EXPERTS_PER_GROUP
TOP_K = 2
D_EXPERT = 256

kernel_name = 'hybrid_diffusion_attn_pool_sgmlp_conv_hmoe'


def rms_norm(x, gain):
    x32 = x.astype(jnp.float32)
    y = x32 * lax.rsqrt(jnp.mean(x32 * x32, axis=-1, keepdims=True) + EPS)
    return (y * gain.astype(jnp.float32)).astype(x.dtype)


def modulate(x, gain, shift, scale):
    return rms_norm(x, gain) * (1 + scale) + shift


def adaln(cond, mod_w, mod_b):
    m = jax.nn.silu(cond) @ mod_w + mod_b
    return jnp.split(m, 6, axis=-1)


def axial_angles(n_rows):
    row = jnp.repeat(jnp.arange(n_rows, dtype=jnp.float32), GRID_W)
    col = jnp.tile(jnp.arange(GRID_W, dtype=jnp.float32), n_rows)
    half = HEAD_DIM // 2
    inv = ROPE_THETA ** (-jnp.arange(0, half, 2, dtype=jnp.float32) / half)
    return row[:, None] * inv, col[:, None] * inv


def rope_1d(x, ang):
    cos = jnp.cos(ang)[None, :, None, :]
    sin = jnp.sin(ang)[None, :, None, :]
    x1, x2 = jnp.split(x, 2, axis=-1)
    return jnp.concatenate([x1 * cos - x2 * sin, x2 * cos + x1 * sin], axis=-1)


def rope_2d(x, row_ang, col_ang):
    x32 = x.astype(jnp.float32)
    xr, xc = jnp.split(x32, 2, axis=-1)
    return jnp.concatenate([rope_1d(xr, row_ang), rope_1d(xc, col_ang)], axis=-1).astype(x.dtype)


def gqa_attend(q, k, v):
    s = jnp.einsum('bqkgd,bskd->bkgqs', q, k, preferred_element_type=jnp.float32) * (HEAD_DIM ** -0.5)
    p = jax.nn.softmax(s, axis=-1).astype(v.dtype)
    return jnp.einsum('bkgqs,bskd->bqkgd', p, v)


def multiscale_pool(p, pool_w, pool_scale):
    bsz, length, _ = p.shape
    p32 = p.astype(jnp.float32)
    cs = jnp.concatenate([jnp.zeros_like(p32[:, :1]), jnp.cumsum(p32, axis=1)], axis=1)
    t = jnp.arange(length)
    diffs = []
    for g, w in enumerate(POOL_WINDOWS):
        lo = jnp.clip(t - w // 2, 0, length)
        hi = jnp.clip(t + w - w // 2, 0, length)
        sl = slice(g * POOL_GROUP, (g + 1) * POOL_GROUP)
        csg = cs[..., sl]
        mean = (csg[:, hi] - csg[:, lo]) / (hi - lo).astype(jnp.float32)[None, :, None]
        diffs.append(mean - p32[..., sl])
    d = jnp.stack(diffs, axis=2).astype(p.dtype)
    y = jnp.einsum('blgc,gcd->blgd', d, pool_w).reshape(bsz, length, POOL_WIDTH)
    return y * pool_scale


def even_mixer(h, hc, w_in, q_gain, k_gain, pool_w, pool_scale, w_out, row_ang, col_ang, need_ctx_out):
    bsz, seq, _ = h.shape
    n_ctx = hc.shape[1]
    q, k, v, p = jnp.split(h @ w_in, [ATTN_WIDTH, ATTN_WIDTH + KV_WIDTH, ATTN_WIDTH + 2 * KV_WIDTH], axis=-1)
    q = rope_2d(rms_norm(q.reshape(bsz, seq, N_Q_HEADS, HEAD_DIM), q_gain), row_ang, col_ang)
    k = rope_2d(rms_norm(k.reshape(bsz, seq, N_KV_HEADS, HEAD_DIM), k_gain), row_ang, col_ang)
    v = v.reshape(bsz, seq, N_KV_HEADS, HEAD_DIM)
    if need_ctx_out:
        qc, kc, vc, pc = jnp.split(hc @ w_in, [ATTN_WIDTH, ATTN_WIDTH + KV_WIDTH, ATTN_WIDTH + 2 * KV_WIDTH], axis=-1)
    else:
        kc, vc = jnp.split(hc @ w_in[:, ATTN_WIDTH:ATTN_WIDTH + 2 * KV_WIDTH], [KV_WIDTH], axis=-1)
    kc = rms_norm(kc.reshape(bsz, n_ctx, N_KV_HEADS, HEAD_DIM), k_gain)
    vc = vc.reshape(bsz, n_ctx, N_KV_HEADS, HEAD_DIM)
    k_all = jnp.concatenate([kc, k], axis=1)
    v_all = jnp.concatenate([vc, v], axis=1)
    n_blk = seq // Q_BLOCK
    qb = q.reshape(bsz, n_blk, Q_BLOCK, N_KV_HEADS, Q_PER_KV, HEAD_DIM).transpose(1, 0, 2, 3, 4, 5)
    o = lax.map(lambda qq: gqa_attend(qq, k_all, v_all), qb)
    o = o.transpose(1, 0, 2, 3, 4, 5).reshape(bsz, seq, ATTN_WIDTH)
    y = jnp.concatenate([o, multiscale_pool(p, pool_w, pool_scale)], axis=-1) @ w_out
    if need_ctx_out:
        qc = rms_norm(qc.reshape(bsz, n_ctx, N_Q_HEADS, HEAD_DIM), q_gain).reshape(bsz, n_ctx, N_KV_HEADS, Q_PER_KV, HEAD_DIM)
        oc = gqa_attend(qc, kc, vc).reshape(bsz, n_ctx, ATTN_WIDTH)
        yc = jnp.concatenate([oc, multiscale_pool(pc, pool_w, pool_scale)], axis=-1) @ w_out
    else:
        yc = None
    return y, yc


def odd_mixer(h, w_in, sg_gain, sg_w, sg_b, conv_w, w_out):
    bsz, length, _ = h.shape
    u, v, hx, bg, cg = jnp.split(h @ w_in, [SG_WIDTH, 2 * SG_WIDTH, 2 * SG_WIDTH + CONV_WIDTH, 2 * SG_WIDTH + 2 * CONV_WIDTH], axis=-1)
    v = rms_norm(v.reshape(bsz, length // SG_CHUNK, SG_CHUNK, SG_GROUPS, SG_GROUP_WIDTH), sg_gain)
    s = jnp.einsum('gpq,bnqgc->bnpgc', sg_w, v) + sg_b.T[:, :, None]
    y_c = u * s.reshape(bsz, length, SG_WIDTH)
    z = cg * hx
    zc = lax.conv_general_dilated(z, conv_w, window_strides=(1,), padding=((CONV_K // 2, CONV_K // 2),),
                                  dimension_numbers=('NWC', 'WIO', 'NWC'), feature_group_count=CONV_WIDTH)
    y_d = bg * zc
    return jnp.concatenate([y_c, y_d], axis=-1) @ w_out


def hier_moe(h, rg_w, rg_b, re_w, re_b, w_gate, w_up, w_down):
    shape = h.shape
    t = h.reshape(-1, shape[-1])
    t32 = t.astype(jnp.float32)
    n_tok = t.shape[0]
    g_prob = jax.nn.softmax(t32 @ rg_w.astype(jnp.float32) + rg_b.astype(jnp.float32), axis=-1)
    g_p, g_idx = lax.top_k(g_prob, 1)
    e_logits = (t32 @ re_w.astype(jnp.float32) + re_b.astype(jnp.float32)).reshape(n_tok, N_GROUPS, EXPERTS_PER_GROUP)
    e_sel = jnp.take_along_axis(e_logits, g_idx[:, :, None], axis=1)[:, 0]
    top_p, top_i = lax.top_k(jax.nn.softmax(e_sel, axis=-1), TOP_K)
    top_p = top_p / jnp.sum(top_p, axis=-1, keepdims=True)
    weights = g_p * top_p
    expert_id = g_idx * EXPERTS_PER_GROUP + top_i
    comb = jnp.sum(jax.nn.one_hot(expert_id, N_EXPERTS, dtype=jnp.float32) * weights[..., None], axis=1)

    def step(acc, xs):
        wg, wu, wd, cw = xs
        y = (jax.nn.silu(t @ wg) * (t @ wu)) @ wd
        return acc + y.astype(jnp.float32) * cw[:, None], None

    acc, _ = lax.scan(step, jnp.zeros(t.shape, jnp.float32), (w_gate, w_up, w_down, comb.T))
    return acc.astype(h.dtype).reshape(shape)


def setup_inputs(seed: int = 0) -> dict:
    key = jax.random.key(seed)
    ks = jax.random.split(key, 32)
    n_even = (DEPTH + 1) // 2
    n_odd = DEPTH // 2
    f32 = jnp.float32

    def nrm(k, shape, scale):
        return jax.random.normal(k, shape, f32) * scale

    def gain(k, shape, noise=0.05):
        return 1.0 + nrm(k, shape, noise)

    return {
        'x': nrm(ks[0], (BATCH, SEQ, D_MODEL), 1.0),
        'c': nrm(ks[1], (BATCH, D_MODEL), 1.0),
        'ctx': nrm(ks[2], (BATCH, CTX_LEN, D_MODEL), 1.0),
        'c_ctx': nrm(ks[3], (D_MODEL,), 1.0),
        'mod_w': nrm(ks[4], (DEPTH, D_MODEL, 6 * D_MODEL), 0.5 * D_MODEL ** -0.5),
        'mod_b': nrm(ks[5], (DEPTH, 6 * D_MODEL), 0.02),
        'norm1_g': gain(ks[6], (DEPTH, D_MODEL)),
        'norm2_g': gain(ks[7], (DEPTH, D_MODEL)),
        'even_w_in': nrm(ks[8], (n_even, D_MODEL, EVEN_IN), D_MODEL ** -0.5),
        'q_gain': gain(ks[9], (n_even, HEAD_DIM)),
        'k_gain': gain(ks[10], (n_even, HEAD_DIM)),
        'pool_w': nrm(ks[11], (n_even, len(POOL_WINDOWS), POOL_GROUP, POOL_GROUP), POOL_GROUP ** -0.5),
        'pool_scale': gain(ks[12], (n_even, POOL_WIDTH), 0.1),
        'even_w_out': nrm(ks[13], (n_even, MIX_WIDTH, D_MODEL), MIX_WIDTH ** -0.5),
        'odd_w_in': nrm(ks[14], (n_odd, D_MODEL, ODD_IN), D_MODEL ** -0.5),
        'sg_gain': gain(ks[15], (n_odd, SG_GROUPS, SG_GROUP_WIDTH)),
        'sg_w': nrm(ks[16], (n_odd, SG_GROUPS, SG_CHUNK, SG_CHUNK), SG_CHUNK ** -0.5),
        'sg_b': gain(ks[17], (n_odd, SG_GROUPS, SG_CHUNK), 0.1),
        'conv_w': nrm(ks[18], (n_odd, CONV_K, 1, CONV_WIDTH), CONV_K ** -0.5),
        'odd_w_out': nrm(ks[19], (n_odd, MIX_WIDTH, D_MODEL), MIX_WIDTH ** -0.5),
        'router_g_w': nrm(ks[20], (DEPTH, D_MODEL, N_GROUPS), D_MODEL ** -0.5),
        'router_g_b': nrm(ks[21], (DEPTH, N_GROUPS), 0.01),
        'router_e_w': nrm(ks[22], (DEPTH, D_MODEL, N_EXPERTS), D_MODEL ** -0.5),
        'router_e_b': nrm(ks[23], (DEPTH, N_EXPERTS), 0.01),
        'w_gate': nrm(ks[24], (DEPTH, N_EXPERTS, D_MODEL, D_EXPERT), D_MODEL ** -0.5),
        'w_up': nrm(ks[25], (DEPTH, N_EXPERTS, D_MODEL, D_EXPERT), D_MODEL ** -0.5),
        'w_down': nrm(ks[26], (DEPTH, N_EXPERTS, D_EXPERT, D_MODEL), D_EXPERT ** -0.5),
    }


def reference(x, c, ctx, c_ctx, mod_w, mod_b, norm1_g, norm2_g, even_w_in, q_gain, k_gain, pool_w, pool_scale,
              even_w_out, odd_w_in, sg_gain, sg_w, sg_b, conv_w, odd_w_out, router_g_w, router_g_b,
              router_e_w, router_e_b, w_gate, w_up, w_down):
    seq = x.shape[1]
    ROWS = seq // GRID_W
    row_ang, col_ang = axial_angles(ROWS)
    last_even = 2 * ((DEPTH - 1) // 2)
    h_lat, h_ctx = x, ctx
    for i in range(DEPTH):
        j = i // 2
        need_ctx_in = i <= last_even
        need_ctx_out = i < last_even
        sh1, sc1, g1, sh2, sc2, g2 = [m[:, None, :] for m in adaln(c, mod_w[i], mod_b[i])]
        a = modulate(h_lat, norm1_g[i], sh1, sc1)
        if need_ctx_in:
            csh1, csc1, cg1, csh2, csc2, cg2 = adaln(c_ctx, mod_w[i], mod_b[i])
            ac = modulate(h_ctx, norm1_g[i], csh1, csc1)
        if i % 2 == 0:
            y, yc = even_mixer(a, ac, even_w_in[j], q_gain[j], k_gain[j], pool_w[j], pool_scale[j],
                               even_w_out[j], row_ang, col_ang, need_ctx_out)
        else:
            y = odd_mixer(a, odd_w_in[j], sg_gain[j], sg_w[j], sg_b[j], conv_w[j], odd_w_out[j])
            yc = odd_mixer(ac, odd_w_in[j], sg_gain[j], sg_w[j], sg_b[j], conv_w[j], odd_w_out[j]) if need_ctx_out else None
        moe_args = (router_g_w[i], router_g_b[i], router_e_w[i], router_e_b[i], w_gate[i], w_up[i], w_down[i])
        h_lat = h_lat + g1 * y
        h_lat = h_lat + g2 * hier_moe(modulate(h_lat, norm2_g[i], sh2, sc2), *moe_args)
        if need_ctx_out:
            h_ctx = h_ctx + cg1 * yc
            h_ctx = h_ctx + cg2 * hier_moe(modulate(h_ctx, norm2_g[i], csh2, csc2), *moe_args)
    return h_lat
```

```cpp
#include <hip/hip_runtime.h>
#include <cstdio>
#include <cstdint>

#ifndef MK_PH
#define MK_PH 0xffffffffu
#endif
#define PH(n) if constexpr (((MK_PH) >> (n)) & 1u)
#ifndef MK_STAGE
#define MK_STAGE 4
#endif

#define LAS __attribute__((address_space(3)))
#define GAS __attribute__((address_space(1)))
typedef unsigned short bf16_t;
typedef short bf16x8 __attribute__((ext_vector_type(8)));
typedef short s16x4 __attribute__((ext_vector_type(4)));
typedef float f32x2 __attribute__((ext_vector_type(2)));
typedef float f32x4 __attribute__((ext_vector_type(4)));
typedef float f32x16 __attribute__((ext_vector_type(16)));
typedef unsigned u32x2 __attribute__((ext_vector_type(2)));
typedef unsigned u32x4 __attribute__((ext_vector_type(4)));

constexpr int NB = 8, SEQ = 4096, DM = 1024, MT = NB * SEQ, CTX = 256, MC = NB * CTX, MA = MT + MC, NKV = SEQ + CTX;
constexpr int NEXP = 16, DEXP = 256, LISTCAP = MT;
constexpr int SLOT_ROWS = 2 * MT + NEXP * 256;
constexpr float EPS = 1e-6f;
constexpr float C2 = 0.125f * 1.4426950408889634f;

constexpr size_t MiB = 1u << 20;
constexpr size_t WS_CTL = 0, CTL_ZERO_BYTES = 1 * MiB;
constexpr size_t WS_MOD = 1 * MiB;
constexpr size_t WS_WIN0 = 2 * MiB;
constexpr size_t WS_WOUT0 = 5 * MiB;
constexpr size_t WS_WIN1 = 7 * MiB;
constexpr size_t WS_WOUT1 = 12 * MiB;
constexpr size_t WS_WGU = 14 * MiB;
constexpr size_t WS_WDN = 46 * MiB;
constexpr size_t WS_WPOOL = 62 * MiB;
constexpr size_t WS_WSG = 62 * MiB + 512 * 1024;
constexpr size_t WS_ABUF = 64 * MiB;
constexpr size_t WS_H = 132 * MiB;
constexpr size_t WS_ACT = 260 * MiB;
constexpr size_t WS_RGN = 294 * MiB;
constexpr size_t RG_Q = WS_RGN, RG_K = RG_Q + 32 * MiB, RG_V = RG_K + 9 * MiB, RG_P = RG_V + 9 * MiB, RG_A2 = RG_P + 32 * MiB;
constexpr size_t WS_ROUTE = 462 * MiB;
constexpr size_t RT_E = WS_ROUTE, RT_POS = RT_E + 256 * 1024, RT_W = RT_POS + 256 * 1024, RT_LIST = WS_ROUTE + 1 * MiB;
constexpr size_t WS_END = 466 * MiB;
static_assert(RG_A2 + (size_t)MT * 1024 * 2 <= WS_ROUTE && WS_RGN + (size_t)SLOT_ROWS * 1024 * 2 <= WS_ROUTE && WS_RGN + (size_t)MT * 2560 * 2 <= WS_ROUTE, "region map");
static_assert(WS_ACT + (size_t)SLOT_ROWS * 256 * 2 <= WS_RGN && WS_ABUF + (size_t)MA * 1024 * 2 <= WS_H && WS_H + (size_t)MT * 1024 * 4 <= WS_ACT, "ws map");
constexpr int CW_CNT = 64;
constexpr int CW_BAR = 4096;

constexpr int RING_BYTES = 131072;
constexpr int LDSCTL_OFF = RING_BYTES, MISC_OFF = LDSCTL_OFF + 320;
constexpr int LDS_BYTES = 147456;
constexpr int NWAVES = 8;

__device__ __forceinline__ unsigned cvt_pk_bf16(float lo, float hi) { unsigned r; asm volatile("v_cvt_pk_bf16_f32 %0, %1, %2" : "=v"(r) : "v"(lo), "v"(hi)); return r; }
__device__ __forceinline__ float bf_lo(unsigned w) { return __uint_as_float(w << 16); }
__device__ __forceinline__ float bf_hi(unsigned w) { return __uint_as_float(w & 0xffff0000u); }
__device__ __forceinline__ float wave_sum(float v) {
#pragma unroll
    for (int o = 1; o < 64; o <<= 1) v += __shfl_xor(v, o);
    return v;
}
__device__ __forceinline__ float fast_rcp(float x) { return __builtin_amdgcn_rcpf(x); }
__device__ __forceinline__ float silu_f(float v) { return v * fast_rcp(1.f + __builtin_amdgcn_exp2f(-1.4426950408889634f * v)); }

__device__ __forceinline__ int opaque_tid() { int t = threadIdx.x; asm volatile("" : "+v"(t)); return t; }

#define XB_TMO      128
#define XB_XCNT(j)  (256  + 64 * (j))
#define XB_XSUB(j)  (1280 + 64 * (j))
#define XB_XGEN(j)  (2304 + 64 * (j))
#define XB_TOP      3328
#define XB_TOPGEN   3392
#define XCD_BAR_WORDS 3456
#define XB_SPIN_CAP (1u << 18)
__device__ __forceinline__ unsigned xb_ld(unsigned* p)              { return __hip_atomic_load(p, __ATOMIC_RELAXED, __HIP_MEMORY_SCOPE_AGENT); }
__device__ __forceinline__ unsigned xb_add(unsigned* p, unsigned v) { return __hip_atomic_fetch_add(p, v, __ATOMIC_RELAXED, __HIP_MEMORY_SCOPE_AGENT); }
__device__ __forceinline__ unsigned xb_xcc_id() { return (unsigned)__builtin_amdgcn_s_getreg((3 << 11) | 20) & 0xFu; }
#define XB_SPIN(cond, bar) do { unsigned _sp = 0; while (cond) { __builtin_amdgcn_s_sleep(1); \
    if ((++_sp & 255u) == 0u) { if (xb_ld(&(bar)[XB_TMO])) break; if (_sp > XB_SPIN_CAP) { atomicAdd(&(bar)[XB_TMO], 1u); break; } } } } while (0)
struct XcdBarrier { unsigned* bar; unsigned x; volatile LAS unsigned* st; };
__device__ __forceinline__ XcdBarrier xcd_barrier_post(unsigned* bar, volatile LAS unsigned* st) {
    XcdBarrier b; b.bar = bar; b.x = xb_xcc_id(); b.st = st;
    if (threadIdx.x == 0) (void)xb_add(&bar[XB_XCNT(b.x)], 1u);
    return b;
}
__device__ __forceinline__ void xcd_barrier_complete(unsigned* bar, unsigned x, unsigned& nloc, unsigned& nx) {
    const unsigned G = gridDim.x * gridDim.y * gridDim.z;
    unsigned sum, cnt, mine, sp = 0u;
    for (;;) {
        sum = 0u; cnt = 0u; mine = 0u;
#pragma unroll
        for (unsigned j = 0; j < 16; ++j) { const unsigned c = xb_ld(&bar[XB_XCNT(j)]); sum += c; cnt += (c > 0u) ? 1u : 0u; mine = (j == x) ? c : mine; }
        if (sum == G) break;
        __builtin_amdgcn_s_sleep(1);
        if ((++sp & 255u) == 0u) { if (xb_ld(&bar[XB_TMO])) break; if (sp > XB_SPIN_CAP) { atomicAdd(&bar[XB_TMO], 1u); break; } }
    }
    nloc = mine > 0u ? mine : 1u; nx = cnt > 0u ? cnt : 1u;
}
__device__ __forceinline__ void xcd_barrier(const XcdBarrier& b) {
    asm volatile("s_waitcnt vmcnt(0)" ::: "memory");
    __syncthreads();
    if (threadIdx.x == 0) {
        unsigned* bar = b.bar;
        __builtin_amdgcn_s_waitcnt(0);
        unsigned nloc = b.st[0], nx = b.st[1];
        if (nloc == 0u) { xcd_barrier_complete(bar, b.x, nloc, nx); b.st[0] = nloc; b.st[1] = nx; }
        const unsigned old = xb_add(&bar[XB_XSUB(b.x)], 1u);
        const unsigned gen = old / nloc;
        if (old + 1u == (gen + 1u) * nloc) {
            __builtin_amdgcn_fence(__ATOMIC_RELEASE, "agent");
            asm volatile("s_waitcnt vmcnt(0)" ::: "memory");
            const unsigned og = xb_add(&bar[XB_TOP], 1u);
            const unsigned tg = og / nx;
            if (og + 1u == (tg + 1u) * nx) xb_add(&bar[XB_TOPGEN], 1u);
            else XB_SPIN(xb_ld(&bar[XB_TOPGEN]) == tg, bar);
            __builtin_amdgcn_fence(__ATOMIC_ACQUIRE, "agent");
            xb_add(&bar[XB_XGEN(b.x)], 1u);
            asm volatile("s_waitcnt vmcnt(0)" ::: "memory");
        } else {
            XB_SPIN(xb_ld(&bar[XB_XGEN(b.x)]) == gen, bar);
            __builtin_amdgcn_fence(__ATOMIC_ACQUIRE, "agent");
            asm volatile("s_waitcnt vmcnt(0)" ::: "memory");
        }
    }
    __syncthreads();
}

namespace pg8 {
constexpr int BM = 256, BK = 64, HALF = 128, HTB = HALF * BK * 2;
__device__ __forceinline__ int lds_byte(int r, int c) { const int st = (r >> 4) * 2 + (c >> 5), rr = r & 15, cc = c & 31, ob = rr * 64 + cc * 2; return st * 1024 + (ob ^ (((ob >> 9) & 1) << 5)); }
__device__ __forceinline__ void stage_rc(int b, int& R, int& C) { const int st = b / 1024, sb = b % 1024, swz = sb ^ (((sb >> 9) & 1) << 5); R = (st >> 1) * 16 + swz / 64; C = (st & 1) * 32 + (swz % 64) / 2; }
__device__ __forceinline__ int perm32(int rho) { const int n = rho >> 4, i = rho & 15; return 8 * (i >> 2) + 4 * n + (i & 3); }

struct Unit { int pm, pn, aux, e, r; };

template <class Epi, class Sched, bool GATHER>
__device__ __forceinline__ void gemm_phase(LAS unsigned char* lds, const bf16_t* A, const bf16_t* Bt, const int K, const Sched& S, const Epi& E) {
    const int tid = opaque_tid(), wid = __builtin_amdgcn_readfirstlane(tid >> 6), lane = tid & 63, wr = wid >> 2, wc = wid & 3, fr = lane & 15, fq = lane >> 4;
    const int nt = K / BK;
    unsigned voffB[2]; int RA[2], CA[2];
#pragma unroll
    for (int i = 0; i < 2; ++i) { int R, C; stage_rc(tid * 16 + i * 8192, R, C); const int Rb = Epi::PERM ? ((R & ~31) + perm32(R & 31)) : R;
        voffB[i] = (unsigned)(Rb * K + C) * 2u; RA[i] = R; CA[i] = C; }
    const size_t kstep = (size_t)(BK * 2);
    const size_t hstep = (size_t)HALF * K * 2;
    const size_t tstep = 2 * hstep;
    const unsigned ldsw = (unsigned)wid * 1024u;
    const int aoff = lds_byte(wr * 64 + fr, fq * 8), boff = lds_byte(wc * 32 + fr, fq * 8);
#define PG8_SA(b, h) (((b) * 2 + (h)) * HTB)
#define PG8_SB(b, h) ((4 + (b) * 2 + (h)) * HTB)
#define PG8_STAGE(bufoff, gbase, voff) do { _Pragma("unroll") for (int _i = 0; _i < 2; ++_i) \
        __builtin_amdgcn_global_load_lds((const unsigned*)((const char*)(gbase) + (voff)[_i]), (LAS unsigned*)(lds + (bufoff) + ldsw + _i * 8192), 16, 0, 0); } while (0)
#define PG8_LDA(dst, b, h) do { _Pragma("unroll") for (int m = 0; m < 4; ++m) _Pragma("unroll") for (int k = 0; k < 2; ++k) dst[m][k] = *(const LAS bf16x8*)(lds + PG8_SA(b, h) + aoff + m * 2048 + k * 1024); } while (0)
#define PG8_LDB(dst, b, h) do { _Pragma("unroll") for (int n = 0; n < 2; ++n) _Pragma("unroll") for (int k = 0; k < 2; ++k) dst[n][k] = *(const LAS bf16x8*)(lds + PG8_SB(b, h) + boff + n * 2048 + k * 1024); } while (0)
#define PG8_MMA(ai, bj, At, Bt_) do { __builtin_amdgcn_s_setprio(1); _Pragma("unroll") for (int m = 0; m < 4; ++m) _Pragma("unroll") for (int n = 0; n < 2; ++n) _Pragma("unroll") for (int k = 0; k < 2; ++k) \
        acc[ai][bj][m][n] = __builtin_amdgcn_mfma_f32_16x16x32_bf16(Bt_[n][k], At[m][k], acc[ai][bj][m][n], 0, 0, 0); __builtin_amdgcn_s_setprio(0); } while (0)
#define PG8_WAIT_V(n) asm volatile("s_waitcnt vmcnt(" #n ")" ::: "memory")
#define PG8_WAIT_L(n) asm volatile("s_waitcnt lgkmcnt(" #n ")" ::: "memory")
#define PG8_BAR __builtin_amdgcn_s_barrier()
#define PG8_SCHED __builtin_amdgcn_sched_barrier(0)
    Unit cur, nxt; int ui = 0;
    if (!S.next(0, cur)) return;
    unsigned voA[2][2], voN[2][2];
    if constexpr (GATHER) S.rows(cur, RA, CA, K, voA);
    else {
#pragma unroll
        for (int h = 0; h < 2; ++h)
#pragma unroll
            for (int i = 0; i < 2; ++i) voA[h][i] = (unsigned)((h * HALF + RA[i]) * K + CA[i]) * 2u;
    }
    f32x4 acc[2][2][4][2];
#pragma unroll
    for (int a = 0; a < 2; ++a)
#pragma unroll
        for (int b = 0; b < 2; ++b)
#pragma unroll
            for (int m = 0; m < 4; ++m)
#pragma unroll
                for (int n = 0; n < 2; ++n) acc[a][b][m][n] = (f32x4){0.f, 0.f, 0.f, 0.f};
    bf16x8 At[4][2], B0[2][2], B1[2][2];
    const char* cA = GATHER ? (const char*)A : (const char*)A + (size_t)cur.pm * tstep;
    const char* cB = (const char*)Bt + (size_t)cur.pn * tstep;
    PG8_STAGE(PG8_SB(0, 0), cB, voffB); PG8_STAGE(PG8_SB(0, 1), cB + hstep, voffB); PG8_STAGE(PG8_SA(0, 0), cA, voA[0]); PG8_STAGE(PG8_SA(0, 1), cA, voA[1]);
    if (wr == 1) PG8_BAR;
    PG8_WAIT_V(2); PG8_BAR;
    PG8_STAGE(PG8_SB(1, 0), cB + kstep, voffB); PG8_STAGE(PG8_SA(1, 0), cA + kstep, voA[0]); PG8_STAGE(PG8_SB(1, 1), cB + hstep + kstep, voffB);
    PG8_WAIT_V(6); PG8_BAR;
    for (;;) {
        const bool has_next = S.next(ui + 1, nxt);
        const char* nA = cA; const char* nB = cB;
        if (has_next) { nA = GATHER ? (const char*)A : (const char*)A + (size_t)nxt.pm * tstep; nB = (const char*)Bt + (size_t)nxt.pn * tstep; }
        if constexpr (GATHER) {
            if (has_next) S.rows(nxt, RA, CA, K, voN);
            else {
#pragma unroll
                for (int h = 0; h < 2; ++h)
#pragma unroll
                    for (int i = 0; i < 2; ++i) voN[h][i] = voA[h][i];
            }
        }
#pragma unroll 1
        for (int t = 0; t < nt; t += 2) {
            const bool last = (t == nt - 2);
            const char* a1 = cA + (size_t)(t + 1) * kstep;
            const char* a2 = last ? nA : cA + (size_t)(t + 2) * kstep; const char* b2 = last ? nB : cB + (size_t)(t + 2) * kstep;
            const char* a3 = a2 + kstep; const char* b3 = b2 + kstep;
            unsigned sel[2][2];
#pragma unroll
            for (int h = 0; h < 2; ++h)
#pragma unroll
                for (int i = 0; i < 2; ++i) sel[h][i] = (GATHER && last) ? voN[h][i] : voA[h][i];
            PG8_LDB(B0, 0, 0); PG8_LDB(B1, 0, 1); PG8_SCHED; PG8_LDA(At, 0, 0); PG8_STAGE(PG8_SA(1, 1), a1, voA[1]);
            PG8_WAIT_V(8); PG8_WAIT_L(0); PG8_BAR; PG8_MMA(0, 0, At, B0); PG8_MMA(0, 1, At, B1); PG8_BAR; PG8_SCHED;
            PG8_LDA(At, 0, 1); PG8_STAGE(PG8_SB(0, 0), b2, voffB); PG8_STAGE(PG8_SB(0, 1), b2 + hstep, voffB); PG8_STAGE(PG8_SA(0, 0), a2, sel[0]);
            PG8_WAIT_V(8); PG8_WAIT_L(0); PG8_BAR; PG8_MMA(1, 0, At, B0); PG8_MMA(1, 1, At, B1); PG8_BAR; PG8_SCHED;
            PG8_LDB(B0, 1, 0); PG8_LDB(B1, 1, 1); PG8_SCHED; PG8_LDA(At, 1, 0); PG8_STAGE(PG8_SA(0, 1), a2, sel[1]);
            PG8_WAIT_V(8); PG8_WAIT_L(0); PG8_BAR; PG8_MMA(0, 0, At, B0); PG8_MMA(0, 1, At, B1); PG8_BAR; PG8_SCHED;
            PG8_LDA(At, 1, 1); PG8_STAGE(PG8_SB(1, 0), b3, voffB); PG8_STAGE(PG8_SB(1, 1), b3 + hstep, voffB); PG8_STAGE(PG8_SA(1, 0), a3, sel[0]);
            PG8_WAIT_V(8); PG8_WAIT_L(0); PG8_BAR; PG8_MMA(1, 0, At, B0); PG8_MMA(1, 1, At, B1); PG8_BAR; PG8_SCHED;
        }
        if (wr == 0) PG8_BAR;
        E(acc, cur, wr, wc, fr, fq);
        if (!has_next) break;
#pragma unroll
        for (int a = 0; a < 2; ++a)
#pragma unroll
            for (int b = 0; b < 2; ++b)
#pragma unroll
                for (int m = 0; m < 4; ++m)
#pragma unroll
                    for (int n = 0; n < 2; ++n) acc[a][b][m][n] = (f32x4){0.f, 0.f, 0.f, 0.f};
        cur = nxt; cA = nA; cB = nB; ++ui;
        if constexpr (GATHER) {
#pragma unroll
            for (int h = 0; h < 2; ++h)
#pragma unroll
                for (int i = 0; i < 2; ++i) voA[h][i] = voN[h][i];
        }
        if (wr == 1) PG8_BAR;
    }
    PG8_WAIT_V(0);
    PG8_BAR;
#undef PG8_SA
#undef PG8_SB
#undef PG8_STAGE
#undef PG8_LDA
#undef PG8_LDB
#undef PG8_MMA
#undef PG8_WAIT_V
#undef PG8_WAIT_L
#undef PG8_BAR
#undef PG8_SCHED
}

struct SchedGrid {
    int nN, total, G, c;
    __device__ __forceinline__ bool next(int i, Unit& u) const { const int L = i * G + c; if (L >= total) return false; u.pm = L / nN; u.pn = L % nN; u.aux = u.pn; u.e = 0; u.r = 0; return true; }
};
struct SchedInProj0 {
    int G, c;
    __device__ __forceinline__ bool next(int i, Unit& u) const { const int L = i * G + c; if (L >= 648) return false;
        if (L < 640) { u.pm = L / 5; u.pn = L % 5; } else { u.pm = 128 + (L - 640); u.pn = 2; } u.aux = u.pn; u.e = 0; u.r = 0; return true; }
};
struct SchedMoE {
    const volatile LAS int* tp; const int* list; int ncol, G, c; bool gather;
    __device__ __forceinline__ bool next(int i, Unit& u) const {
        const int L = i * G + c; const int total = tp[16] * ncol; if (L >= total) return false;
        const int rt = L / ncol, pl = L % ncol; int e = 0;
#pragma unroll
        for (int j = 1; j < 16; ++j) e += (rt >= tp[j]) ? 1 : 0;
        e = __builtin_amdgcn_readfirstlane(e);
        u.pm = rt; u.pn = e * ncol + pl; u.aux = pl; u.e = e; u.r = rt - tp[e]; return true;
    }
    __device__ __forceinline__ void rows(const Unit& u, const int (&RA)[2], const int (&CA)[2], int K, unsigned (&vo)[2][2]) const {
        const int cnt = tp[17 + u.e];
#pragma unroll
        for (int h = 0; h < 2; ++h)
#pragma unroll
            for (int i = 0; i < 2; ++i) { const int idx = u.r * 256 + h * HALF + RA[i]; const int tok = (idx < cnt) ? list[u.e * LISTCAP + idx] : 0;
                vo[h][i] = (unsigned)(tok * K + CA[i]) * 2u; }
    }
};

typedef f32x4 Acc[2][2][4][2];
struct EpiBf16 {
    static constexpr bool PERM = true;
    bf16_t* O; int ldc; bool use_aux;
    __device__ __forceinline__ void operator()(const Acc& acc, const Unit& u, int wr, int wc, int fr_, int fq_) const {
        int ln_ = fr_ | (fq_ << 4); asm volatile("" : "+v"(ln_)); const int fr = ln_ & 15, fq = ln_ >> 4;
        const int row0 = u.pm * BM + wr * 64 + fr; const int col0 = (use_aux ? u.aux : u.pn) * BM + wc * 32 + 8 * fq;
#pragma unroll
        for (int ai = 0; ai < 2; ++ai)
#pragma unroll
            for (int m = 0; m < 4; ++m) { bf16_t* rowp = O + (size_t)(row0 + ai * HALF + m * 16) * ldc + col0;
#pragma unroll
                for (int bj = 0; bj < 2; ++bj) { const f32x4 v0 = acc[ai][bj][m][0], v1 = acc[ai][bj][m][1];
                    u32x4 w; w.x = cvt_pk_bf16(v0[0], v0[1]); w.y = cvt_pk_bf16(v0[2], v0[3]); w.z = cvt_pk_bf16(v1[0], v1[1]); w.w = cvt_pk_bf16(v1[2], v1[3]);
                    *(u32x4*)(rowp + bj * HALF) = w; } }
    }
};
struct EpiGateUp {
    static constexpr bool PERM = true;
    bf16_t* O;
    __device__ __forceinline__ void operator()(const Acc& acc, const Unit& u, int wr, int wc, int fr_, int fq_) const {
        int ln_ = fr_ | (fq_ << 4); asm volatile("" : "+v"(ln_)); const int fr = ln_ & 15, fq = ln_ >> 4;
        const int row0 = u.pm * BM + wr * 64 + fr; const int col0 = u.aux * HALF + wc * 32 + 8 * fq;
#pragma unroll
        for (int ai = 0; ai < 2; ++ai)
#pragma unroll
            for (int m = 0; m < 4; ++m) { bf16_t* rowp = O + (size_t)(row0 + ai * HALF + m * 16) * DEXP + col0;
                float o[8];
#pragma unroll
                for (int n = 0; n < 2; ++n)
#pragma unroll
                    for (int j = 0; j < 4; ++j) o[n * 4 + j] = silu_f(acc[ai][0][m][n][j]) * acc[ai][1][m][n][j];
                u32x4 w; w.x = cvt_pk_bf16(o[0], o[1]); w.y = cvt_pk_bf16(o[2], o[3]); w.z = cvt_pk_bf16(o[4], o[5]); w.w = cvt_pk_bf16(o[6], o[7]);
                *(u32x4*)rowp = w; }
    }
};
struct EpiResid {
    static constexpr bool PERM = false;
    const float* Hin; float* Hout; const float* gate;
    __device__ __forceinline__ void operator()(const Acc& acc, const Unit& u, int wr, int wc, int fr_, int fq_) const {
        int ln_ = fr_ | (fq_ << 4); asm volatile("" : "+v"(ln_)); const int fr = ln_ & 15, fq = ln_ >> 4;
        const int b = u.pm >> 4; const int col0 = u.pn * BM + wc * 32 + 4 * fq; const float* gb = gate + (size_t)b * 6144 + col0;
        f32x4 gv[2][2];
#pragma unroll
        for (int bj = 0; bj < 2; ++bj)
#pragma unroll
            for (int n = 0; n < 2; ++n) gv[bj][n] = *(const f32x4*)(gb + bj * HALF + n * 16);
#pragma unroll
        for (int ai = 0; ai < 2; ++ai)
#pragma unroll
            for (int m = 0; m < 4; ++m) { const size_t off = (size_t)(u.pm * BM + ai * HALF + wr * 64 + m * 16 + fr) * DM + col0;
#pragma unroll
                for (int bj = 0; bj < 2; ++bj)
#pragma unroll
                    for (int n = 0; n < 2; ++n) { const f32x4 hv = *(const f32x4*)(Hin + off + bj * HALF + n * 16);
                        *(f32x4*)(Hout + off + bj * HALF + n * 16) = hv + gv[bj][n] * acc[ai][bj][m][n]; } }
    }
};
struct EpiQKV {
    static constexpr bool PERM = true;
    bf16_t *Q, *Kb, *Vb, *P; const float *qg, *kg;
    __device__ __forceinline__ void operator()(const Acc& acc, const Unit& u, int wr, int wc, int fr_, int fq_) const {
        int ln_ = fr_ | (fq_ << 4); asm volatile("" : "+v"(ln_)); const int fr = ln_ & 15, fq = ln_ >> 4;
        const int pn = u.pn; const bool isctx = u.pm >= 128;
        const int rloc0 = wr * 64 + fr;
        if (pn >= 3) {
#pragma unroll
            for (int ai = 0; ai < 2; ++ai)
#pragma unroll
                for (int m = 0; m < 4; ++m) { bf16_t* rowp = P + (size_t)(u.pm * BM + rloc0 + ai * HALF + m * 16) * 512 + (pn - 3) * BM + wc * 32 + 8 * fq;
#pragma unroll
                    for (int bj = 0; bj < 2; ++bj) { const f32x4 v0 = acc[ai][bj][m][0], v1 = acc[ai][bj][m][1];
                        u32x4 w; w.x = cvt_pk_bf16(v0[0], v0[1]); w.y = cvt_pk_bf16(v0[2], v0[3]); w.z = cvt_pk_bf16(v1[0], v1[1]); w.w = cvt_pk_bf16(v1[2], v1[3]);
                        *(u32x4*)(rowp + bj * HALF) = w; } }
            return;
        }
        if (pn == 2 && wc >= 2) {
            const int vh = wc - 2;
#pragma unroll
            for (int ai = 0; ai < 2; ++ai)
#pragma unroll
                for (int m = 0; m < 4; ++m) { const int rl = rloc0 + ai * HALF + m * 16; int b, krow;
                    if (isctx) { const int cr = (u.pm - 128) * BM + rl; b = cr >> 8; krow = cr & 255; } else { const int mt = u.pm * BM + rl; b = mt >> 12; krow = CTX + (mt & 4095); }
                    bf16_t* rowp = Vb + ((size_t)(b * 2 + vh) * NKV + krow) * 64 + 8 * fq;
#pragma unroll
                    for (int bj = 0; bj < 2; ++bj) { const f32x4 v0 = acc[ai][bj][m][0], v1 = acc[ai][bj][m][1];
                        u32x4 w; w.x = cvt_pk_bf16(v0[0], v0[1]); w.y = cvt_pk_bf16(v0[2], v0[3]); w.z = cvt_pk_bf16(v1[0], v1[1]); w.w = cvt_pk_bf16(v1[2], v1[3]);
                        *(u32x4*)(rowp + bj * 32) = w; } }
            return;
        }
        const bool isq = pn < 2; const int head = isq ? pn * 4 + wc : wc;
        const float* gsrc = (isq ? qg : kg) + 32 * (fq >> 1) + 8 * (fq & 1);
        float g1[8], g2[8], inv[8];
#pragma unroll
        for (int j = 0; j < 8; ++j) { g1[j] = gsrc[j]; g2[j] = gsrc[16 + j];
            inv[j] = __builtin_amdgcn_exp2f(-(float)(8 * (fq & 1) + j) * (13.287712379549449f / 16.0f)) * 0.15915494309189535f; }
        const float osc = isq ? C2 : 1.0f;
#pragma unroll
        for (int ai = 0; ai < 2; ++ai)
#pragma unroll
            for (int m = 0; m < 4; ++m) {
                const int rl = rloc0 + ai * HALF + m * 16;
                float x1[8], x2[8];
#pragma unroll
                for (int n = 0; n < 2; ++n)
#pragma unroll
                    for (int j = 0; j < 4; ++j) { x1[n * 4 + j] = acc[ai][0][m][n][j]; x2[n * 4 + j] = acc[ai][1][m][n][j]; }
                float ss = 0.f;
#pragma unroll
                for (int j = 0; j < 8; ++j) ss += x1[j] * x1[j] + x2[j] * x2[j];
                ss += __shfl_xor(ss, 16); ss += __shfl_xor(ss, 32);
                const float rstd = __builtin_amdgcn_rsqf(ss * (1.0f / 64.0f) + EPS) * osc;
                int b, krow, mt = 0; float pos = 0.f;
                if (isctx) { const int cr = (u.pm - 128) * BM + rl; b = cr >> 8; krow = cr & 255; }
                else { mt = u.pm * BM + rl; b = mt >> 12; const int t = mt & 4095; krow = CTX + t; pos = (float)((fq >> 1) ? (t & 63) : (t >> 6)); }
                float o1[8], o2[8];
#pragma unroll
                for (int j = 0; j < 8; ++j) { const float y1 = x1[j] * rstd * g1[j], y2 = x2[j] * rstd * g2[j];
                    if (isctx) { o1[j] = y1; o2[j] = y2; }
                    else { const float rev = pos * inv[j]; const float cs = __builtin_amdgcn_cosf(rev), sn = __builtin_amdgcn_sinf(rev);
                        o1[j] = y1 * cs - y2 * sn; o2[j] = y2 * cs + y1 * sn; } }
                bf16_t* rowp = isq ? (Q + (size_t)mt * 512 + head * 64 + 8 * fq) : (Kb + ((size_t)(b * 2 + head) * NKV + krow) * 64 + 8 * fq);
                u32x4 w; w.x = cvt_pk_bf16(o1[0], o1[1]); w.y = cvt_pk_bf16(o1[2], o1[3]); w.z = cvt_pk_bf16(o1[4], o1[5]); w.w = cvt_pk_bf16(o1[6], o1[7]);
                *(u32x4*)rowp = w;
                w.x = cvt_pk_bf16(o2[0], o2[1]); w.y = cvt_pk_bf16(o2[2], o2[3]); w.z = cvt_pk_bf16(o2[4], o2[5]); w.w = cvt_pk_bf16(o2[6], o2[7]);
                *(u32x4*)(rowp + 32) = w;
            }
    }
};
}

namespace attn_body {
constexpr int NW = 8, QBLK = 32, QB = QBLK * NW, KVBLK = 64, NT = NKV / KVBLK;
constexpr int QP = 512, KP = 64, OP = 1024;
static_assert(NT % 2 == 0 && NT >= 8, "tile count");
__device__ __forceinline__ int crow(int r, int hi) { return (r & 3) + 8 * (r >> 2) + 4 * hi; }
#define SBAR() __builtin_amdgcn_sched_barrier(0)
constexpr int NSLOT = 3, SLOTB = 8192;
constexpr int LDS_K = 0, LDS_V = NSLOT * SLOTB, LDS_WS = 2 * NSLOT * SLOTB, LDS_OST = LDS_WS + NW * 64 * 4, ATT_LDS_BYTES = LDS_OST + NW * 4096;
__device__ __forceinline__ void glds16(const void* gsrc, unsigned lds_dst) { unsigned keep;
    asm volatile("s_mov_b32 %0, m0\n\ts_mov_b32 m0, %2\n\ts_nop 0\n\tglobal_load_lds_dwordx4 %1, off\n\ts_mov_b32 m0, %0" : "=&s"(keep) : "v"(gsrc), "s"(lds_dst) : "memory"); }
__device__ __forceinline__ float max3f(float a, float b, float c) { float r; asm("v_max3_f32 %0, %1, %2, %3" : "=v"(r) : "v"(a), "v"(b), "v"(c)); return r; }
__device__ __forceinline__ float max2f(float a, float b) { float r; asm("v_max_f32_e32 %0, %1, %2" : "=v"(r) : "v"(a), "v"(b)); return r; }
__device__ __forceinline__ float fadd_s(float a, float b) { float r; asm("v_add_f32_e32 %0, %1, %2" : "=v"(r) : "v"(a), "v"(b)); return r; }
__device__ __forceinline__ float fsub_s(float a, float b) { float r; asm("v_sub_f32_e32 %0, %1, %2" : "=v"(r) : "v"(a), "v"(b)); return r; }
typedef __bf16 bf16x2_t __attribute__((ext_vector_type(2)));
__device__ __forceinline__ unsigned cvtpk_s(float lo, float hi) { f32x2 v = {lo, hi}; bf16x2_t b = __builtin_convertvector(v, bf16x2_t); return __builtin_bit_cast(unsigned, b); }
#define WAIT_BAR(N) asm volatile("s_waitcnt vmcnt(" #N ") lgkmcnt(0)\n\ts_barrier" ::: "memory")
__device__ __forceinline__ void qkt(f32x16& p0, f32x16& p1, const char* Kslot, const bf16x8* qr, const f32x16& negm, int r32, int hi) {
    const char* kb = Kslot + hi * 1024 + r32 * 16;
#pragma unroll
    for (int d0 = 0; d0 < 4; ++d0) {
        const bf16x8 b0 = *reinterpret_cast<const bf16x8*>(kb + d0 * 2048);
        const bf16x8 b1 = *reinterpret_cast<const bf16x8*>(kb + d0 * 2048 + 512);
        if (d0 == 0) { p0 = __builtin_amdgcn_mfma_f32_32x32x16_bf16(b0, qr[0], negm, 0, 0, 0); p1 = __builtin_amdgcn_mfma_f32_32x32x16_bf16(b1, qr[0], negm, 0, 0, 0); }
        else { p0 = __builtin_amdgcn_mfma_f32_32x32x16_bf16(b0, qr[d0], p0, 0, 0, 0); p1 = __builtin_amdgcn_mfma_f32_32x32x16_bf16(b1, qr[d0], p1, 0, 0, 0); } }
}
typedef __attribute__((address_space(3))) const char* lds_cptr;
typedef short v4i16_t __attribute__((ext_vector_type(4)));
__device__ __forceinline__ void kload8(bf16x8* kf, lds_cptr kp) {
    kf[0] = *(const LAS bf16x8*)(kp);        kf[1] = *(const LAS bf16x8*)(kp + 512);
    kf[2] = *(const LAS bf16x8*)(kp + 2048); kf[3] = *(const LAS bf16x8*)(kp + 2560);
    kf[4] = *(const LAS bf16x8*)(kp + 4096); kf[5] = *(const LAS bf16x8*)(kp + 4608);
    kf[6] = *(const LAS bf16x8*)(kp + 6144); kf[7] = *(const LAS bf16x8*)(kp + 6656);
}
__device__ __forceinline__ void kload2(bf16x8* kf, lds_cptr kp, int j) { kf[2 * j] = *(const LAS bf16x8*)(kp + j * 2048); kf[2 * j + 1] = *(const LAS bf16x8*)(kp + j * 2048 + 512); }
__device__ __forceinline__ s16x4 vtr(lds_cptr p) { return __builtin_bit_cast(s16x4, __builtin_amdgcn_ds_read_tr16_b64_v4i16((LAS v4i16_t*)p)); }
__device__ __forceinline__ float rowmax(const f32x16& p0, const f32x16& p1) {
    float a = max3f(p0[0], p0[1], p1[0]), b = max3f(p0[2], p0[3], p1[1]); a = max3f(a, p1[2], p1[3]);
#pragma unroll
    for (int r = 4; r < 16; r += 4) { a = max3f(a, p0[r], p0[r + 1]); b = max3f(b, p0[r + 2], p0[r + 3]); a = max3f(a, p1[r], p1[r + 1]); b = max3f(b, p1[r + 2], p1[r + 3]); }
    const float m = max2f(a, b);
    auto rr = __builtin_amdgcn_permlane32_swap(__float_as_uint(m), __float_as_uint(m), false, false);
    return max2f(__uint_as_float(rr[0]), __uint_as_float(rr[1]));
}
__device__ __forceinline__ void pv(f32x16* o, int vb, bf16x8 pa0, bf16x8 pa1, bf16x8 pa2, bf16x8 pa3) {
#pragma unroll
    for (int d0 = 0; d0 < 2; ++d0) { s16x4 lo[4], hi[4];
#pragma unroll
        for (int ks = 0; ks < 4; ++ks) {
            asm volatile("ds_read_b64_tr_b16 %0,%1 offset:%c2" : "=&v"(lo[ks]) : "v"(vb), "i"(d0 * 4096 + ks * 1024) : "memory");
            asm volatile("ds_read_b64_tr_b16 %0,%1 offset:%c2" : "=&v"(hi[ks]) : "v"(vb), "i"(d0 * 4096 + ks * 1024 + 512) : "memory"); }
        asm volatile("s_waitcnt lgkmcnt(0)" ::: "memory"); SBAR();
#define PK(k) (bf16x8){lo[k][0], lo[k][1], lo[k][2], lo[k][3], hi[k][0], hi[k][1], hi[k][2], hi[k][3]}
        o[d0] = __builtin_amdgcn_mfma_f32_32x32x16_bf16(pa0, PK(0), o[d0], 0, 0, 0);
        o[d0] = __builtin_amdgcn_mfma_f32_32x32x16_bf16(pa1, PK(1), o[d0], 0, 0, 0);
        o[d0] = __builtin_amdgcn_mfma_f32_32x32x16_bf16(pa2, PK(2), o[d0], 0, 0, 0);
        o[d0] = __builtin_amdgcn_mfma_f32_32x32x16_bf16(pa3, PK(3), o[d0], 0, 0, 0);
#undef PK
    }
}
template <int THRL> __device__ __forceinline__ void attn_unit(int b, int h, int qb, const bf16_t* Q, const bf16_t* __restrict__ K, const bf16_t* __restrict__ V, bf16_t* O, char* shm) {
    const int tid = opaque_tid(), lane = tid & 63, r32 = lane & 31, hi = lane >> 5; const int wid = __builtin_amdgcn_readfirstlane(tid >> 6);
    const long rowq = (long)b * SEQ + qb * QB + wid * QBLK;
    const bf16_t* Qw = Q + rowq * QP + h * 64;
    const bf16_t* Kh = K + (long)(b * 2 + (h >> 2)) * NKV * KP, *Vh = V + (long)(b * 2 + (h >> 2)) * NKV * KP;
    const unsigned lds0 = (unsigned)(uintptr_t)shm;
    float* wsf = (float*)(shm + LDS_WS) + wid * 64;
    const bf16_t* ksrc = Kh + (long)lane * KP + wid * 8;
    const bf16_t* vsrc = Vh + (long)(16 * (wid & 3) + (lane >> 2)) * KP + (wid >> 2) * 32 + (lane & 3) * 8;
    const unsigned kdst = lds0 + LDS_K + wid * 1024, vdst = lds0 + LDS_V + wid * 1024;
#define DMA_K(t, slot) glds16(ksrc + (long)(t) * KVBLK * KP, (unsigned)__builtin_amdgcn_readfirstlane(kdst + (slot)))
#define DMA_V(t, slot) glds16(vsrc + (long)(t) * KVBLK * KP, (unsigned)__builtin_amdgcn_readfirstlane(vdst + (slot)))
    const int vb0 = (int)(lds0 + LDS_V) + ((lane >> 4) & 1) * 32 + (lane & 3) * 8 + (4 * hi + ((lane & 15) >> 2)) * 64;
    const char* Kbase = shm + LDS_K; bf16x8 kf[8];
    const lds_cptr shm3 = (lds_cptr)shm; const lds_cptr kp0 = shm3 + LDS_K + hi * 1024 + r32 * 16; const lds_cptr vp0 = shm3 + LDS_V + ((lane >> 4) & 1) * 32 + (lane & 3) * 8 + (4 * hi + ((lane & 15) >> 2)) * 64;
    DMA_K(0, 0); DMA_V(0, 0); DMA_K(1, SLOTB);
    bf16x8 qr[4];
#pragma unroll
    for (int d0 = 0; d0 < 4; ++d0) qr[d0] = *reinterpret_cast<const bf16x8*>(&Qw[(long)r32 * QP + d0 * 16 + hi * 8]);
    float mhat = 0.f, l_reg = 0.f; f32x16 o[2]; o[0] = f32x16{}; o[1] = f32x16{}; f32x16 negm = f32x16{}; asm volatile("" : "+v"(negm));
    bool resc = false;
#define START(P0, P1) do { const float rm = rowmax(P0, P1); resc = false; \
    { const float dl = rm; mhat = fadd_s(mhat, dl); \
      _Pragma("unroll") for (int r = 0; r < 16; ++r) { P0[r] = fsub_s(P0[r], dl); P1[r] = fsub_s(P1[r], dl); } \
      _Pragma("unroll") for (int r = 0; r < 16; ++r) negm[r] = -mhat; asm volatile("" : "+v"(negm)); } \
    _Pragma("unroll") for (int r = 0; r < 16; ++r) P0[r] = __builtin_amdgcn_exp2f(P0[r]); } while (0)
#define RESC() do { if (resc) { asm volatile("s_waitcnt lgkmcnt(0)" ::: "memory"); \
      _Pragma("unroll") for (int d_ = 0; d_ < 2; ++d_) _Pragma("unroll") for (int r = 0; r < 16; ++r) o[d_][r] *= wsf[crow(r, hi)]; } } while (0)
    f32x16 pA0, pA1, pB0, pB1;
    int sl_prev = 0, sl_cur = 0, sl_next = SLOTB;
#define ROT() do { sl_prev = sl_cur; sl_cur = sl_next; sl_next = (sl_next == (NSLOT - 1) * SLOTB) ? 0 : sl_next + SLOTB; } while (0)
    DMA_K(2, 2 * SLOTB);
    WAIT_BAR(3);
    qkt(pA0, pA1, Kbase, qr, negm, r32, hi); asm volatile("s_nop 15\n\ts_nop 7" : "+v"(pA0), "+v"(pA1));
    START(pA0, pA1);
    _Pragma("unroll") for (int r = 0; r < 16; ++r) pA1[r] = __builtin_amdgcn_exp2f(pA1[r]);
    WAIT_BAR(0);
    DMA_K(3, 0); DMA_V(1, SLOTB);
    ROT();
    kload8(kf, kp0 + sl_cur);
    WAIT_BAR(2);
    s16x4 vlo[8], vhi[8]; u32x4 pw0, pw1, pw2, pw3;
#define PKW(P, B) cvtpk_s(P[B], P[B + 1])
#define PAF(k) __builtin_bit_cast(bf16x8, pw##k)
#define VFR(i) (bf16x8){vlo[i][0], vlo[i][1], vlo[i][2], vlo[i][3], vhi[i][0], vhi[i][1], vhi[i][2], vhi[i][3]}
#define PIN(x) asm volatile("" : "+v"(x))
#define MX3(a, b, c) __builtin_fmaxf(__builtin_fmaxf((a), (b)), (c))
#define GAPA(MF, A0, A1, A2, A3, W0, W1, PW) do { MF; sacc += A0; sacc += A1; sacc += A2; sacc += A3; PIN(sacc); W0; W1; PIN(PW); SBAR(); } while (0)
#define EX(v) __builtin_amdgcn_exp2f(v)
#define GAPB(MF, X, B) do { MF; X[B] = EX(X[B]); X[B + 1] = EX(X[B + 1]); X[B + 2] = EX(X[B + 2]); X[B + 3] = EX(X[B + 3]); PIN(X); SBAR(); } while (0)
#define VRD(i) do { vlo[i] = vtr(vp_ + (((i) >> 2) * 4096 + ((i) & 3) * 1024)); vhi[i] = vtr(vp_ + (((i) >> 2) * 4096 + ((i) & 3) * 1024 + 512)); } while (0)
#define KRD(G, j) do { if (G) { kload2(kf, kp0 + sl_next, j); SBAR(); } } while (0)
#define STEP(C0, C1, P0, P1, t, GK, GV, GL) do { SBAR(); \
    const lds_cptr vp_ = vp0 + sl_prev; \
    VRD(0); SBAR(); float sacc = (P0[0] + P0[1]); \
    GAPA(C0 = __builtin_amdgcn_mfma_f32_32x32x16_bf16(kf[0], qr[0], negm, 0, 0, 0), P0[2], P0[3], P0[4], P0[5],     pw0[0] = PKW(P0, 0), pw0[1] = PKW(P0, 2), pw0); \
    VRD(4); SBAR(); GAPA(C1 = __builtin_amdgcn_mfma_f32_32x32x16_bf16(kf[1], qr[0], negm, 0, 0, 0), P0[6], P0[7], P0[8], P0[9],     pw0[2] = PKW(P0, 4), pw0[3] = PKW(P0, 6), pw0); \
    VRD(1); SBAR(); GAPA(C0 = __builtin_amdgcn_mfma_f32_32x32x16_bf16(kf[2], qr[1], C0, 0, 0, 0),   P0[10], P0[11], P0[12], P0[13], pw1[0] = PKW(P0, 8), pw1[1] = PKW(P0, 10), pw1); \
    VRD(5); SBAR(); GAPA(C1 = __builtin_amdgcn_mfma_f32_32x32x16_bf16(kf[3], qr[1], C1, 0, 0, 0),   P0[14], P0[15], P1[0], P1[1],   pw1[2] = PKW(P0, 12), pw1[3] = PKW(P0, 14), pw1); \
    VRD(2); SBAR(); GAPA(C0 = __builtin_amdgcn_mfma_f32_32x32x16_bf16(kf[4], qr[2], C0, 0, 0, 0),   P1[2], P1[3], P1[4], P1[5],     pw2[0] = PKW(P1, 0), pw2[1] = PKW(P1, 2), pw2); \
    VRD(6); SBAR(); GAPA(C1 = __builtin_amdgcn_mfma_f32_32x32x16_bf16(kf[5], qr[2], C1, 0, 0, 0),   P1[6], P1[7], P1[8], P1[9],     pw2[2] = PKW(P1, 4), pw2[3] = PKW(P1, 6), pw2); \
    VRD(3); SBAR(); GAPA(C0 = __builtin_amdgcn_mfma_f32_32x32x16_bf16(kf[6], qr[3], C0, 0, 0, 0),   P1[10], P1[11], P1[12], P1[13], pw3[0] = PKW(P1, 8), pw3[1] = PKW(P1, 10), pw3); \
    VRD(7); SBAR(); GAPA(C1 = __builtin_amdgcn_mfma_f32_32x32x16_bf16(kf[7], qr[3], C1, 0, 0, 0),   P1[14], P1[15], 0.f, 0.f,       pw3[2] = PKW(P1, 12), pw3[3] = PKW(P1, 14), pw3); \
    l_reg += sacc; \
    if (GK) { DMA_K((t) + 3, sl_cur); } if (GV) { DMA_V((t) + 1, sl_next); } \
    { float a = MX3(C0[0], C0[1], C1[0]), b_ = MX3(C0[2], C0[3], C1[1]); a = MX3(a, C1[2], C1[3]); \
      _Pragma("unroll") for (int r = 4; r < 16; r += 4) { a = MX3(a, C0[r], C0[r + 1]); b_ = MX3(b_, C0[r + 2], C0[r + 3]); a = MX3(a, C1[r], C1[r + 1]); b_ = MX3(b_, C1[r + 2], C1[r + 3]); } \
      float rm = __builtin_fmaxf(a, b_); { auto rr = __builtin_amdgcn_permlane32_swap(__float_as_uint(rm), __float_as_uint(rm), false, false); rm = __builtin_fmaxf(__uint_as_float(rr[0]), __uint_as_float(rr[1])); } \
      resc = false; \
      if (__builtin_expect(__any(rm > (float)THRL), 0)) { const float dl = __builtin_fmaxf(rm, 0.f); mhat += dl; \
        _Pragma("unroll") for (int r = 0; r < 16; ++r) { C0[r] -= dl; C1[r] -= dl; } \
        _Pragma("unroll") for (int r = 0; r < 16; ++r) negm[r] = -mhat; asm volatile("" : "+v"(negm)); \
        const float f = __builtin_amdgcn_exp2f(-dl); l_reg *= f; if (hi == 0) wsf[r32] = f; resc = true; } } \
    SBAR(); \
    GAPB(o[0] = __builtin_amdgcn_mfma_f32_32x32x16_bf16(PAF(0), VFR(0), o[0], 0, 0, 0), C0, 0); \
    GAPB(o[1] = __builtin_amdgcn_mfma_f32_32x32x16_bf16(PAF(0), VFR(4), o[1], 0, 0, 0), C0, 4); \
    KRD(GL, 0); GAPB(o[0] = __builtin_amdgcn_mfma_f32_32x32x16_bf16(PAF(1), VFR(1), o[0], 0, 0, 0), C0, 8); \
    KRD(GL, 1); GAPB(o[1] = __builtin_amdgcn_mfma_f32_32x32x16_bf16(PAF(1), VFR(5), o[1], 0, 0, 0), C0, 12); \
    KRD(GL, 2); GAPB(o[0] = __builtin_amdgcn_mfma_f32_32x32x16_bf16(PAF(2), VFR(2), o[0], 0, 0, 0), C1, 0); \
    KRD(GL, 3); GAPB(o[1] = __builtin_amdgcn_mfma_f32_32x32x16_bf16(PAF(2), VFR(6), o[1], 0, 0, 0), C1, 4); \
    GAPB(o[0] = __builtin_amdgcn_mfma_f32_32x32x16_bf16(PAF(3), VFR(3), o[0], 0, 0, 0), C1, 8); \
    GAPB(o[1] = __builtin_amdgcn_mfma_f32_32x32x16_bf16(PAF(3), VFR(7), o[1], 0, 0, 0), C1, 12); \
    } while (0)
    int t = 1;
    for (; t + 5 < NT; t += 2) {
        STEP(pB0, pB1, pA0, pA1, t, true, true, true);     WAIT_BAR(2); RESC(); ROT();
        STEP(pA0, pA1, pB0, pB1, t + 1, true, true, true); WAIT_BAR(2); RESC(); ROT();
    }
#define ENDW(tt) do { if ((tt) + 3 < NT) { WAIT_BAR(2); } else if ((tt) + 2 < NT) { WAIT_BAR(1); } else { WAIT_BAR(0); } } while (0)
    for (; t + 1 < NT; t += 2) {
        STEP(pB0, pB1, pA0, pA1, t, (t + 3 < NT), (t + 1 < NT), (t + 1 < NT));         ENDW(t);     RESC(); ROT();
        STEP(pA0, pA1, pB0, pB1, t + 1, (t + 4 < NT), (t + 2 < NT), (t + 2 < NT));     ENDW(t + 1); RESC(); ROT();
    }
    STEP(pB0, pB1, pA0, pA1, NT - 1, false, false, false); RESC();
    { float sacc = pB0[0] + pB0[1]; _Pragma("unroll") for (int r = 2; r < 16; ++r) sacc += pB0[r]; _Pragma("unroll") for (int r = 0; r < 16; ++r) sacc += pB1[r]; l_reg += sacc;
      pw0 = (u32x4){PKW(pB0, 0), PKW(pB0, 2), PKW(pB0, 4), PKW(pB0, 6)}; pw1 = (u32x4){PKW(pB0, 8), PKW(pB0, 10), PKW(pB0, 12), PKW(pB0, 14)}; pw2 = (u32x4){PKW(pB1, 0), PKW(pB1, 2), PKW(pB1, 4), PKW(pB1, 6)}; pw3 = (u32x4){PKW(pB1, 8), PKW(pB1, 10), PKW(pB1, 12), PKW(pB1, 14)};
      SBAR(); pv(o, vb0 + sl_cur, PAF(0), PAF(1), PAF(2), PAF(3)); }
#undef PKW
#undef PAF
#undef VFR
#undef PIN
#undef MX3
#undef GAPA
#undef GAPB
#undef EX
#undef VRD
#undef KRD
#undef STEP
#undef ENDW
    { auto rr = __builtin_amdgcn_permlane32_swap(__float_as_uint(l_reg), __float_as_uint(l_reg), false, false); l_reg = __uint_as_float(rr[0]) + __uint_as_float(rr[1]); }
    if (hi == 0) wsf[32 + r32] = l_reg; asm volatile("s_waitcnt lgkmcnt(0)" ::: "memory");
    float rli[16];
#pragma unroll
    for (int r = 0; r < 16; ++r) rli[r] = __builtin_amdgcn_rcpf(wsf[32 + crow(r, hi)]);
    bf16_t* Ow = O + rowq * OP + h * 64;
    { bf16_t* stg = (bf16_t*)(shm + LDS_OST) + wid * 2048;
#pragma unroll
      for (int r = 0; r < 16; ++r) { const int orow = crow(r, hi);
#pragma unroll
        for (int d0 = 0; d0 < 2; ++d0) stg[orow * 64 + d0 * 32 + r32] = (bf16_t)(cvtpk_s(o[d0][r] * rli[r], 0.f) & 0xffffu); }
      asm volatile("s_waitcnt lgkmcnt(0)" ::: "memory");
#pragma unroll
      for (int i = 0; i < 4; ++i) { const int row = i * 8 + (lane >> 3), ch = lane & 7; const u32x4 v = *(const u32x4*)(stg + row * 64 + ch * 8); *(u32x4*)(Ow + (long)row * OP + ch * 8) = v; } }
    asm volatile("s_waitcnt lgkmcnt(0)\n\ts_barrier" ::: "memory");
#undef DMA_K
#undef DMA_V
#undef START
#undef RESC
#undef ROT
}
#undef SBAR
#undef WAIT_BAR
}

#define LDS_WAIT() asm volatile("s_waitcnt lgkmcnt(0)" ::: "memory")
constexpr int TP_OFF = LDSCTL_OFF + 512;
struct Args { const float* in[27]; float* out; unsigned char* ws; };
enum { I_X = 0, I_C, I_CTX, I_CCTX, I_MODW, I_MODB, I_N1G, I_N2G, I_EWIN, I_QG, I_KG, I_POOLW, I_POOLS, I_EWOUT, I_OWIN, I_SGG, I_SGW, I_SGB, I_CONVW, I_OWOUT,
       I_RGW, I_RGB, I_REW, I_REB, I_WG, I_WU, I_WD };

__device__ __forceinline__ int map_in0(int n) {
    if (n < 640) { const int hd = n >> 6, e = n & 63; const int s = e >> 5, r = e & 31, bj = r >> 4, i = r & 15, j = 16 * s + i;
        const int pn = (hd < 8) ? (hd >> 2) : 2, wc = (hd < 8) ? (hd & 3) : (hd - 8); return 256 * pn + 128 * bj + 32 * wc + j; }
    if (n < 768) { const int vh = (n - 640) >> 6, e = n & 63, bj = e >> 5, j = e & 31; return 512 + 128 * bj + 32 * (2 + vh) + j; }
    return n;
}
__device__ __forceinline__ void p0_transpose_item(const float* W, int K, int N, bf16_t* WT, int kind, int off, LAS float* scr, int item, int lane) {
    const int nblk = N / 32, kb = item / nblk, nb = item % nblk, k0 = 64 * kb, n0 = 32 * nb;
#pragma unroll 8
    for (int i = 0; i < 32; ++i) { const int kk = 2 * i + (lane >> 5); scr[kk * 33 + (lane & 31)] = W[(size_t)(k0 + kk) * N + n0 + (lane & 31)]; }
    LDS_WAIT(); asm volatile("" ::: "memory");
    const int c = lane & 7;
#pragma unroll
    for (int j = 0; j < 4; ++j) { const int n = (lane >> 3) + 8 * j; const LAS float* s = scr + (8 * c) * 33 + n; const int ng = n0 + n;
        const int dst = (kind == 1) ? map_in0(ng) : (kind == 2) ? off + 256 * (ng >> 7) + (ng & 127) : off + ng;
        u32x4 o; o.x = cvt_pk_bf16(s[0 * 33], s[1 * 33]); o.y = cvt_pk_bf16(s[2 * 33], s[3 * 33]); o.z = cvt_pk_bf16(s[4 * 33], s[5 * 33]); o.w = cvt_pk_bf16(s[6 * 33], s[7 * 33]);
        *(u32x4*)(WT + (size_t)dst * K + k0 + 8 * c) = o; }
    LDS_WAIT(); asm volatile("" ::: "memory");
}
__device__ __forceinline__ void p0_prologue(const Args& a, LAS unsigned char* lds, int tid, int lane, int wave, int vcu, int G) {
    unsigned char* ws = a.ws;
    for (int unit = blockIdx.x; unit < 192; unit += G) {
        LAS float* sc = (LAS float*)lds;
        LAS float* red = (LAS float*)(lds + 36864);
        for (int idx = tid; idx < 9 * 1024; idx += 512) { const int r = idx >> 10, k = idx & 1023; const float v = (r < 8) ? a.in[I_C][r * 1024 + k] : a.in[I_CCTX][k]; sc[idx] = silu_f(v); }
        __syncthreads();
        const int l = unit / 96, nb = unit % 96, n = nb * 64 + lane;
        const float* Wm = a.in[I_MODW] + (size_t)l * 1024 * 6144 + n;
        float acc[9];
#pragma unroll
        for (int r = 0; r < 9; ++r) acc[r] = 0.f;
        for (int k = wave * 128; k < wave * 128 + 128; k += 4) {
            float w4[4];
#pragma unroll
            for (int q = 0; q < 4; ++q) w4[q] = Wm[(size_t)(k + q) * 6144];
#pragma unroll
            for (int r = 0; r < 9; ++r) { const f32x4 s4 = *(const LAS f32x4*)(sc + r * 1024 + k); acc[r] += s4[0] * w4[0] + s4[1] * w4[1] + s4[2] * w4[2] + s4[3] * w4[3]; }
        }
#pragma unroll
        for (int r = 0; r < 9; ++r) red[(wave * 9 + r) * 64 + lane] = acc[r];
        __syncthreads();
        for (int idx = tid; idx < 9 * 64; idx += 512) { const int r = idx >> 6, ln = idx & 63; float s = a.in[I_MODB][l * 6144 + nb * 64 + ln];
#pragma unroll
            for (int w = 0; w < 8; ++w) s += red[(w * 9 + r) * 64 + ln];
            ((float*)(ws + WS_MOD))[(size_t)(l * 9 + r) * 6144 + nb * 64 + ln] = s; }
        __syncthreads();
    }
    LAS float* scr = (LAS float*)(lds + wave * 16384);
    const int gw = vcu * NWAVES + wave, NGW = G * NWAVES;
    constexpr int I0 = 16 * 40, I1 = 16 * 32, I2 = 16 * 80, I3 = 16 * 32, IGU = 128, IDN = 128, IPL = 8;
    constexpr int E0 = I0, E1 = E0 + I1, E2 = E1 + I2, E3 = E2 + I3, E4 = E3 + 32 * IGU, E5 = E4 + 32 * IGU, E6 = E5 + 32 * IDN, E7 = E6 + 4 * IPL;
    for (int it = gw; it < E7; it += NGW) {
        if (it < E0) p0_transpose_item(a.in[I_EWIN], 1024, 1280, (bf16_t*)(ws + WS_WIN0), 1, 0, scr, it, lane);
        else if (it < E1) p0_transpose_item(a.in[I_EWOUT], 1024, 1024, (bf16_t*)(ws + WS_WOUT0), 0, 0, scr, it - E0, lane);
        else if (it < E2) p0_transpose_item(a.in[I_OWIN], 1024, 2560, (bf16_t*)(ws + WS_WIN1), 0, 0, scr, it - E1, lane);
        else if (it < E3) p0_transpose_item(a.in[I_OWOUT], 1024, 1024, (bf16_t*)(ws + WS_WOUT1), 0, 0, scr, it - E2, lane);
        else if (it < E4) { const int r = it - E3, le = r / IGU;
            p0_transpose_item(a.in[I_WG] + (size_t)le * 1024 * 256, 1024, 256, (bf16_t*)(ws + WS_WGU) + (size_t)(le >> 4) * 8192 * 1024, 2, (le & 15) * 512, scr, r % IGU, lane); }
        else if (it < E5) { const int r = it - E4, le = r / IGU;
            p0_transpose_item(a.in[I_WU] + (size_t)le * 1024 * 256, 1024, 256, (bf16_t*)(ws + WS_WGU) + (size_t)(le >> 4) * 8192 * 1024, 2, (le & 15) * 512 + 128, scr, r % IGU, lane); }
        else if (it < E6) { const int r = it - E5, le = r / IDN;
            p0_transpose_item(a.in[I_WD] + (size_t)le * 256 * 1024, 256, 1024, (bf16_t*)(ws + WS_WDN) + (size_t)(le >> 4) * 16384 * 256, 0, (le & 15) * 1024, scr, r % IDN, lane); }
        else { const int r = it - E6, g = r / IPL;
            p0_transpose_item(a.in[I_POOLW] + (size_t)g * 128 * 128, 128, 128, (bf16_t*)(ws + WS_WPOOL), 0, g * 128, scr, r % IPL, lane); }
    }
    for (int idx = gw * 64 + lane; idx < 4 * 128 * 128; idx += NGW * 64) { const int x = idx & 15; const int q = (x & 3) + 8 * ((x >> 2) & 1) + 4 * (x >> 3);
        const float v = a.in[I_SGW][(idx & ~15) + q]; ((bf16_t*)(ws + WS_WSG))[idx] = (bf16_t)(cvt_pk_bf16(v, 0.f) & 0xffffu); }
}

__device__ __forceinline__ void load_vec16(const float* p, int lane, f32x4 (&v)[4]) {
#pragma unroll
    for (int j = 0; j < 2; ++j)
#pragma unroll
        for (int q = 0; q < 2; ++q) v[2 * j + q] = *(const f32x4*)(p + 8 * lane + 512 * j + 4 * q);
}
__device__ __forceinline__ void store_row_bf16(bf16_t* p, int lane, const f32x4 (&v)[4]) {
#pragma unroll
    for (int j = 0; j < 2; ++j) { u32x4 w; w.x = cvt_pk_bf16(v[2 * j][0], v[2 * j][1]); w.y = cvt_pk_bf16(v[2 * j][2], v[2 * j][3]); w.z = cvt_pk_bf16(v[2 * j + 1][0], v[2 * j + 1][1]); w.w = cvt_pk_bf16(v[2 * j + 1][2], v[2 * j + 1][3]);
        *(u32x4*)(p + 8 * lane + 512 * j) = w; }
}
__device__ __forceinline__ float sumsq16(const f32x4 (&v)[4]) { float s = 0.f;
#pragma unroll
    for (int i = 0; i < 4; ++i) s += (v[i][0] * v[i][0] + v[i][1] * v[i][1]) + (v[i][2] * v[i][2] + v[i][3] * v[i][3]);
    return s; }
__device__ __forceinline__ void load_mod(const float* mod, const float* gain, int l, int r, int cs, int lane, f32x4 (&gm)[4], f32x4 (&sh)[4]) {
    const float* mr = mod + (size_t)(l * 9 + r) * 6144 + cs * 1024; f32x4 g[4], s[4];
    load_vec16(gain + l * 1024, lane, g); load_vec16(mr + 1024, lane, s); load_vec16(mr, lane, sh);
#pragma unroll
    for (int i = 0; i < 4; ++i) gm[i] = g[i] * (1.0f + s[i]);
}
__device__ __forceinline__ void p1_ln_rows(const Args& a, int lane, int gw, int NGW) {
    const float* mod = (const float*)(a.ws + WS_MOD); bf16_t* AB = (bf16_t*)(a.ws + WS_ABUF);
    const int rpw = (MA + NGW - 1) / NGW, m0 = gw * rpw, m1 = (m0 + rpw < MA) ? m0 + rpw : MA;
    int curb = -1; f32x4 gm[4], sh[4];
    for (int m = m0; m < m1; ++m) {
        const int b = (m < MT) ? (m >> 12) : 8;
        if (b != curb) { load_mod(mod, a.in[I_N1G], 0, b, 0, lane, gm, sh); curb = b; }
        const float* src = (m < MT) ? a.in[I_X] + (size_t)m * 1024 : a.in[I_CTX] + (size_t)(m - MT) * 1024;
        f32x4 v[4]; load_vec16(src, lane, v);
        const float rstd = __builtin_amdgcn_rsqf(wave_sum(sumsq16(v)) * (1.0f / 1024.0f) + EPS);
#pragma unroll
        for (int i = 0; i < 4; ++i) v[i] = v[i] * rstd * gm[i] + sh[i];
        store_row_bf16(AB + (size_t)m * 1024, lane, v);
    }
}
__device__ __forceinline__ void copy_rows(const float* src, float* dst, int lane, int gw, int NGW) {
    for (int m = gw; m < MT; m += NGW) { f32x4 v[4]; load_vec16(src + (size_t)m * 1024, lane, v);
#pragma unroll
        for (int j = 0; j < 2; ++j)
#pragma unroll
            for (int q = 0; q < 2; ++q) *(f32x4*)(dst + (size_t)m * 1024 + 8 * lane + 512 * j + 4 * q) = v[2 * j + q]; }
}

__device__ __forceinline__ void pool_task(int rb, int g, const bf16_t* P, const bf16_t* Wp, const float* pscale, bf16_t* A2, int lane) {
    const int r = lane & 31, hh = lane >> 5;
    const int m0 = rb * 32, b = m0 >> 12, t = (m0 & 4095) + r;
    const int half = 1 << g;
    const int lo = (t - half > 0) ? t - half : 0, hi = (t + half < SEQ) ? t + half : SEQ;
    const float invc = 1.0f / (float)(hi - lo);
    const bf16_t* Pb = P + (size_t)b * SEQ * 512 + g * 128 + 8 * hh;
    float sum[8][8];
#pragma unroll
    for (int s = 0; s < 8; ++s)
#pragma unroll
        for (int j = 0; j < 8; ++j) sum[s][j] = 0.f;
    for (int d = -half; d < half; ++d) {
        const int tt = t + d; const bool ok = (tt >= 0) && (tt < SEQ); const int tc = ok ? tt : t;
        const float msk = ok ? 1.0f : 0.0f;
#pragma unroll
        for (int s = 0; s < 8; ++s) { const u32x4 w = *(const u32x4*)(Pb + (size_t)tc * 512 + 16 * s);
            sum[s][0] += msk * bf_lo(w.x); sum[s][1] += msk * bf_hi(w.x); sum[s][2] += msk * bf_lo(w.y); sum[s][3] += msk * bf_hi(w.y);
            sum[s][4] += msk * bf_lo(w.z); sum[s][5] += msk * bf_hi(w.z); sum[s][6] += msk * bf_lo(w.w); sum[s][7] += msk * bf_hi(w.w); }
    }
    bf16x8 afrag[8];
#pragma unroll
    for (int s = 0; s < 8; ++s) { const u32x4 w = *(const u32x4*)(Pb + (size_t)t * 512 + 16 * s);
        u32x4 o; o.x = cvt_pk_bf16(sum[s][0] * invc - bf_lo(w.x), sum[s][1] * invc - bf_hi(w.x)); o.y = cvt_pk_bf16(sum[s][2] * invc - bf_lo(w.y), sum[s][3] * invc - bf_hi(w.y));
        o.z = cvt_pk_bf16(sum[s][4] * invc - bf_lo(w.z), sum[s][5] * invc - bf_hi(w.z)); o.w = cvt_pk_bf16(sum[s][6] * invc - bf_lo(w.w), sum[s][7] * invc - bf_hi(w.w));
        afrag[s] = __builtin_bit_cast(bf16x8, o); }
    bf16_t* orow = A2 + (size_t)(m0 + r) * 1024 + 512 + g * 128;
#pragma unroll
    for (int nb = 0; nb < 4; ++nb) {
        f32x16 acc = f32x16{};
#pragma unroll
        for (int s = 0; s < 8; ++s) { const bf16x8 bfr = *(const bf16x8*)(Wp + (size_t)(g * 128 + 32 * nb + r) * 128 + 16 * s + 8 * hh);
            acc = __builtin_amdgcn_mfma_f32_32x32x16_bf16(bfr, afrag[s], acc, 0, 0, 0); }
#pragma unroll
        for (int rg = 0; rg < 4; ++rg) { const int n = 32 * nb + 8 * rg + 4 * hh; const f32x4 ps = *(const f32x4*)(pscale + g * 128 + n);
            u32x2 w; w.x = cvt_pk_bf16(acc[4 * rg] * ps[0], acc[4 * rg + 1] * ps[1]); w.y = cvt_pk_bf16(acc[4 * rg + 2] * ps[2], acc[4 * rg + 3] * ps[3]);
            *(u32x2*)(orow + n) = w; }
    }
}

template <int N> __device__ __forceinline__ void halve(float (&v)[80], int mask, bool upper) {
#pragma unroll
    for (int i = 0; i < N / 2; ++i) { const float send = upper ? v[i] : v[i + N / 2]; const float keep = upper ? v[i + N / 2] : v[i]; v[i] = keep + __shfl_xor(send, mask); }
}
__device__ __forceinline__ void router_phase(const Args& a, int l, LAS unsigned char* lds, int tid, int lane_unused, int wave, int G) {
    unsigned char* ws = a.ws;
    const float* H = (const float*)(ws + WS_H); bf16_t* T = (bf16_t*)(ws + WS_ABUF); const float* mod = (const float*)(ws + WS_MOD);
    LAS float* WL = (LAS float*)lds;
    LAS float* LOG = (LAS float*)(lds + 81920) + wave * 16 * 20;
    LAS int* REC_E = (LAS int*)(lds + 92160); LAS int* REC_P = REC_E + 256; LAS float* REC_W = (LAS float*)(REC_P + 256);
    LAS int* CNT = (LAS int*)(lds + 95232); LAS int* GBASE = CNT + 16;
    const float* rgw = a.in[I_RGW] + (size_t)l * 1024 * 4; const float* rew = a.in[I_REW] + (size_t)l * 1024 * 16;
    for (int idx = tid; idx < 20480; idx += 512) { const int q = idx & 3, ln = (idx >> 2) & 63, rest = idx >> 8, kk = rest % 5, cc = (rest / 5) % 8, jp = rest / 40;
        const int col = 8 * ln + 512 * jp + cc, o = 4 * kk + q; WL[idx] = (o < 4) ? rgw[col * 4 + o] : rew[col * 16 + (o - 4)]; }
    if (tid < 16) CNT[tid] = 0;
    __syncthreads();
    unsigned* counts = (unsigned*)(ws + WS_CTL) + CW_CNT + 64 * l;
    int* rt_e = (int*)(ws + RT_E); int* rt_p = (int*)(ws + RT_POS); float* rt_w = (float*)(ws + RT_W); int* list = (int*)(ws + RT_LIST);
    for (int blk = blockIdx.x; blk < MT / 128; blk += G) {
        const int tok0 = blk * 128 + wave * 16, b = (blk * 128) >> 12;
#pragma unroll 1
        for (int grp = 0; grp < 8; ++grp) {
            const int lane = opaque_tid() & 63;
            f32x4 hv[2][4];
#pragma unroll
            for (int tk = 0; tk < 2; ++tk) load_vec16(H + (size_t)(tok0 + grp * 2 + tk) * 1024, lane, hv[tk]);
            {   f32x4 gm[4], sh[4]; load_mod(mod, a.in[I_N2G], l, b, 3, lane, gm, sh);
#pragma unroll
                for (int tk = 0; tk < 2; ++tk) { const float rstd = __builtin_amdgcn_rsqf(wave_sum(sumsq16(hv[tk])) * (1.0f / 1024.0f) + EPS);
#pragma unroll
                    for (int i = 0; i < 4; ++i) hv[tk][i] = hv[tk][i] * rstd * gm[i] + sh[i];
                    store_row_bf16(T + (size_t)(tok0 + grp * 2 + tk) * 1024, lane, hv[tk]); } }
            float acc[80];
#pragma unroll
            for (int i = 0; i < 40; ++i) acc[i] = 0.f;
#pragma unroll
            for (int jp = 0; jp < 2; ++jp)
#pragma unroll
                for (int cc = 0; cc < 8; ++cc)
#pragma unroll
                    for (int kk = 0; kk < 5; ++kk) { const f32x4 w4 = *(const LAS f32x4*)(WL + (((jp * 8 + cc) * 5 + kk) * 64 + lane) * 4);
#pragma unroll
                        for (int tk = 0; tk < 2; ++tk) { const float tv = hv[tk][2 * jp + (cc >> 2)][cc & 3];
#pragma unroll
                            for (int q = 0; q < 4; ++q) acc[tk * 20 + 4 * kk + q] += tv * w4[q]; } }
            halve<40>(acc, 32, (lane & 32) != 0); halve<20>(acc, 16, (lane & 16) != 0); halve<10>(acc, 8, (lane & 8) != 0);
#pragma unroll
            for (int i = 0; i < 5; ++i) { acc[i] += __shfl_xor(acc[i], 4); acc[i] += __shfl_xor(acc[i], 2); acc[i] += __shfl_xor(acc[i], 1); }
            if ((lane & 7) == 0) { const int tk = (lane >> 5) & 1, o0 = 10 * ((lane >> 4) & 1) + 5 * ((lane >> 3) & 1);
#pragma unroll
                for (int i = 0; i < 5; ++i) LOG[(grp * 2 + tk) * 20 + o0 + i] = acc[i]; }
        }
        LDS_WAIT(); asm volatile("" ::: "memory");
        const int lane = opaque_tid() & 63, tid = opaque_tid();
        if (lane < 16) {
            const LAS float* lg = LOG + lane * 20; const float* rgb = a.in[I_RGB] + l * 4; const float* reb = a.in[I_REB] + l * 16;
            float gl[4];
#pragma unroll
            for (int j = 0; j < 4; ++j) gl[j] = lg[j] + rgb[j];
            int gi = 0; float gmx = gl[0];
#pragma unroll
            for (int j = 1; j < 4; ++j) if (gl[j] > gmx) { gmx = gl[j]; gi = j; }
            float gs = 0.f;
#pragma unroll
            for (int j = 0; j < 4; ++j) gs += __expf(gl[j] - gmx);
            const float gp = 1.0f / gs;
            float el[4];
#pragma unroll
            for (int j = 0; j < 4; ++j) el[j] = lg[4 + gi * 4 + j] + reb[gi * 4 + j];
            int i1 = 0; float m1 = el[0];
#pragma unroll
            for (int j = 1; j < 4; ++j) if (el[j] > m1) { m1 = el[j]; i1 = j; }
            int i2 = -1; float m2 = -3.0e38f;
#pragma unroll
            for (int j = 0; j < 4; ++j) if (j != i1 && el[j] > m2) { m2 = el[j]; i2 = j; }
            const float ex = __expf(m2 - m1), den = 1.0f / (1.0f + ex);
            const int e1 = gi * 4 + i1, e2 = gi * 4 + i2; const int tl = wave * 16 + lane;
            REC_E[tl * 2] = e1; REC_E[tl * 2 + 1] = e2; REC_W[tl * 2] = gp * den; REC_W[tl * 2 + 1] = gp * ex * den;
            REC_P[tl * 2] = __hip_atomic_fetch_add(CNT + e1, 1, __ATOMIC_RELAXED, __HIP_MEMORY_SCOPE_WORKGROUP);
            REC_P[tl * 2 + 1] = __hip_atomic_fetch_add(CNT + e2, 1, __ATOMIC_RELAXED, __HIP_MEMORY_SCOPE_WORKGROUP);
        }
        __syncthreads();
        if (tid < 16) { GBASE[tid] = (int)__hip_atomic_fetch_add(counts + tid, (unsigned)CNT[tid], __ATOMIC_RELAXED, __HIP_MEMORY_SCOPE_AGENT); }
        __syncthreads();
        if (tid < 256) { const int e = REC_E[tid], pos = GBASE[e] + REC_P[tid]; const int token = blk * 128 + (tid >> 1);
            rt_e[token * 2 + (tid & 1)] = e; rt_p[token * 2 + (tid & 1)] = pos; rt_w[token * 2 + (tid & 1)] = REC_W[tid]; list[e * LISTCAP + pos] = token; }
        if (tid < 16) CNT[tid] = 0;
        __syncthreads();
    }
}
__device__ __forceinline__ void build_tp(const Args& a, int l, LAS unsigned char* lds, int tid) {
    volatile LAS int* tp = (volatile LAS int*)(lds + TP_OFF);
    if (tid == 0) { const unsigned* counts = (const unsigned*)(a.ws + WS_CTL) + CW_CNT + 64 * l; int acc = 0;
        for (int e = 0; e < 16; ++e) { const int c = (int)__hip_atomic_load(counts + e, __ATOMIC_RELAXED, __HIP_MEMORY_SCOPE_AGENT); tp[e] = acc; tp[17 + e] = c; acc += (c + 255) >> 8; }
        tp[16] = acc; }
    __syncthreads();
}
template <bool FINAL> __device__ __forceinline__ void combine_phase(const Args& a, int l, LAS unsigned char* lds, int lane, int gw, int NGW) {
    unsigned char* ws = a.ws; const float* mod = (const float*)(ws + WS_MOD);
    float* H = (float*)(ws + WS_H); const bf16_t* Y = (const bf16_t*)(ws + WS_RGN); bf16_t* AB = (bf16_t*)(ws + WS_ABUF);
    const int* rt_e = (const int*)(ws + RT_E); const int* rt_p = (const int*)(ws + RT_POS); const float* rt_w = (const float*)(ws + RT_W);
    const volatile LAS int* tp = (const volatile LAS int*)(lds + TP_OFF);
    const int rpw = (MT + NGW - 1) / NGW, m0 = gw * rpw, m1 = (m0 + rpw < MT) ? m0 + rpw : MT;
    int curb = -1; f32x4 g2[4], gm[4], sh[4];
    for (int m = m0; m < m1; ++m) {
        const int b = m >> 12;
        if (b != curb) { load_vec16(mod + (size_t)(l * 9 + b) * 6144 + 5 * 1024, lane, g2); if (!FINAL) load_mod(mod, a.in[I_N1G], 1, b, 0, lane, gm, sh); curb = b; }
        const int e0 = rt_e[m * 2], e1 = rt_e[m * 2 + 1]; const float w0 = rt_w[m * 2], w1 = rt_w[m * 2 + 1];
        const size_t s0 = (size_t)(tp[e0] * 256 + rt_p[m * 2]), s1 = (size_t)(tp[e1] * 256 + rt_p[m * 2 + 1]);
        f32x4 hv[4]; load_vec16(H + (size_t)m * 1024, lane, hv);
#pragma unroll
        for (int j = 0; j < 2; ++j) { const u32x4 ya = *(const u32x4*)(Y + s0 * 1024 + 8 * lane + 512 * j), yb = *(const u32x4*)(Y + s1 * 1024 + 8 * lane + 512 * j);
            f32x4 m0v = {w0 * bf_lo(ya.x) + w1 * bf_lo(yb.x), w0 * bf_hi(ya.x) + w1 * bf_hi(yb.x), w0 * bf_lo(ya.y) + w1 * bf_lo(yb.y), w0 * bf_hi(ya.y) + w1 * bf_hi(yb.y)};
            f32x4 m1v = {w0 * bf_lo(ya.z) + w1 * bf_lo(yb.z), w0 * bf_hi(ya.z) + w1 * bf_hi(yb.z), w0 * bf_lo(ya.w) + w1 * bf_lo(yb.w), w0 * bf_hi(ya.w) + w1 * bf_hi(yb.w)};
            hv[2 * j] = hv[2 * j] + g2[2 * j] * m0v; hv[2 * j + 1] = hv[2 * j + 1] + g2[2 * j + 1] * m1v; }
        float* dst = FINAL ? a.out + (size_t)m * 1024 : H + (size_t)m * 1024;
#pragma unroll
        for (int j = 0; j < 2; ++j)
#pragma unroll
            for (int q = 0; q < 2; ++q) *(f32x4*)(dst + 8 * lane + 512 * j + 4 * q) = hv[2 * j + q];
        if (!FINAL) { const float rstd = __builtin_amdgcn_rsqf(wave_sum(sumsq16(hv)) * (1.0f / 1024.0f) + EPS);
#pragma unroll
            for (int i = 0; i < 4; ++i) hv[i] = hv[i] * rstd * gm[i] + sh[i];
            store_row_bf16(AB + (size_t)m * 1024, lane, hv); }
    }
}

__device__ __forceinline__ void sgconv_phase(const Args& a, LAS unsigned char* lds, int tid, int lane, int wave, int G) {
    unsigned char* ws = a.ws; const bf16_t* UV = (const bf16_t*)(ws + WS_RGN); bf16_t* MIX = (bf16_t*)(ws + WS_ABUF); const bf16_t* WSG = (const bf16_t*)(ws + WS_WSG);
    const int r32 = lane & 31, hi = lane >> 5;
    for (int blk = blockIdx.x; blk < MT / 128; blk += G) {
        const int tok0 = blk * 128;
        {
            const int g = wave >> 1, ch = lane & 15; float gn[8];
#pragma unroll
            for (int j = 0; j < 8; ++j) gn[j] = a.in[I_SGG][g * 128 + 8 * ch + j];
#pragma unroll 4
            for (int it = 0; it < 16; ++it) { const int q = 64 * (wave & 1) + 4 * it + (lane >> 4);
                const u32x4 w = *(const u32x4*)(UV + (size_t)(tok0 + q) * 2560 + 512 + g * 128 + 8 * ch);
                float v[8] = {bf_lo(w.x), bf_hi(w.x), bf_lo(w.y), bf_hi(w.y), bf_lo(w.z), bf_hi(w.z), bf_lo(w.w), bf_hi(w.w)};
                float ss = 0.f;
#pragma unroll
                for (int j = 0; j < 8; ++j) ss += v[j] * v[j];
                ss += __shfl_xor(ss, 1); ss += __shfl_xor(ss, 2); ss += __shfl_xor(ss, 4); ss += __shfl_xor(ss, 8);
                const float rstd = __builtin_amdgcn_rsqf(ss * (1.0f / 128.0f) + EPS);
                u32x4 o; o.x = cvt_pk_bf16(v[0] * rstd * gn[0], v[1] * rstd * gn[1]); o.y = cvt_pk_bf16(v[2] * rstd * gn[2], v[3] * rstd * gn[3]);
                o.z = cvt_pk_bf16(v[4] * rstd * gn[4], v[5] * rstd * gn[5]); o.w = cvt_pk_bf16(v[6] * rstd * gn[6], v[7] * rstd * gn[7]);
                *(LAS u32x4*)(lds + g * 32768 + (ch >> 2) * 8192 + q * 64 + (ch & 3) * 16) = o; }
        }
        __syncthreads();
        {
            const int g = wave >> 1, ph = wave & 1;
            f32x16 acc[2][4];
#pragma unroll
            for (int pb = 0; pb < 2; ++pb)
#pragma unroll
                for (int cb = 0; cb < 4; ++cb) acc[pb][cb] = f32x16{};
            const LAS unsigned char* vbase = lds + g * 32768 + ((lane >> 4) & 1) * 32 + (lane & 3) * 8 + (4 * hi + ((lane & 15) >> 2)) * 64;
#pragma unroll 2
            for (int s = 0; s < 8; ++s) {
                bf16x8 wf[2];
#pragma unroll
                for (int pb = 0; pb < 2; ++pb) wf[pb] = *(const bf16x8*)(WSG + (size_t)(g * 128 + 64 * ph + 32 * pb + r32) * 128 + 16 * s + 8 * hi);
#pragma unroll
                for (int cb = 0; cb < 4; ++cb) {
                    const s16x4 lo = attn_body::vtr((attn_body::lds_cptr)(vbase + cb * 8192 + s * 1024)), hh = attn_body::vtr((attn_body::lds_cptr)(vbase + cb * 8192 + s * 1024 + 512));
                    const bf16x8 vf = (bf16x8){lo[0], lo[1], lo[2], lo[3], hh[0], hh[1], hh[2], hh[3]};
#pragma unroll
                    for (int pb = 0; pb < 2; ++pb) acc[pb][cb] = __builtin_amdgcn_mfma_f32_32x32x16_bf16(vf, wf[pb], acc[pb][cb], 0, 0, 0);
                }
            }
#pragma unroll
            for (int pb = 0; pb < 2; ++pb) { const int p = 64 * ph + 32 * pb + r32; const float bias = a.in[I_SGB][g * 128 + p];
                const bf16_t* urow = UV + (size_t)(tok0 + p) * 2560 + g * 128; bf16_t* orow = MIX + (size_t)(tok0 + p) * 1024 + g * 128;
#pragma unroll
                for (int cb = 0; cb < 4; ++cb)
#pragma unroll
                    for (int rg = 0; rg < 4; ++rg) { const int c0 = 32 * cb + 8 * rg + 4 * hi; const u32x2 uu = *(const u32x2*)(urow + c0);
                        u32x2 w; w.x = cvt_pk_bf16(bf_lo(uu.x) * (acc[pb][cb][4 * rg] + bias), bf_hi(uu.x) * (acc[pb][cb][4 * rg + 1] + bias));
                        w.y = cvt_pk_bf16(bf_lo(uu.y) * (acc[pb][cb][4 * rg + 2] + bias), bf_hi(uu.y) * (acc[pb][cb][4 * rg + 3] + bias));
                        *(u32x2*)(orow + c0) = w; } }
        }
        {
            float cw[3][8];
#pragma unroll
            for (int k = 0; k < 3; ++k)
#pragma unroll
                for (int j = 0; j < 8; ++j) cw[k][j] = a.in[I_CONVW][k * 512 + 8 * lane + j];
            auto zrow = [&](int tok, float (&z)[8]) { const u32x4 hx = *(const u32x4*)(UV + (size_t)tok * 2560 + 1024 + 8 * lane), cg = *(const u32x4*)(UV + (size_t)tok * 2560 + 2048 + 8 * lane);
                z[0] = bf_lo(hx.x) * bf_lo(cg.x); z[1] = bf_hi(hx.x) * bf_hi(cg.x); z[2] = bf_lo(hx.y) * bf_lo(cg.y); z[3] = bf_hi(hx.y) * bf_hi(cg.y);
                z[4] = bf_lo(hx.z) * bf_lo(cg.z); z[5] = bf_hi(hx.z) * bf_hi(cg.z); z[6] = bf_lo(hx.w) * bf_lo(cg.w); z[7] = bf_hi(hx.w) * bf_hi(cg.w); };
            const int t0 = tok0 + wave * 16; float zp[8], zc[8], zn[8];
            if ((t0 & 4095) == 0) {
#pragma unroll
                for (int j = 0; j < 8; ++j) zp[j] = 0.f; } else zrow(t0 - 1, zp);
            zrow(t0, zc);
#pragma unroll 1
            for (int i = 0; i < 16; ++i) { const int tok = t0 + i;
                if ((tok & 4095) == 4095) {
#pragma unroll
                    for (int j = 0; j < 8; ++j) zn[j] = 0.f; } else zrow(tok + 1, zn);
                const u32x4 bg = *(const u32x4*)(UV + (size_t)tok * 2560 + 1536 + 8 * lane);
                const float bgv[8] = {bf_lo(bg.x), bf_hi(bg.x), bf_lo(bg.y), bf_hi(bg.y), bf_lo(bg.z), bf_hi(bg.z), bf_lo(bg.w), bf_hi(bg.w)};
                float y[8];
#pragma unroll
                for (int j = 0; j < 8; ++j) y[j] = bgv[j] * (cw[0][j] * zp[j] + cw[1][j] * zc[j] + cw[2][j] * zn[j]);
                u32x4 o; o.x = cvt_pk_bf16(y[0], y[1]); o.y = cvt_pk_bf16(y[2], y[3]); o.z = cvt_pk_bf16(y[4], y[5]); o.w = cvt_pk_bf16(y[6], y[7]);
                *(u32x4*)(MIX + (size_t)tok * 1024 + 512 + 8 * lane) = o;
#pragma unroll
                for (int j = 0; j < 8; ++j) { zp[j] = zc[j]; zc[j] = zn[j]; } }
        }
        __syncthreads();
    }
}

__global__ void __launch_bounds__(NWAVES * 64, 2) mk_fwd(Args a) {
    extern __shared__ __attribute__((aligned(16))) unsigned char lds_raw[];
    LAS unsigned char* lds = (LAS unsigned char*)lds_raw;
    const int tid0 = threadIdx.x, wave = __builtin_amdgcn_readfirstlane(tid0 >> 6);
#define tid opaque_tid()
#define lane (opaque_tid() & 63)
    const int G = gridDim.x; const int bx = blockIdx.x; const int vcu = (G % 8 == 0) ? (bx % 8) * (G / 8) + bx / 8 : bx;
    const int gw = vcu * NWAVES + wave, NGW = G * NWAVES;
    unsigned char* ws = a.ws;
    for (int u = tid0; u < (LDS_BYTES - LDSCTL_OFF) / 4; u += NWAVES * 64) ((LAS unsigned*)(lds + LDSCTL_OFF))[u] = 0u;
    __syncthreads();
    volatile LAS unsigned* MISC = (volatile LAS unsigned*)(lds + MISC_OFF);
    XcdBarrier bar = xcd_barrier_post((unsigned*)(ws + WS_CTL) + CW_BAR, MISC + 8);
#define GRID_BAR() xcd_barrier(bar)
    const float* mod = (const float*)(ws + WS_MOD);
    float* H = (float*)(ws + WS_H);
    bf16_t* ABUF = (bf16_t*)(ws + WS_ABUF);

    PH(0) p0_prologue(a, lds, tid, lane, wave, vcu, G);
    GRID_BAR();
#if MK_STAGE == 0
    copy_rows(a.in[I_X], a.out, lane, gw, NGW); return;
#endif
    PH(1) p1_ln_rows(a, lane, gw, NGW);
    GRID_BAR();
    PH(2) {   pg8::SchedInProj0 S{G, vcu};
        pg8::EpiQKV E{(bf16_t*)(ws + RG_Q), (bf16_t*)(ws + RG_K), (bf16_t*)(ws + RG_V), (bf16_t*)(ws + RG_P), a.in[I_QG], a.in[I_KG]};
        pg8::gemm_phase<pg8::EpiQKV, pg8::SchedInProj0, false>(lds, ABUF, (const bf16_t*)(ws + WS_WIN0), 1024, S, E); }
    GRID_BAR();
    PH(3) {   const int nper = (NB * 8 * (SEQ / 256)) / G;
        for (int i = 0; i < nper; ++i) { const int uidx = vcu * nper + i; const int b = uidx >> 7, rem = uidx & 127, h = rem & 7, qb = rem >> 3;
            attn_body::attn_unit<8>(b, h, qb, (const bf16_t*)(ws + RG_Q), (const bf16_t*)(ws + RG_K), (const bf16_t*)(ws + RG_V), (bf16_t*)(ws + RG_A2), (char*)lds_raw); }
        for (int task = gw; task < (MT / 32) * 4; task += NGW)
            pool_task(task >> 2, task & 3, (const bf16_t*)(ws + RG_P), (const bf16_t*)(ws + WS_WPOOL), a.in[I_POOLS], (bf16_t*)(ws + RG_A2), lane); }
    GRID_BAR();
    PH(4) {   pg8::SchedGrid S{4, 128 * 4, G, vcu};
        pg8::EpiResid E{a.in[I_X], H, mod + 2 * 1024};
        pg8::gemm_phase<pg8::EpiResid, pg8::SchedGrid, false>(lds, (const bf16_t*)(ws + RG_A2), (const bf16_t*)(ws + WS_WOUT0), 1024, S, E); }
    GRID_BAR();
#if MK_STAGE == 1
    copy_rows(H, a.out, lane, gw, NGW); return;
#endif
#if MK_STAGE >= 2
    PH(5) router_phase(a, 0, lds, tid, lane, wave, G);
    GRID_BAR();
    build_tp(a, 0, lds, tid);
    PH(6) {   pg8::SchedMoE S{(const volatile LAS int*)(lds + TP_OFF), (const int*)(ws + RT_LIST), 2, G, vcu, true};
        pg8::EpiGateUp E{(bf16_t*)(ws + WS_ACT)};
        pg8::gemm_phase<pg8::EpiGateUp, pg8::SchedMoE, true>(lds, ABUF, (const bf16_t*)(ws + WS_WGU), 1024, S, E); }
    GRID_BAR();
    PH(7) {   pg8::SchedMoE S{(const volatile LAS int*)(lds + TP_OFF), (const int*)(ws + RT_LIST), 4, G, vcu, false};
        pg8::EpiBf16 E{(bf16_t*)(ws + WS_RGN), 1024, true};
        pg8::gemm_phase<pg8::EpiBf16, pg8::SchedMoE, false>(lds, (const bf16_t*)(ws + WS_ACT), (const bf16_t*)(ws + WS_WDN), 256, S, E); }
    GRID_BAR();
    PH(8) combine_phase<false>(a, 0, lds, lane, gw, NGW);
    GRID_BAR();
#endif
#if MK_STAGE == 2
    copy_rows(H, a.out, lane, gw, NGW); return;
#endif
#if MK_STAGE >= 3
    PH(9) {   pg8::SchedGrid S{10, 128 * 10, G, vcu};
        pg8::EpiBf16 E{(bf16_t*)(ws + WS_RGN), 2560, false};
        pg8::gemm_phase<pg8::EpiBf16, pg8::SchedGrid, false>(lds, ABUF, (const bf16_t*)(ws + WS_WIN1), 1024, S, E); }
    GRID_BAR();
    PH(10) sgconv_phase(a, lds, tid, lane, wave, G);
    GRID_BAR();
    PH(11) {   pg8::SchedGrid S{4, 128 * 4, G, vcu};
        pg8::EpiResid E{H, H, mod + (size_t)9 * 6144 + 2 * 1024};
        pg8::gemm_phase<pg8::EpiResid, pg8::SchedGrid, false>(lds, ABUF, (const bf16_t*)(ws + WS_WOUT1), 1024, S, E); }
    GRID_BAR();
#endif
#if MK_STAGE == 3
    copy_rows(H, a.out, lane, gw, NGW); return;
#endif
#if MK_STAGE >= 4
    router_phase(a, 1, lds, tid, lane, wave, G);
    GRID_BAR();
    build_tp(a, 1, lds, tid);
    {   pg8::SchedMoE S{(const volatile LAS int*)(lds + TP_OFF), (const int*)(ws + RT_LIST), 2, G, vcu, true};
        pg8::EpiGateUp E{(bf16_t*)(ws + WS_ACT)};
        pg8::gemm_phase<pg8::EpiGateUp, pg8::SchedMoE, true>(lds, ABUF, (const bf16_t*)(ws + WS_WGU) + (size_t)8192 * 1024, 1024, S, E); }
    GRID_BAR();
    {   pg8::SchedMoE S{(const volatile LAS int*)(lds + TP_OFF), (const int*)(ws + RT_LIST), 4, G, vcu, false};
        pg8::EpiBf16 E{(bf16_t*)(ws + WS_RGN), 1024, true};
        pg8::gemm_phase<pg8::EpiBf16, pg8::SchedMoE, false>(lds, (const bf16_t*)(ws + WS_ACT), (const bf16_t*)(ws + WS_WDN) + (size_t)16384 * 256, 256, S, E); }
    GRID_BAR();
    combine_phase<true>(a, 1, lds, lane, gw, NGW);
#endif
#undef tid
#undef lane
}

extern "C" void kernel_launch(void* const* d_in, const int* in_sizes, int n_in, void* d_out, int out_size, void* d_ws, size_t ws_size, hipStream_t stream) {
    static int grid = 0;
    if (grid == 0) {
        if (n_in != 27 || out_size != MT * DM || ws_size < WS_END) { fprintf(stderr, "kernel_launch: unexpected problem (n_in %d, out %d, ws %zu)\n", n_in, out_size, ws_size); grid = -1; return; }
        int dev = 0, cus = 0, per_cu = 0;
        if (hipGetDevice(&dev) != hipSuccess || hipDeviceGetAttribute(&cus, hipDeviceAttributeMultiprocessorCount, dev) != hipSuccess) { grid = -1; return; }
        if (hipFuncSetAttribute((const void*)mk_fwd, hipFuncAttributeMaxDynamicSharedMemorySize, LDS_BYTES) != hipSuccess) { fprintf(stderr, "kernel_launch: hipFuncSetAttribute failed\n"); grid = -1; return; }
        if (hipOccupancyMaxActiveBlocksPerMultiprocessor(&per_cu, (const void*)mk_fwd, NWAVES * 64, LDS_BYTES) != hipSuccess || per_cu < 1) { fprintf(stderr, "kernel_launch: occupancy query says %d blocks per CU\n", per_cu); }
        (void)hipGetLastError();
        grid = cus;
    }
    if (grid < 0) return;
    if (hipMemsetAsync((char*)d_ws + WS_CTL, 0, CTL_ZERO_BYTES, stream) != hipSuccess) return;
    Args a{};
    for (int i = 0; i < 27; ++i) a.in[i] = (const float*)d_in[i];
    a.out = (float*)d_out; a.ws = (unsigned char*)d_ws;
    hipLaunchKernelGGL(mk_fwd, dim3(grid), dim3(NWAVES * 64), LDS_BYTES, stream, a);
}
```

```cpp
#include <hip/hip_runtime.h>
#include <cstdio>
#include <cstdint>

#ifndef MK_PH
#define MK_PH 0xffffffffu
#endif
#define PH(n) if constexpr (((MK_PH) >> (n)) & 1u)
#ifndef MK_PROBE
#define MK_PROBE 0u
#endif
#ifndef MK_STAGE
#define MK_STAGE 4
#endif

#define LAS __attribute__((address_space(3)))
#define GAS __attribute__((address_space(1)))
typedef unsigned short bf16_t;
typedef short bf16x8 __attribute__((ext_vector_type(8)));
typedef short s16x4 __attribute__((ext_vector_type(4)));
typedef float f32x2 __attribute__((ext_vector_type(2)));
typedef float f32x4 __attribute__((ext_vector_type(4)));
typedef float f32x16 __attribute__((ext_vector_type(16)));
typedef unsigned u32x2 __attribute__((ext_vector_type(2)));
typedef unsigned u32x4 __attribute__((ext_vector_type(4)));

constexpr int NB = 8, SEQ = 4096, DM = 1024, MT = NB * SEQ, CTX = 256, MC = NB * CTX, MA = MT + MC, NKV = SEQ + CTX;
constexpr int NEXP = 16, DEXP = 256, LISTCAP = MT;
constexpr int SLOT_ROWS = 2 * MT + NEXP * 256;
constexpr float EPS = 1e-6f;
constexpr float C2 = 0.125f * 1.4426950408889634f;

constexpr size_t MiB = 1u << 20;
constexpr size_t WS_CTL = 0, CTL_ZERO_BYTES = 1 * MiB;
constexpr size_t WS_MOD = 1 * MiB;
constexpr size_t WS_WIN0 = 2 * MiB;
constexpr size_t WS_WOUT0 = 5 * MiB;
constexpr size_t WS_WIN1 = 7 * MiB;
constexpr size_t WS_WOUT1 = 12 * MiB;
constexpr size_t WS_WGU = 14 * MiB;
constexpr size_t WS_WDN = 46 * MiB;
constexpr size_t WS_WPOOL = 62 * MiB;
constexpr size_t WS_WSG = 62 * MiB + 512 * 1024;
constexpr size_t WS_ABUF = 64 * MiB;
constexpr size_t WS_H = 132 * MiB;
constexpr size_t WS_ACT = 260 * MiB;
constexpr size_t WS_RGN = 294 * MiB;
constexpr size_t RG_Q = WS_RGN, RG_K = RG_Q + 32 * MiB, RG_V = RG_K + 9 * MiB, RG_P = RG_V + 9 * MiB, RG_A2 = RG_P + 32 * MiB;
constexpr size_t WS_ROUTE = 462 * MiB;
constexpr size_t RT_E = WS_ROUTE, RT_POS = RT_E + 256 * 1024, RT_W = RT_POS + 256 * 1024, RT_LIST = WS_ROUTE + 1 * MiB;
constexpr size_t WS_END = 466 * MiB;
static_assert(RG_A2 + (size_t)MT * 1024 * 2 <= WS_ROUTE && WS_RGN + (size_t)SLOT_ROWS * 1024 * 2 <= WS_ROUTE && WS_RGN + (size_t)MT * 2560 * 2 <= WS_ROUTE, "region map");
static_assert(WS_ACT + (size_t)SLOT_ROWS * 256 * 2 <= WS_RGN && WS_ABUF + (size_t)MA * 1024 * 2 <= WS_H && WS_H + (size_t)MT * 1024 * 4 <= WS_ACT, "ws map");
constexpr int CW_CNT = 64;
constexpr int CW_BAR = 4096;

constexpr int RING_BYTES = 131072;
constexpr int LDSCTL_OFF = RING_BYTES, MISC_OFF = LDSCTL_OFF + 320;
constexpr int LDS_BYTES = 147456;
constexpr int NWAVES = 8;

__device__ __forceinline__ unsigned cvt_pk_bf16(float lo, float hi) { unsigned r; asm volatile("v_cvt_pk_bf16_f32 %0, %1, %2" : "=v"(r) : "v"(lo), "v"(hi)); return r; }
__device__ __forceinline__ float bf_lo(unsigned w) { return __uint_as_float(w << 16); }
__device__ __forceinline__ float bf_hi(unsigned w) { return __uint_as_float(w & 0xffff0000u); }
__device__ __forceinline__ float wave_sum(float v) {
#pragma unroll
    for (int o = 1; o < 64; o <<= 1) v += __shfl_xor(v, o);
    return v;
}
__device__ __forceinline__ float fast_rcp(float x) { return __builtin_amdgcn_rcpf(x); }
__device__ __forceinline__ float silu_f(float v) { return v * fast_rcp(1.f + __builtin_amdgcn_exp2f(-1.4426950408889634f * v)); }

__device__ __forceinline__ int opaque_tid() { int t = threadIdx.x; asm volatile("" : "+v"(t)); return t; }

#define XB_TMO      128
#define XB_XCNT(j)  (256  + 64 * (j))
#define XB_XSUB(j)  (1280 + 64 * (j))
#define XB_XGEN(j)  (2304 + 64 * (j))
#define XB_TOP      3328
#define XB_TOPGEN   3392
#define XCD_BAR_WORDS 3456
#define XB_SPIN_CAP (1u << 18)
__device__ __forceinline__ unsigned xb_ld(unsigned* p)              { return __hip_atomic_load(p, __ATOMIC_RELAXED, __HIP_MEMORY_SCOPE_AGENT); }
__device__ __forceinline__ unsigned xb_add(unsigned* p, unsigned v) { return __hip_atomic_fetch_add(p, v, __ATOMIC_RELAXED, __HIP_MEMORY_SCOPE_AGENT); }
__device__ __forceinline__ unsigned xb_xcc_id() { return (unsigned)__builtin_amdgcn_s_getreg((3 << 11) | 20) & 0xFu; }
#define XB_SPIN(cond, bar) do { unsigned _sp = 0; while (cond) { __builtin_amdgcn_s_sleep(1); \
    if ((++_sp & 255u) == 0u) { if (xb_ld(&(bar)[XB_TMO])) break; if (_sp > XB_SPIN_CAP) { atomicAdd(&(bar)[XB_TMO], 1u); break; } } } } while (0)
struct XcdBarrier { unsigned* bar; unsigned x; volatile LAS unsigned* st; };
__device__ __forceinline__ XcdBarrier xcd_barrier_post(unsigned* bar, volatile LAS unsigned* st) {
    XcdBarrier b; b.bar = bar; b.x = xb_xcc_id(); b.st = st;
    if (threadIdx.x == 0) (void)xb_add(&bar[XB_XCNT(b.x)], 1u);
    return b;
}
__device__ __forceinline__ void xcd_barrier_complete(unsigned* bar, unsigned x, unsigned& nloc, unsigned& nx) {
    const unsigned G = gridDim.x * gridDim.y * gridDim.z;
    unsigned sum, cnt, mine, sp = 0u;
    for (;;) {
        sum = 0u; cnt = 0u; mine = 0u;
#pragma unroll
        for (unsigned j = 0; j < 16; ++j) { const unsigned c = xb_ld(&bar[XB_XCNT(j)]); sum += c; cnt += (c > 0u) ? 1u : 0u; mine = (j == x) ? c : mine; }
        if (sum == G) break;
        __builtin_amdgcn_s_sleep(1);
        if ((++sp & 255u) == 0u) { if (xb_ld(&bar[XB_TMO])) break; if (sp > XB_SPIN_CAP) { atomicAdd(&bar[XB_TMO], 1u); break; } }
    }
    nloc = mine > 0u ? mine : 1u; nx = cnt > 0u ? cnt : 1u;
}
__device__ __forceinline__ void xcd_barrier(const XcdBarrier& b) {
    asm volatile("s_waitcnt vmcnt(0)" ::: "memory");
    __syncthreads();
    if (threadIdx.x == 0) {
        unsigned* bar = b.bar;
        __builtin_amdgcn_s_waitcnt(0);
        unsigned nloc = b.st[0], nx = b.st[1];
        if (nloc == 0u) { xcd_barrier_complete(bar, b.x, nloc, nx); b.st[0] = nloc; b.st[1] = nx; }
        const unsigned old = xb_add(&bar[XB_XSUB(b.x)], 1u);
        const unsigned gen = old / nloc;
        if (old + 1u == (gen + 1u) * nloc) {
            __builtin_amdgcn_fence(__ATOMIC_RELEASE, "agent");
            asm volatile("s_waitcnt vmcnt(0)" ::: "memory");
            const unsigned og = xb_add(&bar[XB_TOP], 1u);
            const unsigned tg = og / nx;
            if (og + 1u == (tg + 1u) * nx) xb_add(&bar[XB_TOPGEN], 1u);
            else XB_SPIN(xb_ld(&bar[XB_TOPGEN]) == tg, bar);
            __builtin_amdgcn_fence(__ATOMIC_ACQUIRE, "agent");
            xb_add(&bar[XB_XGEN(b.x)], 1u);
            asm volatile("s_waitcnt vmcnt(0)" ::: "memory");
        } else {
            XB_SPIN(xb_ld(&bar[XB_XGEN(b.x)]) == gen, bar);
            __builtin_amdgcn_fence(__ATOMIC_ACQUIRE, "agent");
            asm volatile("s_waitcnt vmcnt(0)" ::: "memory");
        }
    }
    __syncthreads();
}

namespace pg8 {
constexpr int BM = 256, BK = 64, HALF = 128, HTB = HALF * BK * 2;
__device__ __forceinline__ int lds_byte(int r, int c) { const int st = (r >> 4) * 2 + (c >> 5), rr = r & 15, cc = c & 31, ob = rr * 64 + cc * 2; return st * 1024 + (ob ^ (((ob >> 9) & 1) << 5)); }
__device__ __forceinline__ void stage_rc(int b, int& R, int& C) { const int st = b / 1024, sb = b % 1024, swz = sb ^ (((sb >> 9) & 1) << 5); R = (st >> 1) * 16 + swz / 64; C = (st & 1) * 32 + (swz % 64) / 2; }
__device__ __forceinline__ int perm32(int rho) { const int n = rho >> 4, i = rho & 15; return 8 * (i >> 2) + 4 * n + (i & 3); }

struct Unit { int pm, pn, aux, e, r; };

template <class Epi, class Sched, bool GATHER>
__device__ __forceinline__ void gemm_phase(LAS unsigned char* lds, const bf16_t* A, const bf16_t* Bt, const int K, const Sched& S, const Epi& E) {
    const int tid = opaque_tid(), wid = __builtin_amdgcn_readfirstlane(tid >> 6), lane = tid & 63, wr = wid >> 2, wc = wid & 3, fr = lane & 15, fq = lane >> 4;
    const int nt = K / BK;
    unsigned voffB[2]; int RA[2], CA[2];
#pragma unroll
    for (int i = 0; i < 2; ++i) { int R, C; stage_rc(tid * 16 + i * 8192, R, C); const int Rb = Epi::PERM ? ((R & ~31) + perm32(R & 31)) : R;
        voffB[i] = (unsigned)(Rb * K + C) * 2u; RA[i] = R; CA[i] = C; }
    const size_t kstep = (size_t)(BK * 2);
    const size_t hstep = (size_t)HALF * K * 2;
    const size_t tstep = 2 * hstep;
    const unsigned ldsw = (unsigned)wid * 1024u;
    const int aoff = lds_byte(wr * 64 + fr, fq * 8), boff = lds_byte(wc * 32 + fr, fq * 8);
#define PG8_SA(b, h) (((b) * 2 + (h)) * HTB)
#define PG8_SB(b, h) ((4 + (b) * 2 + (h)) * HTB)
#define PG8_STAGE(bufoff, gbase, voff) do { _Pragma("unroll") for (int _i = 0; _i < 2; ++_i) \
        __builtin_amdgcn_global_load_lds((const unsigned*)((const char*)(gbase) + (voff)[_i]), (LAS unsigned*)(lds + (bufoff) + ldsw + _i * 8192), 16, 0, 0); } while (0)
#define PG8_LDA(dst, b, h) do { _Pragma("unroll") for (int m = 0; m < 4; ++m) _Pragma("unroll") for (int k = 0; k < 2; ++k) dst[m][k] = *(const LAS bf16x8*)(lds + PG8_SA(b, h) + aoff + m * 2048 + k * 1024); } while (0)
#define PG8_LDB(dst, b, h) do { _Pragma("unroll") for (int n = 0; n < 2; ++n) _Pragma("unroll") for (int k = 0; k < 2; ++k) dst[n][k] = *(const LAS bf16x8*)(lds + PG8_SB(b, h) + boff + n * 2048 + k * 1024); } while (0)
#define PG8_MMA(ai, bj, At, Bt_) do { __builtin_amdgcn_s_setprio(1); _Pragma("unroll") for (int m = 0; m < 4; ++m) _Pragma("unroll") for (int n = 0; n < 2; ++n) _Pragma("unroll") for (int k = 0; k < 2; ++k) \
        acc[ai][bj][m][n] = __builtin_amdgcn_mfma_f32_16x16x32_bf16(Bt_[n][k], At[m][k], acc[ai][bj][m][n], 0, 0, 0); __builtin_amdgcn_s_setprio(0); } while (0)
#define PG8_WAIT_V(n) asm volatile("s_waitcnt vmcnt(" #n ")" ::: "memory")
#define PG8_WAIT_L(n) asm volatile("s_waitcnt lgkmcnt(" #n ")" ::: "memory")
#define PG8_BAR __builtin_amdgcn_s_barrier()
#define PG8_SCHED __builtin_amdgcn_sched_barrier(0)
    Unit cur, nxt; int ui = 0;
    if (!S.next(0, cur)) return;
    unsigned voA[2][2], voN[2][2];
    if constexpr (GATHER) S.rows(cur, RA, CA, K, voA);
    else {
#pragma unroll
        for (int h = 0; h < 2; ++h)
#pragma unroll
            for (int i = 0; i < 2; ++i) voA[h][i] = (unsigned)((h * HALF + RA[i]) * K + CA[i]) * 2u;
    }
    f32x4 acc[2][2][4][2];
#pragma unroll
    for (int a = 0; a < 2; ++a)
#pragma unroll
        for (int b = 0; b < 2; ++b)
#pragma unroll
            for (int m = 0; m < 4; ++m)
#pragma unroll
                for (int n = 0; n < 2; ++n) acc[a][b][m][n] = (f32x4){0.f, 0.f, 0.f, 0.f};
    bf16x8 At[4][2], B0[2][2], B1[2][2];
    const char* cA = GATHER ? (const char*)A : (const char*)A + (size_t)cur.pm * tstep;
    const char* cB = (const char*)Bt + (size_t)cur.pn * tstep;
    PG8_STAGE(PG8_SB(0, 0), cB, voffB); PG8_STAGE(PG8_SB(0, 1), cB + hstep, voffB); PG8_STAGE(PG8_SA(0, 0), cA, voA[0]); PG8_STAGE(PG8_SA(0, 1), cA, voA[1]);
    if (wr == 1) PG8_BAR;
    PG8_WAIT_V(2); PG8_BAR;
    PG8_STAGE(PG8_SB(1, 0), cB + kstep, voffB); PG8_STAGE(PG8_SA(1, 0), cA + kstep, voA[0]); PG8_STAGE(PG8_SB(1, 1), cB + hstep + kstep, voffB);
    PG8_WAIT_V(6); PG8_BAR;
    for (;;) {
        const bool has_next = S.next(ui + 1, nxt);
        const char* nA = cA; const char* nB = cB;
        if (has_next) { nA = GATHER ? (const char*)A : (const char*)A + (size_t)nxt.pm * tstep; nB = (const char*)Bt + (size_t)nxt.pn * tstep; }
        if constexpr (GATHER) {
            if (has_next) S.rows(nxt, RA, CA, K, voN);
            else {
#pragma unroll
                for (int h = 0; h < 2; ++h)
#pragma unroll
                    for (int i = 0; i < 2; ++i) voN[h][i] = voA[h][i];
            }
        }
#pragma unroll 1
        for (int t = 0; t < nt; t += 2) {
            const bool last = (t == nt - 2);
            const char* a1 = cA + (size_t)(t + 1) * kstep;
            const char* a2 = last ? nA : cA + (size_t)(t + 2) * kstep; const char* b2 = last ? nB : cB + (size_t)(t + 2) * kstep;
            const char* a3 = a2 + kstep; const char* b3 = b2 + kstep;
            unsigned sel[2][2];
#pragma unroll
            for (int h = 0; h < 2; ++h)
#pragma unroll
                for (int i = 0; i < 2; ++i) sel[h][i] = (GATHER && last) ? voN[h][i] : voA[h][i];
            PG8_LDB(B0, 0, 0); PG8_LDB(B1, 0, 1); PG8_SCHED; PG8_LDA(At, 0, 0); PG8_STAGE(PG8_SA(1, 1), a1, voA[1]);
            PG8_WAIT_V(8); PG8_WAIT_L(0); PG8_BAR; PG8_MMA(0, 0, At, B0); PG8_MMA(0, 1, At, B1); PG8_BAR; PG8_SCHED;
            PG8_LDA(At, 0, 1); PG8_STAGE(PG8_SB(0, 0), b2, voffB); PG8_STAGE(PG8_SB(0, 1), b2 + hstep, voffB); PG8_STAGE(PG8_SA(0, 0), a2, sel[0]);
            PG8_WAIT_V(8); PG8_WAIT_L(0); PG8_BAR; PG8_MMA(1, 0, At, B0); PG8_MMA(1, 1, At, B1); PG8_BAR; PG8_SCHED;
            PG8_LDB(B0, 1, 0); PG8_LDB(B1, 1, 1); PG8_SCHED; PG8_LDA(At, 1, 0); PG8_STAGE(PG8_SA(0, 1), a2, sel[1]);
            PG8_WAIT_V(8); PG8_WAIT_L(0); PG8_BAR; PG8_MMA(0, 0, At, B0); PG8_MMA(0, 1, At, B1); PG8_BAR; PG8_SCHED;
            PG8_LDA(At, 1, 1); PG8_STAGE(PG8_SB(1, 0), b3, voffB); PG8_STAGE(PG8_SB(1, 1), b3 + hstep, voffB); PG8_STAGE(PG8_SA(1, 0), a3, sel[0]);
            PG8_WAIT_V(8); PG8_WAIT_L(0); PG8_BAR; PG8_MMA(1, 0, At, B0); PG8_MMA(1, 1, At, B1); PG8_BAR; PG8_SCHED;
        }
        if constexpr (Epi::ALIGN) { if (wr == 0) PG8_BAR; }
        E(acc, cur, wr, wc, fr, fq);
        if (!has_next) break;
#pragma unroll
        for (int a = 0; a < 2; ++a)
#pragma unroll
            for (int b = 0; b < 2; ++b)
#pragma unroll
                for (int m = 0; m < 4; ++m)
#pragma unroll
                    for (int n = 0; n < 2; ++n) acc[a][b][m][n] = (f32x4){0.f, 0.f, 0.f, 0.f};
        cur = nxt; cA = nA; cB = nB; ++ui;
        if constexpr (GATHER) {
#pragma unroll
            for (int h = 0; h < 2; ++h)
#pragma unroll
                for (int i = 0; i < 2; ++i) voA[h][i] = voN[h][i];
        }
        if constexpr (Epi::ALIGN) { if (wr == 1) PG8_BAR; }
    }
    PG8_WAIT_V(0);
    if constexpr (!Epi::ALIGN) { if (wr == 0) PG8_BAR; }
    PG8_BAR;
#undef PG8_SA
#undef PG8_SB
#undef PG8_STAGE
#undef PG8_LDA
#undef PG8_LDB
#undef PG8_MMA
#undef PG8_WAIT_V
#undef PG8_WAIT_L
#undef PG8_BAR
#undef PG8_SCHED
}

struct SchedGrid {
    int nN, total, G, c;
    __device__ __forceinline__ bool next(int i, Unit& u) const { const int L = i * G + c; if (L >= total) return false; u.pm = L / nN; u.pn = L % nN; u.aux = u.pn; u.e = 0; u.r = 0; return true; }
};
struct SchedInProj0 {
    int G, c;
    __device__ __forceinline__ bool next(int i, Unit& u) const { const int L = i * G + c; if (L >= 648) return false;
        if (L < 640) { u.pm = L / 5; u.pn = L % 5; } else { u.pm = 128 + (L - 640); u.pn = 2; } u.aux = u.pn; u.e = 0; u.r = 0; return true; }
};
struct SchedMoE {
    const volatile LAS int* tp; const int* list; int ncol, G, c; bool gather;
    __device__ __forceinline__ bool next(int i, Unit& u) const {
        const int L = i * G + c; const int total = tp[16] * ncol; if (L >= total) return false;
        const int rt = L / ncol, pl = L % ncol; int e = 0;
#pragma unroll
        for (int j = 1; j < 16; ++j) e += (rt >= tp[j]) ? 1 : 0;
        e = __builtin_amdgcn_readfirstlane(e);
        u.pm = rt; u.pn = e * ncol + pl; u.aux = pl; u.e = e; u.r = rt - tp[e]; return true;
    }
    __device__ __forceinline__ void rows(const Unit& u, const int (&RA)[2], const int (&CA)[2], int K, unsigned (&vo)[2][2]) const {
        const int cnt = tp[17 + u.e];
#pragma unroll
        for (int h = 0; h < 2; ++h)
#pragma unroll
            for (int i = 0; i < 2; ++i) { const int idx = u.r * 256 + h * HALF + RA[i]; const int tok = (idx < cnt) ? list[u.e * LISTCAP + idx] : 0;
                vo[h][i] = (unsigned)(tok * K + CA[i]) * 2u; }
    }
};

typedef f32x4 Acc[2][2][4][2];
struct EpiBf16 {
    static constexpr bool PERM = true, ALIGN = true;
    bf16_t* O; int ldc; bool use_aux;
    __device__ __forceinline__ void operator()(const Acc& acc, const Unit& u, int wr, int wc, int fr_, int fq_) const {
        int ln_ = fr_ | (fq_ << 4); asm volatile("" : "+v"(ln_)); const int fr = ln_ & 15, fq = ln_ >> 4;
        const int row0 = u.pm * BM + wr * 64 + fr; const int col0 = (use_aux ? u.aux : u.pn) * BM + wc * 32 + 8 * fq;
#pragma unroll
        for (int ai = 0; ai < 2; ++ai)
#pragma unroll
            for (int m = 0; m < 4; ++m) { bf16_t* rowp = O + (size_t)(row0 + ai * HALF + m * 16) * ldc + col0;
#pragma unroll
                for (int bj = 0; bj < 2; ++bj) { const f32x4 v0 = acc[ai][bj][m][0], v1 = acc[ai][bj][m][1];
                    u32x4 w; w.x = cvt_pk_bf16(v0[0], v0[1]); w.y = cvt_pk_bf16(v0[2], v0[3]); w.z = cvt_pk_bf16(v1[0], v1[1]); w.w = cvt_pk_bf16(v1[2], v1[3]);
                    *(u32x4*)(rowp + bj * HALF) = w; } }
    }
};
struct EpiGateUp {
    static constexpr bool PERM = true, ALIGN = true;
    bf16_t* O;
    __device__ __forceinline__ void operator()(const Acc& acc, const Unit& u, int wr, int wc, int fr_, int fq_) const {
        int ln_ = fr_ | (fq_ << 4); asm volatile("" : "+v"(ln_)); const int fr = ln_ & 15, fq = ln_ >> 4;
        const int row0 = u.pm * BM + wr * 64 + fr; const int col0 = u.aux * HALF + wc * 32 + 8 * fq;
#pragma unroll
        for (int ai = 0; ai < 2; ++ai)
#pragma unroll
            for (int m = 0; m < 4; ++m) { bf16_t* rowp = O + (size_t)(row0 + ai * HALF + m * 16) * DEXP + col0;
                float o[8];
#pragma unroll
                for (int n = 0; n < 2; ++n)
#pragma unroll
                    for (int j = 0; j < 4; ++j) o[n * 4 + j] = silu_f(acc[ai][0][m][n][j]) * acc[ai][1][m][n][j];
                u32x4 w; w.x = cvt_pk_bf16(o[0], o[1]); w.y = cvt_pk_bf16(o[2], o[3]); w.z = cvt_pk_bf16(o[4], o[5]); w.w = cvt_pk_bf16(o[6], o[7]);
                *(u32x4*)rowp = w; }
    }
};
struct EpiResid {
    static constexpr bool PERM = false, ALIGN = false;
    const float* Hin; float* Hout; const float* gate;
    __device__ __forceinline__ void operator()(const Acc& acc, const Unit& u, int wr, int wc, int fr_, int fq_) const {
        int ln_ = fr_ | (fq_ << 4); asm volatile("" : "+v"(ln_)); const int fr = ln_ & 15, fq = ln_ >> 4;
        const int b = u.pm >> 4; const int col0 = u.pn * BM + wc * 32 + 4 * fq; const float* gb = gate + (size_t)b * 6144 + col0;
        f32x4 gv[2][2];
#pragma unroll
        for (int bj = 0; bj < 2; ++bj)
#pragma unroll
            for (int n = 0; n < 2; ++n) gv[bj][n] = *(const f32x4*)(gb + bj * HALF + n * 16);
#pragma unroll
        for (int ai = 0; ai < 2; ++ai)
#pragma unroll
            for (int m = 0; m < 4; ++m) { const size_t off = (size_t)(u.pm * BM + ai * HALF + wr * 64 + m * 16 + fr) * DM + col0;
#pragma unroll
                for (int bj = 0; bj < 2; ++bj)
#pragma unroll
                    for (int n = 0; n < 2; ++n) { const f32x4 hv = *(const f32x4*)(Hin + off + bj * HALF + n * 16);
                        *(f32x4*)(Hout + off + bj * HALF + n * 16) = hv + gv[bj][n] * acc[ai][bj][m][n]; } }
    }
};
struct EpiQKV {
    static constexpr bool PERM = true, ALIGN = true;
    bf16_t *Q, *Kb, *Vb, *P; const float *qg, *kg;
    __device__ __forceinline__ void operator()(const Acc& acc, const Unit& u, int wr, int wc, int fr_, int fq_) const {
        int ln_ = fr_ | (fq_ << 4); asm volatile("" : "+v"(ln_)); const int fr = ln_ & 15, fq = ln_ >> 4;
        const int pn = u.pn; const bool isctx = u.pm >= 128;
        const int rloc0 = wr * 64 + fr;
        if (pn >= 3) {
#pragma unroll
            for (int ai = 0; ai < 2; ++ai)
#pragma unroll
                for (int m = 0; m < 4; ++m) { bf16_t* rowp = P + (size_t)(u.pm * BM + rloc0 + ai * HALF + m * 16) * 512 + (pn - 3) * BM + wc * 32 + 8 * fq;
#pragma unroll
                    for (int bj = 0; bj < 2; ++bj) { const f32x4 v0 = acc[ai][bj][m][0], v1 = acc[ai][bj][m][1];
                        u32x4 w; w.x = cvt_pk_bf16(v0[0], v0[1]); w.y = cvt_pk_bf16(v0[2], v0[3]); w.z = cvt_pk_bf16(v1[0], v1[1]); w.w = cvt_pk_bf16(v1[2], v1[3]);
                        *(u32x4*)(rowp + bj * HALF) = w; } }
            return;
        }
        if (pn == 2 && wc >= 2) {
            const int vh = wc - 2;
#pragma unroll
            for (int ai = 0; ai < 2; ++ai)
#pragma unroll
                for (int m = 0; m < 4; ++m) { const int rl = rloc0 + ai * HALF + m * 16; int b, krow;
                    if (isctx) { const int cr = (u.pm - 128) * BM + rl; b = cr >> 8; krow = cr & 255; } else { const int mt = u.pm * BM + rl; b = mt >> 12; krow = CTX + (mt & 4095); }
                    bf16_t* rowp = Vb + ((size_t)(b * 2 + vh) * NKV + krow) * 64 + 8 * fq;
#pragma unroll
                    for (int bj = 0; bj < 2; ++bj) { const f32x4 v0 = acc[ai][bj][m][0], v1 = acc[ai][bj][m][1];
                        u32x4 w; w.x = cvt_pk_bf16(v0[0], v0[1]); w.y = cvt_pk_bf16(v0[2], v0[3]); w.z = cvt_pk_bf16(v1[0], v1[1]); w.w = cvt_pk_bf16(v1[2], v1[3]);
                        *(u32x4*)(rowp + bj * 32) = w; } }
            return;
        }
        const bool isq = pn < 2; const int head = isq ? pn * 4 + wc : wc;
        const float* gsrc = (isq ? qg : kg) + 32 * (fq >> 1) + 8 * (fq & 1);
        float g1[8], g2[8], inv[8];
#pragma unroll
        for (int j = 0; j < 8; ++j) { g1[j] = gsrc[j]; g2[j] = gsrc[16 + j];
            inv[j] = __builtin_amdgcn_exp2f(-(float)(8 * (fq & 1) + j) * (13.287712379549449f / 16.0f)) * 0.15915494309189535f; }
        const float osc = isq ? C2 : 1.0f;
#pragma unroll
        for (int ai = 0; ai < 2; ++ai)
#pragma unroll
            for (int m = 0; m < 4; ++m) {
                const int rl = rloc0 + ai * HALF + m * 16;
                float x1[8], x2[8];
#pragma unroll
                for (int n = 0; n < 2; ++n)
#pragma unroll
                    for (int j = 0; j < 4; ++j) { x1[n * 4 + j] = acc[ai][0][m][n][j]; x2[n * 4 + j] = acc[ai][1][m][n][j]; }
                float ss = 0.f;
#pragma unroll
                for (int j = 0; j < 8; ++j) ss += x1[j] * x1[j] + x2[j] * x2[j];
                ss += __shfl_xor(ss, 16); ss += __shfl_xor(ss, 32);
                const float rstd = __builtin_amdgcn_rsqf(ss * (1.0f / 64.0f) + EPS) * osc;
                int b, krow, mt = 0; float pos = 0.f;
                if (isctx) { const int cr = (u.pm - 128) * BM + rl; b = cr >> 8; krow = cr & 255; }
                else { mt = u.pm * BM + rl; b = mt >> 12; const int t = mt & 4095; krow = CTX + t; pos = (float)((fq >> 1) ? (t & 63) : (t >> 6)); }
                float o1[8], o2[8];
#pragma unroll
                for (int j = 0; j < 8; ++j) { const float y1 = x1[j] * rstd * g1[j], y2 = x2[j] * rstd * g2[j];
                    if (isctx) { o1[j] = y1; o2[j] = y2; }
                    else { const float rev = pos * inv[j]; const float cs = __builtin_amdgcn_cosf(rev), sn = __builtin_amdgcn_sinf(rev);
                        o1[j] = y1 * cs - y2 * sn; o2[j] = y2 * cs + y1 * sn; } }
                bf16_t* rowp = isq ? (Q + (size_t)mt * 512 + head * 64 + 8 * fq) : (Kb + ((size_t)(b * 2 + head) * NKV + krow) * 64 + 8 * fq);
                u32x4 w; w.x = cvt_pk_bf16(o1[0], o1[1]); w.y = cvt_pk_bf16(o1[2], o1[3]); w.z = cvt_pk_bf16(o1[4], o1[5]); w.w = cvt_pk_bf16(o1[6], o1[7]);
                *(u32x4*)rowp = w;
                w.x = cvt_pk_bf16(o2[0], o2[1]); w.y = cvt_pk_bf16(o2[2], o2[3]); w.z = cvt_pk_bf16(o2[4], o2[5]); w.w = cvt_pk_bf16(o2[6], o2[7]);
                *(u32x4*)(rowp + 32) = w;
            }
    }
};
}

namespace attn_body {
constexpr int NW = 8, QBLK = 32, QB = QBLK * NW, KVBLK = 64, NT = NKV / KVBLK;
constexpr int QP = 512, KP = 64, OP = 1024;
static_assert(NT % 2 == 0 && NT >= 8, "tile count");
__device__ __forceinline__ int crow(int r, int hi) { return (r & 3) + 8 * (r >> 2) + 4 * hi; }
#define SBAR() __builtin_amdgcn_sched_barrier(0)
constexpr int NSLOT = 3, SLOTB = 8192;
constexpr int LDS_K = 0, LDS_V = NSLOT * SLOTB, LDS_WS = 2 * NSLOT * SLOTB, LDS_OST = LDS_WS + NW * 64 * 4, ATT_LDS_BYTES = LDS_OST + NW * 4096;
__device__ __forceinline__ void glds16(const void* gsrc, unsigned lds_dst) { unsigned keep;
    asm volatile("s_mov_b32 %0, m0\n\ts_mov_b32 m0, %2\n\ts_nop 0\n\tglobal_load_lds_dwordx4 %1, off\n\ts_mov_b32 m0, %0" : "=&s"(keep) : "v"(gsrc), "s"(lds_dst) : "memory"); }
__device__ __forceinline__ float max3f(float a, float b, float c) { float r; asm("v_max3_f32 %0, %1, %2, %3" : "=v"(r) : "v"(a), "v"(b), "v"(c)); return r; }
__device__ __forceinline__ float max2f(float a, float b) { float r; asm("v_max_f32_e32 %0, %1, %2" : "=v"(r) : "v"(a), "v"(b)); return r; }
__device__ __forceinline__ float fadd_s(float a, float b) { float r; asm("v_add_f32_e32 %0, %1, %2" : "=v"(r) : "v"(a), "v"(b)); return r; }
__device__ __forceinline__ float fsub_s(float a, float b) { float r; asm("v_sub_f32_e32 %0, %1, %2" : "=v"(r) : "v"(a), "v"(b)); return r; }
typedef __bf16 bf16x2_t __attribute__((ext_vector_type(2)));
__device__ __forceinline__ unsigned cvtpk_s(float lo, float hi) { f32x2 v = {lo, hi}; bf16x2_t b = __builtin_convertvector(v, bf16x2_t); return __builtin_bit_cast(unsigned, b); }
#define WAIT_BAR(N) asm volatile("s_waitcnt vmcnt(" #N ") lgkmcnt(0)\n\ts_barrier" ::: "memory")
__device__ __forceinline__ void qkt(f32x16& p0, f32x16& p1, const char* Kslot, const bf16x8* qr, const f32x16& negm, int r32, int hi) {
    const char* kb = Kslot + hi * 1024 + r32 * 16;
#pragma unroll
    for (int d0 = 0; d0 < 4; ++d0) {
        const bf16x8 b0 = *reinterpret_cast<const bf16x8*>(kb + d0 * 2048);
        const bf16x8 b1 = *reinterpret_cast<const bf16x8*>(kb + d0 * 2048 + 512);
        if (d0 == 0) { p0 = __builtin_amdgcn_mfma_f32_32x32x16_bf16(b0, qr[0], negm, 0, 0, 0); p1 = __builtin_amdgcn_mfma_f32_32x32x16_bf16(b1, qr[0], negm, 0, 0, 0); }
        else { p0 = __builtin_amdgcn_mfma_f32_32x32x16_bf16(b0, qr[d0], p0, 0, 0, 0); p1 = __builtin_amdgcn_mfma_f32_32x32x16_bf16(b1, qr[d0], p1, 0, 0, 0); } }
}
typedef __attribute__((address_space(3))) const char* lds_cptr;
typedef short v4i16_t __attribute__((ext_vector_type(4)));
__device__ __forceinline__ void kload8(bf16x8* kf, lds_cptr kp) {
    kf[0] = *(const LAS bf16x8*)(kp);        kf[1] = *(const LAS bf16x8*)(kp + 512);
    kf[2] = *(const LAS bf16x8*)(kp + 2048); kf[3] = *(const LAS bf16x8*)(kp + 2560);
    kf[4] = *(const LAS bf16x8*)(kp + 4096); kf[5] = *(const LAS bf16x8*)(kp + 4608);
    kf[6] = *(const LAS bf16x8*)(kp + 6144); kf[7] = *(const LAS bf16x8*)(kp + 6656);
}
__device__ __forceinline__ void kload2(bf16x8* kf, lds_cptr kp, int j) { kf[2 * j] = *(const LAS bf16x8*)(kp + j * 2048); kf[2 * j + 1] = *(const LAS bf16x8*)(kp + j * 2048 + 512); }
__device__ __forceinline__ s16x4 vtr(lds_cptr p) { return __builtin_bit_cast(s16x4, __builtin_amdgcn_ds_read_tr16_b64_v4i16((LAS v4i16_t*)p)); }
__device__ __forceinline__ float rowmax(const f32x16& p0, const f32x16& p1) {
    float a = max3f(p0[0], p0[1], p1[0]), b = max3f(p0[2], p0[3], p1[1]); a = max3f(a, p1[2], p1[3]);
#pragma unroll
    for (int r = 4; r < 16; r += 4) { a = max3f(a, p0[r], p0[r + 1]); b = max3f(b, p0[r + 2], p0[r + 3]); a = max3f(a, p1[r], p1[r + 1]); b = max3f(b, p1[r + 2], p1[r + 3]); }
    const float m = max2f(a, b);
    auto rr = __builtin_amdgcn_permlane32_swap(__float_as_uint(m), __float_as_uint(m), false, false);
    return max2f(__uint_as_float(rr[0]), __uint_as_float(rr[1]));
}
__device__ __forceinline__ void pv(f32x16* o, int vb, bf16x8 pa0, bf16x8 pa1, bf16x8 pa2, bf16x8 pa3) {
#pragma unroll
    for (int d0 = 0; d0 < 2; ++d0) { s16x4 lo[4], hi[4];
#pragma unroll
        for (int ks = 0; ks < 4; ++ks) {
            asm volatile("ds_read_b64_tr_b16 %0,%1 offset:%c2" : "=&v"(lo[ks]) : "v"(vb), "i"(d0 * 4096 + ks * 1024) : "memory");
            asm volatile("ds_read_b64_tr_b16 %0,%1 offset:%c2" : "=&v"(hi[ks]) : "v"(vb), "i"(d0 * 4096 + ks * 1024 + 512) : "memory"); }
        asm volatile("s_waitcnt lgkmcnt(0)" ::: "memory"); SBAR();
#define PK(k) (bf16x8){lo[k][0], lo[k][1], lo[k][2], lo[k][3], hi[k][0], hi[k][1], hi[k][2], hi[k][3]}
        o[d0] = __builtin_amdgcn_mfma_f32_32x32x16_bf16(pa0, PK(0), o[d0], 0, 0, 0);
        o[d0] = __builtin_amdgcn_mfma_f32_32x32x16_bf16(pa1, PK(1), o[d0], 0, 0, 0);
        o[d0] = __builtin_amdgcn_mfma_f32_32x32x16_bf16(pa2, PK(2), o[d0], 0, 0, 0);
        o[d0] = __builtin_amdgcn_mfma_f32_32x32x16_bf16(pa3, PK(3), o[d0], 0, 0, 0);
#undef PK
    }
}
template <int THRL> __device__ __forceinline__ void attn_unit(int b, int h, int qb, const bf16_t* Q, const bf16_t* __restrict__ K, const bf16_t* __restrict__ V, bf16_t* O, char* shm) {
    const int tid = opaque_tid(), lane = tid & 63, r32 = lane & 31, hi = lane >> 5; const int wid = __builtin_amdgcn_readfirstlane(tid >> 6);
    const long rowq = (long)b * SEQ + qb * QB + wid * QBLK;
    const bf16_t* Qw = Q + rowq * QP + h * 64;
    const bf16_t* Kh = K + (long)(b * 2 + (h >> 2)) * NKV * KP, *Vh = V + (long)(b * 2 + (h >> 2)) * NKV * KP;
    const unsigned lds0 = (unsigned)(uintptr_t)shm;
    float* wsf = (float*)(shm + LDS_WS) + wid * 64;
    const bf16_t* ksrc = Kh + (long)lane * KP + wid * 8;
    const bf16_t* vsrc = Vh + (long)(16 * (wid & 3) + (lane >> 2)) * KP + (wid >> 2) * 32 + (lane & 3) * 8;
    const unsigned kdst = lds0 + LDS_K + wid * 1024, vdst = lds0 + LDS_V + wid * 1024;
#define DMA_K(t, slot) glds16(ksrc + (long)(t) * KVBLK * KP, (unsigned)__builtin_amdgcn_readfirstlane(kdst + (slot)))
#define DMA_V(t, slot) glds16(vsrc + (long)(t) * KVBLK * KP, (unsigned)__builtin_amdgcn_readfirstlane(vdst + (slot)))
    const int vb0 = (int)(lds0 + LDS_V) + ((lane >> 4) & 1) * 32 + (lane & 3) * 8 + (4 * hi + ((lane & 15) >> 2)) * 64;
    const char* Kbase = shm + LDS_K; bf16x8 kf[8];
    const lds_cptr shm3 = (lds_cptr)shm; const lds_cptr kp0 = shm3 + LDS_K + hi * 1024 + r32 * 16; const lds_cptr vp0 = shm3 + LDS_V + ((lane >> 4) & 1) * 32 + (lane & 3) * 8 + (4 * hi + ((lane & 15) >> 2)) * 64;
    DMA_K(0, 0); DMA_V(0, 0); DMA_K(1, SLOTB);
    bf16x8 qr[4];
#pragma unroll
    for (int d0 = 0; d0 < 4; ++d0) qr[d0] = *reinterpret_cast<const bf16x8*>(&Qw[(long)r32 * QP + d0 * 16 + hi * 8]);
    float mhat = 0.f, l_reg = 0.f; f32x16 o[2]; o[0] = f32x16{}; o[1] = f32x16{}; f32x16 negm = f32x16{}; asm volatile("" : "+v"(negm));
    bool resc = false;
#define START(P0, P1) do { const float rm = rowmax(P0, P1); resc = false; \
    { const float dl = rm; mhat = fadd_s(mhat, dl); \
      _Pragma("unroll") for (int r = 0; r < 16; ++r) { P0[r] = fsub_s(P0[r], dl); P1[r] = fsub_s(P1[r], dl); } \
      _Pragma("unroll") for (int r = 0; r < 16; ++r) negm[r] = -mhat; asm volatile("" : "+v"(negm)); } \
    _Pragma("unroll") for (int r = 0; r < 16; ++r) P0[r] = __builtin_amdgcn_exp2f(P0[r]); } while (0)
#define RESC() do { if (resc) { asm volatile("s_waitcnt lgkmcnt(0)" ::: "memory"); \
      _Pragma("unroll") for (int d_ = 0; d_ < 2; ++d_) _Pragma("unroll") for (int r = 0; r < 16; ++r) o[d_][r] *= wsf[crow(r, hi)]; } } while (0)
    f32x16 pA0, pA1, pB0, pB1;
    int sl_prev = 0, sl_cur = 0, sl_next = SLOTB;
#define ROT() do { sl_prev = sl_cur; sl_cur = sl_next; sl_next = (sl_next == (NSLOT - 1) * SLOTB) ? 0 : sl_next + SLOTB; } while (0)
    DMA_K(2, 2 * SLOTB);
    WAIT_BAR(3);
    qkt(pA0, pA1, Kbase, qr, negm, r32, hi); asm volatile("s_nop 15\n\ts_nop 7" : "+v"(pA0), "+v"(pA1));
    START(pA0, pA1);
    _Pragma("unroll") for (int r = 0; r < 16; ++r) pA1[r] = __builtin_amdgcn_exp2f(pA1[r]);
    WAIT_BAR(0);
    DMA_K(3, 0); DMA_V(1, SLOTB);
    ROT();
    kload8(kf, kp0 + sl_cur);
    WAIT_BAR(2);
    s16x4 vlo[8], vhi[8]; u32x4 pw0, pw1, pw2, pw3;
#define PKW(P, B) cvtpk_s(P[B], P[B + 1])
#define PAF(k) __builtin_bit_cast(bf16x8, pw##k)
#define VFR(i) (bf16x8){vlo[i][0], vlo[i][1], vlo[i][2], vlo[i][3], vhi[i][0], vhi[i][1], vhi[i][2], vhi[i][3]}
#define PIN(x) asm volatile("" : "+v"(x))
#define MX3(a, b, c) __builtin_fmaxf(__builtin_fmaxf((a), (b)), (c))
#define GAPA(MF, A0, A1, A2, A3, W0, W1, PW) do { MF; sacc += A0; sacc += A1; sacc += A2; sacc += A3; PIN(sacc); W0; W1; PIN(PW); SBAR(); } while (0)
#define EX(v) __builtin_amdgcn_exp2f(v)
#define GAPB(MF, X, B) do { MF; X[B] = EX(X[B]); X[B + 1] = EX(X[B + 1]); X[B + 2] = EX(X[B + 2]); X[B + 3] = EX(X[B + 3]); PIN(X); SBAR(); } while (0)
#define VRD(i) do { vlo[i] = vtr(vp_ + (((i) >> 2) * 4096 + ((i) & 3) * 1024)); vhi[i] = vtr(vp_ + (((i) >> 2) * 4096 + ((i) & 3) * 1024 + 512)); } while (0)
#define KRD(G, j) do { if (G) { kload2(kf, kp0 + sl_next, j); SBAR(); } } while (0)
#define STEP(C0, C1, P0, P1, t, GK, GV, GL) do { SBAR(); \
    const lds_cptr vp_ = vp0 + sl_prev; \
    VRD(0); SBAR(); float sacc = (P0[0] + P0[1]); \
    GAPA(C0 = __builtin_amdgcn_mfma_f32_32x32x16_bf16(kf[0], qr[0], negm, 0, 0, 0), P0[2], P0[3], P0[4], P0[5],     pw0[0] = PKW(P0, 0), pw0[1] = PKW(P0, 2), pw0); \
    VRD(4); SBAR(); GAPA(C1 = __builtin_amdgcn_mfma_f32_32x32x16_bf16(kf[1], qr[0], negm, 0, 0, 0), P0[6], P0[7], P0[8], P0[9],     pw0[2] = PKW(P0, 4), pw0[3] = PKW(P0, 6), pw0); \
    VRD(1); SBAR(); GAPA(C0 = __builtin_amdgcn_mfma_f32_32x32x16_bf16(kf[2], qr[1], C0, 0, 0, 0),   P0[10], P0[11], P0[12], P0[13], pw1[0] = PKW(P0, 8), pw1[1] = PKW(P0, 10), pw1); \
    VRD(5); SBAR(); GAPA(C1 = __builtin_amdgcn_mfma_f32_32x32x16_bf16(kf[3], qr[1], C1, 0, 0, 0),   P0[14], P0[15], P1[0], P1[1],   pw1[2] = PKW(P0, 12), pw1[3] = PKW(P0, 14), pw1); \
    VRD(2); SBAR(); GAPA(C0 = __builtin_amdgcn_mfma_f32_32x32x16_bf16(kf[4], qr[2], C0, 0, 0, 0),   P1[2], P1[3], P1[4], P1[5],     pw2[0] = PKW(P1, 0), pw2[1] = PKW(P1, 2), pw2); \
    VRD(6); SBAR(); GAPA(C1 = __builtin_amdgcn_mfma_f32_32x32x16_bf16(kf[5], qr[2], C1, 0, 0, 0),   P1[6], P1[7], P1[8], P1[9],     pw2[2] = PKW(P1, 4), pw2[3] = PKW(P1, 6), pw2); \
    VRD(3); SBAR(); GAPA(C0 = __builtin_amdgcn_mfma_f32_32x32x16_bf16(kf[6], qr[3], C0, 0, 0, 0),   P1[10], P1[11], P1[12], P1[13], pw3[0] = PKW(P1, 8), pw3[1] = PKW(P1, 10), pw3); \
    VRD(7); SBAR(); GAPA(C1 = __builtin_amdgcn_mfma_f32_32x32x16_bf16(kf[7], qr[3], C1, 0, 0, 0),   P1[14], P1[15], 0.f, 0.f,       pw3[2] = PKW(P1, 12), pw3[3] = PKW(P1, 14), pw3); \
    l_reg += sacc; \
    if (GK) { DMA_K((t) + 3, sl_cur); } if (GV) { DMA_V((t) + 1, sl_next); } \
    { float a = MX3(C0[0], C0[1], C1[0]), b_ = MX3(C0[2], C0[3], C1[1]); a = MX3(a, C1[2], C1[3]); \
      _Pragma("unroll") for (int r = 4; r < 16; r += 4) { a = MX3(a, C0[r], C0[r + 1]); b_ = MX3(b_, C0[r + 2], C0[r + 3]); a = MX3(a, C1[r], C1[r + 1]); b_ = MX3(b_, C1[r + 2], C1[r + 3]); } \
      float rm = __builtin_fmaxf(a, b_); { auto rr = __builtin_amdgcn_permlane32_swap(__float_as_uint(rm), __float_as_uint(rm), false, false); rm = __builtin_fmaxf(__uint_as_float(rr[0]), __uint_as_float(rr[1])); } \
      resc = false; \
      if (__builtin_expect(__any(rm > (float)THRL), 0)) { const float dl = __builtin_fmaxf(rm, 0.f); mhat += dl; \
        _Pragma("unroll") for (int r = 0; r < 16; ++r) { C0[r] -= dl; C1[r] -= dl; } \
        _Pragma("unroll") for (int r = 0; r < 16; ++r) negm[r] = -mhat; asm volatile("" : "+v"(negm)); \
        const float f = __builtin_amdgcn_exp2f(-dl); l_reg *= f; if (hi == 0) wsf[r32] = f; resc = true; } } \
    SBAR(); \
    GAPB(o[0] = __builtin_amdgcn_mfma_f32_32x32x16_bf16(PAF(0), VFR(0), o[0], 0, 0, 0), C0, 0); \
    GAPB(o[1] = __builtin_amdgcn_mfma_f32_32x32x16_bf16(PAF(0), VFR(4), o[1], 0, 0, 0), C0, 4); \
    KRD(GL, 0); GAPB(o[0] = __builtin_amdgcn_mfma_f32_32x32x16_bf16(PAF(1), VFR(1), o[0], 0, 0, 0), C0, 8); \
    KRD(GL, 1); GAPB(o[1] = __builtin_amdgcn_mfma_f32_32x32x16_bf16(PAF(1), VFR(5), o[1], 0, 0, 0), C0, 12); \
    KRD(GL, 2); GAPB(o[0] = __builtin_amdgcn_mfma_f32_32x32x16_bf16(PAF(2), VFR(2), o[0], 0, 0, 0), C1, 0); \
    KRD(GL, 3); GAPB(o[1] = __builtin_amdgcn_mfma_f32_32x32x16_bf16(PAF(2), VFR(6), o[1], 0, 0, 0), C1, 4); \
    GAPB(o[0] = __builtin_amdgcn_mfma_f32_32x32x16_bf16(PAF(3), VFR(3), o[0], 0, 0, 0), C1, 8); \
    GAPB(o[1] = __builtin_amdgcn_mfma_f32_32x32x16_bf16(PAF(3), VFR(7), o[1], 0, 0, 0), C1, 12); \
    } while (0)
    int t = 1;
    for (; t + 5 < NT; t += 2) {
        STEP(pB0, pB1, pA0, pA1, t, true, true, true);     WAIT_BAR(2); RESC(); ROT();
        STEP(pA0, pA1, pB0, pB1, t + 1, true, true, true); WAIT_BAR(2); RESC(); ROT();
    }
#define ENDW(tt) do { if ((tt) + 3 < NT) { WAIT_BAR(2); } else if ((tt) + 2 < NT) { WAIT_BAR(1); } else { WAIT_BAR(0); } } while (0)
    for (; t + 1 < NT; t += 2) {
        STEP(pB0, pB1, pA0, pA1, t, (t + 3 < NT), (t + 1 < NT), (t + 1 < NT));         ENDW(t);     RESC(); ROT();
        STEP(pA0, pA1, pB0, pB1, t + 1, (t + 4 < NT), (t + 2 < NT), (t + 2 < NT));     ENDW(t + 1); RESC(); ROT();
    }
    STEP(pB0, pB1, pA0, pA1, NT - 1, false, false, false); RESC();
    { float sacc = pB0[0] + pB0[1]; _Pragma("unroll") for (int r = 2; r < 16; ++r) sacc += pB0[r]; _Pragma("unroll") for (int r = 0; r < 16; ++r) sacc += pB1[r]; l_reg += sacc;
      pw0 = (u32x4){PKW(pB0, 0), PKW(pB0, 2), PKW(pB0, 4), PKW(pB0, 6)}; pw1 = (u32x4){PKW(pB0, 8), PKW(pB0, 10), PKW(pB0, 12), PKW(pB0, 14)}; pw2 = (u32x4){PKW(pB1, 0), PKW(pB1, 2), PKW(pB1, 4), PKW(pB1, 6)}; pw3 = (u32x4){PKW(pB1, 8), PKW(pB1, 10), PKW(pB1, 12), PKW(pB1, 14)};
      SBAR(); pv(o, vb0 + sl_cur, PAF(0), PAF(1), PAF(2), PAF(3)); }
#undef PKW
#undef PAF
#undef VFR
#undef PIN
#undef MX3
#undef GAPA
#undef GAPB
#undef EX
#undef VRD
#undef KRD
#undef STEP
#undef ENDW
    { auto rr = __builtin_amdgcn_permlane32_swap(__float_as_uint(l_reg), __float_as_uint(l_reg), false, false); l_reg = __uint_as_float(rr[0]) + __uint_as_float(rr[1]); }
    if (hi == 0) wsf[32 + r32] = l_reg; asm volatile("s_waitcnt lgkmcnt(0)" ::: "memory");
    float rli[16];
#pragma unroll
    for (int r = 0; r < 16; ++r) rli[r] = __builtin_amdgcn_rcpf(wsf[32 + crow(r, hi)]);
    bf16_t* Ow = O + rowq * OP + h * 64;
    { bf16_t* stg = (bf16_t*)(shm + LDS_OST) + wid * 2048;
#pragma unroll
      for (int r = 0; r < 16; ++r) { const int orow = crow(r, hi);
#pragma unroll
        for (int d0 = 0; d0 < 2; ++d0) stg[orow * 64 + d0 * 32 + r32] = (bf16_t)(cvtpk_s(o[d0][r] * rli[r], 0.f) & 0xffffu); }
      asm volatile("s_waitcnt lgkmcnt(0)" ::: "memory");
#pragma unroll
      for (int i = 0; i < 4; ++i) { const int row = i * 8 + (lane >> 3), ch = lane & 7; const u32x4 v = *(const u32x4*)(stg + row * 64 + ch * 8); *(u32x4*)(Ow + (long)row * OP + ch * 8) = v; } }
    asm volatile("s_waitcnt lgkmcnt(0)\n\ts_barrier" ::: "memory");
#undef DMA_K
#undef DMA_V
#undef START
#undef RESC
#undef ROT
}
#undef SBAR
#undef WAIT_BAR
}

#define LDS_WAIT() asm volatile("s_waitcnt lgkmcnt(0)" ::: "memory")
constexpr int TP_OFF = LDSCTL_OFF + 512;
struct Args { const float* in[27]; float* out; unsigned char* ws; };
enum { I_X = 0, I_C, I_CTX, I_CCTX, I_MODW, I_MODB, I_N1G, I_N2G, I_EWIN, I_QG, I_KG, I_POOLW, I_POOLS, I_EWOUT, I_OWIN, I_SGG, I_SGW, I_SGB, I_CONVW, I_OWOUT,
       I_RGW, I_RGB, I_REW, I_REB, I_WG, I_WU, I_WD };

__device__ __forceinline__ int map_in0(int n) {
    if (n < 640) { const int hd = n >> 6, e = n & 63; const int s = e >> 5, r = e & 31, bj = r >> 4, i = r & 15, j = 16 * s + i;
        const int pn = (hd < 8) ? (hd >> 2) : 2, wc = (hd < 8) ? (hd & 3) : (hd - 8); return 256 * pn + 128 * bj + 32 * wc + j; }
    if (n < 768) { const int vh = (n - 640) >> 6, e = n & 63, bj = e >> 5, j = e & 31; return 512 + 128 * bj + 32 * (2 + vh) + j; }
    return n;
}
__device__ __forceinline__ void p0_transpose_item(const float* W, int K, int N, bf16_t* WT, int kind, int off, LAS float* scr, int item, int lane) {
    const int nblk = N / 32, kb = item / nblk, nb = item % nblk, k0 = 64 * kb, n0 = 32 * nb;
    float tv[32];
#pragma unroll
    for (int i = 0; i < 32; ++i) tv[i] = W[(size_t)(k0 + 2 * i + (lane >> 5)) * N + n0 + (lane & 31)];
#pragma unroll
    for (int i = 0; i < 32; ++i) scr[(2 * i + (lane >> 5)) * 33 + (lane & 31)] = tv[i];
    LDS_WAIT(); asm volatile("" ::: "memory");
    const int c = lane & 7;
#pragma unroll
    for (int j = 0; j < 4; ++j) { const int n = (lane >> 3) + 8 * j; const LAS float* s = scr + (8 * c) * 33 + n; const int ng = n0 + n;
        const int dst = (kind == 1) ? map_in0(ng) : (kind == 2) ? off + 256 * (ng >> 7) + (ng & 127) : off + ng;
        u32x4 o; o.x = cvt_pk_bf16(s[0 * 33], s[1 * 33]); o.y = cvt_pk_bf16(s[2 * 33], s[3 * 33]); o.z = cvt_pk_bf16(s[4 * 33], s[5 * 33]); o.w = cvt_pk_bf16(s[6 * 33], s[7 * 33]);
        *(u32x4*)(WT + (size_t)dst * K + k0 + 8 * c) = o; }
    LDS_WAIT(); asm volatile("" ::: "memory");
}
__device__ __forceinline__ void p0_prologue(const Args& a, LAS unsigned char* lds, int tid, int lane, int wave, int vcu, int G) {
    unsigned char* ws = a.ws;
    for (int unit = blockIdx.x; unit < 192; unit += G) {
        LAS float* sc = (LAS float*)lds;
        LAS float* red = (LAS float*)(lds + 36864);
        for (int idx = tid; idx < 9 * 1024; idx += 512) { const int r = idx >> 10, k = idx & 1023; const float v = (r < 8) ? a.in[I_C][r * 1024 + k] : a.in[I_CCTX][k]; sc[idx] = silu_f(v); }
        __syncthreads();
        const int l = unit / 96, nb = unit % 96;
        const int ks = lane >> 4, c4 = lane & 15;
        const float* Wm = a.in[I_MODW] + (size_t)l * 1024 * 6144 + nb * 64 + 4 * c4;
        f32x4 acc4[9];
#pragma unroll
        for (int r = 0; r < 9; ++r) acc4[r] = (f32x4){0.f, 0.f, 0.f, 0.f};
#pragma unroll 1
        for (int k0 = wave * 128; k0 < wave * 128 + 128; k0 += 32) {
            f32x4 wv[8];
#pragma unroll
            for (int i = 0; i < 8; ++i) wv[i] = *(const f32x4*)(Wm + (size_t)(k0 + 4 * i + ks) * 6144);
#pragma unroll
            for (int i = 0; i < 8; ++i)
#pragma unroll
                for (int r = 0; r < 9; ++r) acc4[r] += sc[r * 1024 + k0 + 4 * i + ks] * wv[i];
        }
#pragma unroll
        for (int r = 0; r < 9; ++r) {
#pragma unroll
            for (int q = 0; q < 4; ++q) { float v = acc4[r][q]; v += __shfl_xor(v, 16); v += __shfl_xor(v, 32); acc4[r][q] = v; }
        }
        if (lane < 16) {
#pragma unroll
            for (int r = 0; r < 9; ++r) *(LAS f32x4*)(red + (wave * 9 + r) * 64 + 4 * c4) = acc4[r];
        }
        __syncthreads();
        for (int idx = tid; idx < 9 * 64; idx += 512) { const int r = idx >> 6, ln = idx & 63; float s = a.in[I_MODB][l * 6144 + nb * 64 + ln];
#pragma unroll
            for (int w = 0; w < 8; ++w) s += red[(w * 9 + r) * 64 + ln];
            ((float*)(ws + WS_MOD))[(size_t)(l * 9 + r) * 6144 + nb * 64 + ln] = s; }
        __syncthreads();
    }
    LAS float* scr = (LAS float*)(lds + wave * 16384);
    const int gw = vcu * NWAVES + wave, NGW = G * NWAVES;
    constexpr int I0 = 16 * 40, I1 = 16 * 32, I2 = 16 * 80, I3 = 16 * 32, IGU = 128, IDN = 128, IPL = 8;
    constexpr int E0 = I0, E1 = E0 + I1, E2 = E1 + I2, E3 = E2 + I3, E4 = E3 + 32 * IGU, E5 = E4 + 32 * IGU, E6 = E5 + 32 * IDN, E7 = E6 + 4 * IPL;
    for (int it = gw; it < E7; it += NGW) {
        if (it < E0) p0_transpose_item(a.in[I_EWIN], 1024, 1280, (bf16_t*)(ws + WS_WIN0), 1, 0, scr, it, lane);
        else if (it < E1) p0_transpose_item(a.in[I_EWOUT], 1024, 1024, (bf16_t*)(ws + WS_WOUT0), 0, 0, scr, it - E0, lane);
        else if (it < E2) p0_transpose_item(a.in[I_OWIN], 1024, 2560, (bf16_t*)(ws + WS_WIN1), 0, 0, scr, it - E1, lane);
        else if (it < E3) p0_transpose_item(a.in[I_OWOUT], 1024, 1024, (bf16_t*)(ws + WS_WOUT1), 0, 0, scr, it - E2, lane);
        else if (it < E4) { const int r = it - E3, le = r / IGU;
            p0_transpose_item(a.in[I_WG] + (size_t)le * 1024 * 256, 1024, 256, (bf16_t*)(ws + WS_WGU) + (size_t)(le >> 4) * 8192 * 1024, 2, (le & 15) * 512, scr, r % IGU, lane); }
        else if (it < E5) { const int r = it - E4, le = r / IGU;
            p0_transpose_item(a.in[I_WU] + (size_t)le * 1024 * 256, 1024, 256, (bf16_t*)(ws + WS_WGU) + (size_t)(le >> 4) * 8192 * 1024, 2, (le & 15) * 512 + 128, scr, r % IGU, lane); }
        else if (it < E6) { const int r = it - E5, le = r / IDN;
            p0_transpose_item(a.in[I_WD] + (size_t)le * 256 * 1024, 256, 1024, (bf16_t*)(ws + WS_WDN) + (size_t)(le >> 4) * 16384 * 256, 0, (le & 15) * 1024, scr, r % IDN, lane); }
        else { const int r = it - E6, g = r / IPL;
            p0_transpose_item(a.in[I_POOLW] + (size_t)g * 128 * 128, 128, 128, (bf16_t*)(ws + WS_WPOOL), 0, g * 128, scr, r % IPL, lane); }
    }
    for (int idx = gw * 64 + lane; idx < 4 * 128 * 128; idx += NGW * 64) { const int x = idx & 15; const int q = (x & 3) + 8 * ((x >> 2) & 1) + 4 * (x >> 3);
        const float v = a.in[I_SGW][(idx & ~15) + q]; ((bf16_t*)(ws + WS_WSG))[idx] = (bf16_t)(cvt_pk_bf16(v, 0.f) & 0xffffu); }
}

__device__ __forceinline__ void load_vec16(const float* p, int lane, f32x4 (&v)[4]) {
#pragma unroll
    for (int j = 0; j < 2; ++j)
#pragma unroll
        for (int q = 0; q < 2; ++q) v[2 * j + q] = *(const f32x4*)(p + 8 * lane + 512 * j + 4 * q);
}
__device__ __forceinline__ void store_row_bf16(bf16_t* p, int lane, const f32x4 (&v)[4]) {
#pragma unroll
    for (int j = 0; j < 2; ++j) { u32x4 w; w.x = cvt_pk_bf16(v[2 * j][0], v[2 * j][1]); w.y = cvt_pk_bf16(v[2 * j][2], v[2 * j][3]); w.z = cvt_pk_bf16(v[2 * j + 1][0], v[2 * j + 1][1]); w.w = cvt_pk_bf16(v[2 * j + 1][2], v[2 * j + 1][3]);
        *(u32x4*)(p + 8 * lane + 512 * j) = w; }
}
__device__ __forceinline__ float sumsq16(const f32x4 (&v)[4]) { float s = 0.f;
#pragma unroll
    for (int i = 0; i < 4; ++i) s += (v[i][0] * v[i][0] + v[i][1] * v[i][1]) + (v[i][2] * v[i][2] + v[i][3] * v[i][3]);
    return s; }
__device__ __forceinline__ void load_mod(const float* mod, const float* gain, int l, int r, int cs, int lane, f32x4 (&gm)[4], f32x4 (&sh)[4]) {
    const float* mr = mod + (size_t)(l * 9 + r) * 6144 + cs * 1024; f32x4 g[4], s[4];
    load_vec16(gain + l * 1024, lane, g); load_vec16(mr + 1024, lane, s); load_vec16(mr, lane, sh);
#pragma unroll
    for (int i = 0; i < 4; ++i) gm[i] = g[i] * (1.0f + s[i]);
}
__device__ __forceinline__ void p1_ln_rows(const Args& a, int lane, int gw, int NGW) {
    const float* mod = (const float*)(a.ws + WS_MOD); bf16_t* AB = (bf16_t*)(a.ws + WS_ABUF);
    const int rpw = (MA + NGW - 1) / NGW, m0 = gw * rpw, m1 = (m0 + rpw < MA) ? m0 + rpw : MA;
    int curb = -1; f32x4 gm[4], sh[4];
    for (int mm = m0; mm < m1; mm += 2) {
        const int mB = (mm + 1 < m1) ? mm + 1 : mm;
        f32x4 vv[2][4];
        load_vec16((mm < MT) ? a.in[I_X] + (size_t)mm * 1024 : a.in[I_CTX] + (size_t)(mm - MT) * 1024, lane, vv[0]);
        load_vec16((mB < MT) ? a.in[I_X] + (size_t)mB * 1024 : a.in[I_CTX] + (size_t)(mB - MT) * 1024, lane, vv[1]);
#pragma unroll
        for (int r = 0; r < 2; ++r) { const int m = r ? mB : mm; if (r && mB == mm) break;
            const int b = (m < MT) ? (m >> 12) : 8;
            if (b != curb) { load_mod(mod, a.in[I_N1G], 0, b, 0, lane, gm, sh); curb = b; }
            const float rstd = __builtin_amdgcn_rsqf(wave_sum(sumsq16(vv[r])) * (1.0f / 1024.0f) + EPS);
#pragma unroll
            for (int i = 0; i < 4; ++i) vv[r][i] = vv[r][i] * rstd * gm[i] + sh[i];
            store_row_bf16(AB + (size_t)m * 1024, lane, vv[r]); }
    }
}
__device__ __forceinline__ void copy_rows(const float* src, float* dst, int lane, int gw, int NGW) {
    for (int m = gw; m < MT; m += NGW) { f32x4 v[4]; load_vec16(src + (size_t)m * 1024, lane, v);
#pragma unroll
        for (int j = 0; j < 2; ++j)
#pragma unroll
            for (int q = 0; q < 2; ++q) *(f32x4*)(dst + (size_t)m * 1024 + 8 * lane + 512 * j + 4 * q) = v[2 * j + q]; }
}

__device__ __forceinline__ void pool_task(int rb, int g, const bf16_t* P, const bf16_t* Wp, const float* pscale, bf16_t* A2, int lane) {
    const int r = lane & 31, hh = lane >> 5;
    const int m0 = rb * 32, b = m0 >> 12, t = (m0 & 4095) + r;
    const int half = 1 << g;
    const int lo = (t - half > 0) ? t - half : 0, hi = (t + half < SEQ) ? t + half : SEQ;
    const float invc = 1.0f / (float)(hi - lo);
    const bf16_t* Pb = P + (size_t)b * SEQ * 512 + g * 128 + 8 * hh;
    float sum[8][8];
#pragma unroll
    for (int s = 0; s < 8; ++s)
#pragma unroll
        for (int j = 0; j < 8; ++j) sum[s][j] = 0.f;
#pragma unroll 2
    for (int d2 = -half; d2 < half; d2 += 2)
#pragma unroll
    for (int dd = 0; dd < 2; ++dd) { const int d = d2 + dd;
        const int tt = t + d; const bool ok = (tt >= 0) && (tt < SEQ); const int tc = ok ? tt : t;
        const float msk = ok ? 1.0f : 0.0f;
#pragma unroll
        for (int s = 0; s < 8; ++s) { const u32x4 w = *(const u32x4*)(Pb + (size_t)tc * 512 + 16 * s);
            sum[s][0] += msk * bf_lo(w.x); sum[s][1] += msk * bf_hi(w.x); sum[s][2] += msk * bf_lo(w.y); sum[s][3] += msk * bf_hi(w.y);
            sum[s][4] += msk * bf_lo(w.z); sum[s][5] += msk * bf_hi(w.z); sum[s][6] += msk * bf_lo(w.w); sum[s][7] += msk * bf_hi(w.w); }
    }
    bf16x8 afrag[8];
#pragma unroll
    for (int s = 0; s < 8; ++s) { const u32x4 w = *(const u32x4*)(Pb + (size_t)t * 512 + 16 * s);
        u32x4 o; o.x = cvt_pk_bf16(sum[s][0] * invc - bf_lo(w.x), sum[s][1] * invc - bf_hi(w.x)); o.y = cvt_pk_bf16(sum[s][2] * invc - bf_lo(w.y), sum[s][3] * invc - bf_hi(w.y));
        o.z = cvt_pk_bf16(sum[s][4] * invc - bf_lo(w.z), sum[s][5] * invc - bf_hi(w.z)); o.w = cvt_pk_bf16(sum[s][6] * invc - bf_lo(w.w), sum[s][7] * invc - bf_hi(w.w));
        afrag[s] = __builtin_bit_cast(bf16x8, o); }
    bf16_t* orow = A2 + (size_t)(m0 + r) * 1024 + 512 + g * 128;
#pragma unroll
    for (int nb = 0; nb < 4; ++nb) {
        f32x16 acc = f32x16{};
#pragma unroll
        for (int s = 0; s < 8; ++s) { const bf16x8 bfr = *(const bf16x8*)(Wp + (size_t)(g * 128 + 32 * nb + r) * 128 + 16 * s + 8 * hh);
            acc = __builtin_amdgcn_mfma_f32_32x32x16_bf16(bfr, afrag[s], acc, 0, 0, 0); }
#pragma unroll
        for (int rg = 0; rg < 4; ++rg) { const int n = 32 * nb + 8 * rg + 4 * hh; const f32x4 ps = *(const f32x4*)(pscale + g * 128 + n);
            u32x2 w; w.x = cvt_pk_bf16(acc[4 * rg] * ps[0], acc[4 * rg + 1] * ps[1]); w.y = cvt_pk_bf16(acc[4 * rg + 2] * ps[2], acc[4 * rg + 3] * ps[3]);
            *(u32x2*)(orow + n) = w; }
    }
}

template <int N> __device__ __forceinline__ void halve(float (&v)[80], int mask, bool upper) {
#pragma unroll
    for (int i = 0; i < N / 2; ++i) { const float send = upper ? v[i] : v[i + N / 2]; const float keep = upper ? v[i + N / 2] : v[i]; v[i] = keep + __shfl_xor(send, mask); }
}
__device__ __forceinline__ void router_phase(const Args& a, int l, LAS unsigned char* lds, int tid, int lane_unused, int wave, int G) {
    unsigned char* ws = a.ws;
    const float* H = (const float*)(ws + WS_H); bf16_t* T = (bf16_t*)(ws + WS_ABUF); const float* mod = (const float*)(ws + WS_MOD);
    LAS float* WL = (LAS float*)lds;
    LAS float* LOG = (LAS float*)(lds + 81920) + wave * 16 * 20;
    LAS int* REC_E = (LAS int*)(lds + 92160); LAS int* REC_P = REC_E + 256; LAS float* REC_W = (LAS float*)(REC_P + 256);
    LAS int* CNT = (LAS int*)(lds + 95232); LAS int* GBASE = CNT + 16;
    const float* rgw = a.in[I_RGW] + (size_t)l * 1024 * 4; const float* rew = a.in[I_REW] + (size_t)l * 1024 * 16;
    for (int idx = tid; idx < 20480; idx += 512) { const int q = idx & 3, ln = (idx >> 2) & 63, rest = idx >> 8, kk = rest % 5, cc = (rest / 5) % 8, jp = rest / 40;
        const int col = 8 * ln + 512 * jp + cc, o = 4 * kk + q; WL[idx] = (o < 4) ? rgw[col * 4 + o] : rew[col * 16 + (o - 4)]; }
    if (tid < 16) CNT[tid] = 0;
    __syncthreads();
    unsigned* counts = (unsigned*)(ws + WS_CTL) + CW_CNT + 64 * l;
    int* rt_e = (int*)(ws + RT_E); int* rt_p = (int*)(ws + RT_POS); float* rt_w = (float*)(ws + RT_W); int* list = (int*)(ws + RT_LIST);
    for (int blk = blockIdx.x; blk < MT / 128; blk += G) {
        const int tok0 = blk * 128 + wave * 16, b = (blk * 128) >> 12;
#pragma unroll 1
        for (int grp = 0; grp < 8; ++grp) {
            const int lane = opaque_tid() & 63;
            f32x4 hv[2][4];
#pragma unroll
            for (int tk = 0; tk < 2; ++tk) load_vec16(H + (size_t)(tok0 + grp * 2 + tk) * 1024, lane, hv[tk]);
            {   f32x4 gm[4], sh[4]; load_mod(mod, a.in[I_N2G], l, b, 3, lane, gm, sh);
#pragma unroll
                for (int tk = 0; tk < 2; ++tk) { const float rstd = __builtin_amdgcn_rsqf(wave_sum(sumsq16(hv[tk])) * (1.0f / 1024.0f) + EPS);
#pragma unroll
                    for (int i = 0; i < 4; ++i) hv[tk][i] = hv[tk][i] * rstd * gm[i] + sh[i];
                    store_row_bf16(T + (size_t)(tok0 + grp * 2 + tk) * 1024, lane, hv[tk]); } }
            float acc[80];
#pragma unroll
            for (int i = 0; i < 40; ++i) acc[i] = 0.f;
#pragma unroll
            for (int jp = 0; jp < 2; ++jp)
#pragma unroll
                for (int cc = 0; cc < 8; ++cc)
#pragma unroll
                    for (int kk = 0; kk < 5; ++kk) { const f32x4 w4 = *(const LAS f32x4*)(WL + (((jp * 8 + cc) * 5 + kk) * 64 + lane) * 4);
#pragma unroll
                        for (int tk = 0; tk < 2; ++tk) { const float tv = hv[tk][2 * jp + (cc >> 2)][cc & 3];
#pragma unroll
                            for (int q = 0; q < 4; ++q) acc[tk * 20 + 4 * kk + q] += tv * w4[q]; } }
            halve<40>(acc, 32, (lane & 32) != 0); halve<20>(acc, 16, (lane & 16) != 0); halve<10>(acc, 8, (lane & 8) != 0);
#pragma unroll
            for (int i = 0; i < 5; ++i) { acc[i] += __shfl_xor(acc[i], 4); acc[i] += __shfl_xor(acc[i], 2); acc[i] += __shfl_xor(acc[i], 1); }
            if ((lane & 7) == 0) { const int tk = (lane >> 5) & 1, o0 = 10 * ((lane >> 4) & 1) + 5 * ((lane >> 3) & 1);
#pragma unroll
                for (int i = 0; i < 5; ++i) LOG[(grp * 2 + tk) * 20 + o0 + i] = acc[i]; }
        }
        LDS_WAIT(); asm volatile("" ::: "memory");
        const int lane = opaque_tid() & 63, tid = opaque_tid();
        if (lane < 16) {
            const LAS float* lg = LOG + lane * 20; const float* rgb = a.in[I_RGB] + l * 4; const float* reb = a.in[I_REB] + l * 16;
            float gl[4];
#pragma unroll
            for (int j = 0; j < 4; ++j) gl[j] = lg[j] + rgb[j];
            int gi = 0; float gmx = gl[0];
#pragma unroll
            for (int j = 1; j < 4; ++j) if (gl[j] > gmx) { gmx = gl[j]; gi = j; }
            float gs = 0.f;
#pragma unroll
            for (int j = 0; j < 4; ++j) gs += __expf(gl[j] - gmx);
            const float gp = 1.0f / gs;
            float el[4];
#pragma unroll
            for (int j = 0; j < 4; ++j) el[j] = lg[4 + gi * 4 + j] + reb[gi * 4 + j];
            int i1 = 0; float m1 = el[0];
#pragma unroll
            for (int j = 1; j < 4; ++j) if (el[j] > m1) { m1 = el[j]; i1 = j; }
            int i2 = -1; float m2 = -3.0e38f;
#pragma unroll
            for (int j = 0; j < 4; ++j) if (j != i1 && el[j] > m2) { m2 = el[j]; i2 = j; }
            const float ex = __expf(m2 - m1), den = 1.0f / (1.0f + ex);
            const int e1 = gi * 4 + i1, e2 = gi * 4 + i2; const int tl = wave * 16 + lane;
            REC_E[tl * 2] = e1; REC_E[tl * 2 + 1] = e2; REC_W[tl * 2] = gp * den; REC_W[tl * 2 + 1] = gp * ex * den;
            REC_P[tl * 2] = __hip_atomic_fetch_add(CNT + e1, 1, __ATOMIC_RELAXED, __HIP_MEMORY_SCOPE_WORKGROUP);
            REC_P[tl * 2 + 1] = __hip_atomic_fetch_add(CNT + e2, 1, __ATOMIC_RELAXED, __HIP_MEMORY_SCOPE_WORKGROUP);
        }
        __syncthreads();
        if (tid < 16) { GBASE[tid] = (int)__hip_atomic_fetch_add(counts + tid, (unsigned)CNT[tid], __ATOMIC_RELAXED, __HIP_MEMORY_SCOPE_AGENT); }
        __syncthreads();
        if (tid < 256) { const int e = REC_E[tid], pos = GBASE[e] + REC_P[tid]; const int token = blk * 128 + (tid >> 1);
            rt_e[token * 2 + (tid & 1)] = e; rt_p[token * 2 + (tid & 1)] = pos; rt_w[token * 2 + (tid & 1)] = REC_W[tid]; list[e * LISTCAP + pos] = token; }
        if (tid < 16) CNT[tid] = 0;
        __syncthreads();
    }
}
__device__ __forceinline__ void build_tp(const Args& a, int l, LAS unsigned char* lds, int tid) {
    volatile LAS int* tp = (volatile LAS int*)(lds + TP_OFF);
    if (tid == 0) { const unsigned* counts = (const unsigned*)(a.ws + WS_CTL) + CW_CNT + 64 * l; int acc = 0;
        for (int e = 0; e < 16; ++e) { const int c = (int)__hip_atomic_load(counts + e, __ATOMIC_RELAXED, __HIP_MEMORY_SCOPE_AGENT); tp[e] = acc; tp[17 + e] = c; acc += (c + 255) >> 8; }
        tp[16] = acc; }
    __syncthreads();
}
template <bool FINAL> __device__ __forceinline__ void combine_phase(const Args& a, int l, LAS unsigned char* lds, int lane, int gw, int NGW) {
    unsigned char* ws = a.ws; const float* mod = (const float*)(ws + WS_MOD);
    float* H = (float*)(ws + WS_H); const bf16_t* Y = (const bf16_t*)(ws + WS_RGN); bf16_t* AB = (bf16_t*)(ws + WS_ABUF);
    const u32x2* rt_e = (const u32x2*)(ws + RT_E); const u32x2* rt_p = (const u32x2*)(ws + RT_POS); const f32x2* rt_w = (const f32x2*)(ws + RT_W);
    const volatile LAS int* tp = (const volatile LAS int*)(lds + TP_OFF);
    const int rpw = (((MT + NGW - 1) / NGW) + 1) & ~1, m0 = gw * rpw, m1 = (m0 + rpw < MT) ? m0 + rpw : MT;
    int curb = -1; f32x4 g2[4], gm[4], sh[4];
    u32x2 ne[2], np[2]; f32x2 nw[2];
    if (m0 < m1) {
#pragma unroll
        for (int r = 0; r < 2; ++r) { ne[r] = rt_e[m0 + r]; np[r] = rt_p[m0 + r]; nw[r] = rt_w[m0 + r]; } }
    for (int m = m0; m < m1; m += 2) {
        u32x2 ce[2], cp[2]; f32x2 cw[2];
#pragma unroll
        for (int r = 0; r < 2; ++r) { ce[r] = ne[r]; cp[r] = np[r]; cw[r] = nw[r]; }
        if (m + 2 < m1) {
#pragma unroll
            for (int r = 0; r < 2; ++r) { ne[r] = rt_e[m + 2 + r]; np[r] = rt_p[m + 2 + r]; nw[r] = rt_w[m + 2 + r]; } }
        const int b = m >> 12;
        if (b != curb) { load_vec16(mod + (size_t)(l * 9 + b) * 6144 + 5 * 1024, lane, g2); if (!FINAL) load_mod(mod, a.in[I_N1G], 1, b, 0, lane, gm, sh); curb = b; }
        f32x4 hv[2][4]; u32x4 ya[2][2], yb[2][2];
#pragma unroll
        for (int r = 0; r < 2; ++r) { load_vec16(H + (size_t)(m + r) * 1024, lane, hv[r]);
            const size_t s0 = (size_t)(tp[ce[r].x] * 256 + (int)cp[r].x), s1 = (size_t)(tp[ce[r].y] * 256 + (int)cp[r].y);
#pragma unroll
            for (int j = 0; j < 2; ++j) { ya[r][j] = *(const u32x4*)(Y + s0 * 1024 + 8 * lane + 512 * j); yb[r][j] = *(const u32x4*)(Y + s1 * 1024 + 8 * lane + 512 * j); } }
#pragma unroll
        for (int r = 0; r < 2; ++r) { const float w0 = cw[r].x, w1 = cw[r].y;
#pragma unroll
            for (int j = 0; j < 2; ++j) { const u32x4 y0 = ya[r][j], y1 = yb[r][j];
                f32x4 m0v = {w0 * bf_lo(y0.x) + w1 * bf_lo(y1.x), w0 * bf_hi(y0.x) + w1 * bf_hi(y1.x), w0 * bf_lo(y0.y) + w1 * bf_lo(y1.y), w0 * bf_hi(y0.y) + w1 * bf_hi(y1.y)};
                f32x4 m1v = {w0 * bf_lo(y0.z) + w1 * bf_lo(y1.z), w0 * bf_hi(y0.z) + w1 * bf_hi(y1.z), w0 * bf_lo(y0.w) + w1 * bf_lo(y1.w), w0 * bf_hi(y0.w) + w1 * bf_hi(y1.w)};
                hv[r][2 * j] = hv[r][2 * j] + g2[2 * j] * m0v; hv[r][2 * j + 1] = hv[r][2 * j + 1] + g2[2 * j + 1] * m1v; }
            float* dst = FINAL ? a.out + (size_t)(m + r) * 1024 : H + (size_t)(m + r) * 1024;
#pragma unroll
            for (int j = 0; j < 2; ++j)
#pragma unroll
                for (int q = 0; q < 2; ++q) *(f32x4*)(dst + 8 * lane + 512 * j + 4 * q) = hv[r][2 * j + q];
            if (!FINAL) { const float rstd = __builtin_amdgcn_rsqf(wave_sum(sumsq16(hv[r])) * (1.0f / 1024.0f) + EPS);
#pragma unroll
                for (int i = 0; i < 4; ++i) hv[r][i] = hv[r][i] * rstd * gm[i] + sh[i];
                store_row_bf16(AB + (size_t)(m + r) * 1024, lane, hv[r]); } }
    }
}

__device__ __forceinline__ void sgconv_phase(const Args& a, LAS unsigned char* lds, int tid_unused, int lane_unused, int wave, int G) {
    unsigned char* ws = a.ws; const bf16_t* UV = (const bf16_t*)(ws + WS_RGN); bf16_t* MIX = (bf16_t*)(ws + WS_ABUF); const bf16_t* WSG = (const bf16_t*)(ws + WS_WSG);
    for (int blk = blockIdx.x; blk < MT / 128; blk += G) {
        const int tok0 = blk * 128;
        {
            const int lane = opaque_tid() & 63;
            const int g = wave >> 1, ch = lane & 15; float gn[8];
            u32x4 wv[16];
#pragma unroll
            for (int it = 0; it < 16; ++it) wv[it] = *(const u32x4*)(UV + (size_t)(tok0 + 64 * (wave & 1) + 4 * it + (lane >> 4)) * 2560 + 512 + g * 128 + 8 * ch);
#pragma unroll
            for (int j = 0; j < 8; ++j) gn[j] = a.in[I_SGG][g * 128 + 8 * ch + j];
#pragma unroll
            for (int it = 0; it < 16; ++it) { const int q = 64 * (wave & 1) + 4 * it + (lane >> 4); const u32x4 w = wv[it];
                float v[8] = {bf_lo(w.x), bf_hi(w.x), bf_lo(w.y), bf_hi(w.y), bf_lo(w.z), bf_hi(w.z), bf_lo(w.w), bf_hi(w.w)};
                float ss = 0.f;
#pragma unroll
                for (int j = 0; j < 8; ++j) ss += v[j] * v[j];
                ss += __shfl_xor(ss, 1); ss += __shfl_xor(ss, 2); ss += __shfl_xor(ss, 4); ss += __shfl_xor(ss, 8);
                const float rstd = __builtin_amdgcn_rsqf(ss * (1.0f / 128.0f) + EPS);
                u32x4 o; o.x = cvt_pk_bf16(v[0] * rstd * gn[0], v[1] * rstd * gn[1]); o.y = cvt_pk_bf16(v[2] * rstd * gn[2], v[3] * rstd * gn[3]);
                o.z = cvt_pk_bf16(v[4] * rstd * gn[4], v[5] * rstd * gn[5]); o.w = cvt_pk_bf16(v[6] * rstd * gn[6], v[7] * rstd * gn[7]);
                *(LAS u32x4*)(lds + g * 32768 + (ch >> 2) * 8192 + q * 64 + (ch & 3) * 16) = o; }
        }
        {
            const int lane = opaque_tid() & 63;
            float cw[3][8];
#pragma unroll
            for (int k = 0; k < 3; ++k)
#pragma unroll
                for (int j = 0; j < 8; ++j) cw[k][j] = a.in[I_CONVW][k * 512 + 8 * lane + j];
#pragma unroll 1
            for (int hf = 0; hf < 4; ++hf) { const int t0 = tok0 + wave * 16 + hf * 4;
                u32x4 hx[6], cg[6], bg[4];
#pragma unroll
                for (int i = 0; i < 6; ++i) { const bool ok = !((i == 0 && ((t0 & 4095) == 0)) || (i == 5 && (((t0 + 3) & 4095) == 4095))); const int tok = ok ? t0 - 1 + i : t0;
                    hx[i] = *(const u32x4*)(UV + (size_t)tok * 2560 + 1024 + 8 * lane); cg[i] = *(const u32x4*)(UV + (size_t)tok * 2560 + 2048 + 8 * lane);
                    if (!ok) hx[i] = (u32x4){0u, 0u, 0u, 0u}; }
#pragma unroll
                for (int i = 0; i < 4; ++i) bg[i] = *(const u32x4*)(UV + (size_t)(t0 + i) * 2560 + 1536 + 8 * lane);
                float z[6][8];
#pragma unroll
                for (int i = 0; i < 6; ++i) { z[i][0] = bf_lo(hx[i].x) * bf_lo(cg[i].x); z[i][1] = bf_hi(hx[i].x) * bf_hi(cg[i].x); z[i][2] = bf_lo(hx[i].y) * bf_lo(cg[i].y); z[i][3] = bf_hi(hx[i].y) * bf_hi(cg[i].y);
                    z[i][4] = bf_lo(hx[i].z) * bf_lo(cg[i].z); z[i][5] = bf_hi(hx[i].z) * bf_hi(cg[i].z); z[i][6] = bf_lo(hx[i].w) * bf_lo(cg[i].w); z[i][7] = bf_hi(hx[i].w) * bf_hi(cg[i].w); }
#pragma unroll
                for (int i = 0; i < 4; ++i) { const u32x4 b4 = bg[i];
                    const float bgv[8] = {bf_lo(b4.x), bf_hi(b4.x), bf_lo(b4.y), bf_hi(b4.y), bf_lo(b4.z), bf_hi(b4.z), bf_lo(b4.w), bf_hi(b4.w)};
                    float y[8];
#pragma unroll
                    for (int j = 0; j < 8; ++j) y[j] = bgv[j] * (cw[0][j] * z[i][j] + cw[1][j] * z[i + 1][j] + cw[2][j] * z[i + 2][j]);
                    u32x4 o; o.x = cvt_pk_bf16(y[0], y[1]); o.y = cvt_pk_bf16(y[2], y[3]); o.z = cvt_pk_bf16(y[4], y[5]); o.w = cvt_pk_bf16(y[6], y[7]);
                    *(u32x4*)(MIX + (size_t)(t0 + i) * 1024 + 512 + 8 * lane) = o; } }
        }
        __syncthreads();
        {
            const int lane = opaque_tid() & 63, r32 = lane & 31, hi = lane >> 5;
            const int g = wave >> 1, ph = wave & 1;
            f32x16 acc[2][4];
#pragma unroll
            for (int pb = 0; pb < 2; ++pb)
#pragma unroll
                for (int cb = 0; cb < 4; ++cb) acc[pb][cb] = f32x16{};
            const LAS unsigned char* vbase = lds + g * 32768 + ((lane >> 4) & 1) * 32 + (lane & 3) * 8 + (4 * hi + ((lane & 15) >> 2)) * 64;
#pragma unroll 4
            for (int s = 0; s < 8; ++s) {
                bf16x8 wf[2];
#pragma unroll
                for (int pb = 0; pb < 2; ++pb) wf[pb] = *(const bf16x8*)(WSG + (size_t)(g * 128 + 64 * ph + 32 * pb + r32) * 128 + 16 * s + 8 * hi);
#pragma unroll
                for (int cb = 0; cb < 4; ++cb) {
                    const s16x4 lo = attn_body::vtr((attn_body::lds_cptr)(vbase + cb * 8192 + s * 1024)), hh = attn_body::vtr((attn_body::lds_cptr)(vbase + cb * 8192 + s * 1024 + 512));
                    const bf16x8 vf = (bf16x8){lo[0], lo[1], lo[2], lo[3], hh[0], hh[1], hh[2], hh[3]};
#pragma unroll
                    for (int pb = 0; pb < 2; ++pb) acc[pb][cb] = __builtin_amdgcn_mfma_f32_32x32x16_bf16(vf, wf[pb], acc[pb][cb], 0, 0, 0);
                }
            }
#pragma unroll
            for (int pb = 0; pb < 2; ++pb) { const int p = 64 * ph + 32 * pb + r32; const float bias = a.in[I_SGB][g * 128 + p];
                const bf16_t* urow = UV + (size_t)(tok0 + p) * 2560 + g * 128; bf16_t* orow = MIX + (size_t)(tok0 + p) * 1024 + g * 128;
                u32x2 uu[4][4];
#pragma unroll
                for (int cb = 0; cb < 4; ++cb)
#pragma unroll
                    for (int rg = 0; rg < 4; ++rg) uu[cb][rg] = *(const u32x2*)(urow + 32 * cb + 8 * rg + 4 * hi);
#pragma unroll
                for (int cb = 0; cb < 4; ++cb)
#pragma unroll
                    for (int rg = 0; rg < 4; ++rg) { const int c0 = 32 * cb + 8 * rg + 4 * hi; const u32x2 u2 = uu[cb][rg];
                        u32x2 w; w.x = cvt_pk_bf16(bf_lo(u2.x) * (acc[pb][cb][4 * rg] + bias), bf_hi(u2.x) * (acc[pb][cb][4 * rg + 1] + bias));
                        w.y = cvt_pk_bf16(bf_lo(u2.y) * (acc[pb][cb][4 * rg + 2] + bias), bf_hi(u2.y) * (acc[pb][cb][4 * rg + 3] + bias));
                        *(u32x2*)(orow + c0) = w; } }
        }
        __syncthreads();
    }
}

__global__ void __launch_bounds__(NWAVES * 64, 2) mk_fwd(Args a) {
    extern __shared__ __attribute__((aligned(16))) unsigned char lds_raw[];
    LAS unsigned char* lds = (LAS unsigned char*)lds_raw;
    const int tid0 = threadIdx.x, wave = __builtin_amdgcn_readfirstlane(tid0 >> 6);
#define tid opaque_tid()
#define lane (opaque_tid() & 63)
    const int G = gridDim.x; const int bx = blockIdx.x; const int vcu = (G % 8 == 0) ? (bx % 8) * (G / 8) + bx / 8 : bx;
    const int gw = vcu * NWAVES + wave, NGW = G * NWAVES;
    unsigned char* ws = a.ws;
    for (int u = tid0; u < (LDS_BYTES - LDSCTL_OFF) / 4; u += NWAVES * 64) ((LAS unsigned*)(lds + LDSCTL_OFF))[u] = 0u;
    __syncthreads();
    volatile LAS unsigned* MISC = (volatile LAS unsigned*)(lds + MISC_OFF);
    XcdBarrier bar = xcd_barrier_post((unsigned*)(ws + WS_CTL) + CW_BAR, MISC + 8);
    unsigned long long t_ph = 0; if constexpr (MK_PROBE != 0u) t_ph = __builtin_amdgcn_s_memrealtime();
#define PROBE_IDLE(n) do { if constexpr (MK_PROBE != 0u) { if constexpr (((MK_PROBE) >> (n)) & 1u) { const unsigned long long t1_ = __builtin_amdgcn_s_memrealtime(), d_ = t1_ - t_ph; \
        while (__builtin_amdgcn_s_memrealtime() - t1_ < d_) __builtin_amdgcn_s_sleep(8); } t_ph = __builtin_amdgcn_s_memrealtime(); } } while (0)
#define GRID_BAR(n) do { xcd_barrier(bar); PROBE_IDLE(n); } while (0)
    const float* mod = (const float*)(ws + WS_MOD);
    float* H = (float*)(ws + WS_H);
    bf16_t* ABUF = (bf16_t*)(ws + WS_ABUF);

    PH(0) p0_prologue(a, lds, tid, lane, wave, vcu, G);
    GRID_BAR(0);
#if MK_STAGE == 0
    copy_rows(a.in[I_X], a.out, lane, gw, NGW); return;
#endif
    PH(1) p1_ln_rows(a, lane, gw, NGW);
    GRID_BAR(1);
    PH(2) {   pg8::SchedInProj0 S{G, vcu};
        pg8::EpiQKV E{(bf16_t*)(ws + RG_Q), (bf16_t*)(ws + RG_K), (bf16_t*)(ws + RG_V), (bf16_t*)(ws + RG_P), a.in[I_QG], a.in[I_KG]};
        pg8::gemm_phase<pg8::EpiQKV, pg8::SchedInProj0, false>(lds, ABUF, (const bf16_t*)(ws + WS_WIN0), 1024, S, E); }
    GRID_BAR(2);
    PH(3) {   const int nper = (NB * 8 * (SEQ / 256)) / G;
        for (int i = 0; i < nper; ++i) { const int uidx = vcu * nper + i; const int b = uidx >> 7, rem = uidx & 127, h = rem & 7, qb = rem >> 3;
            attn_body::attn_unit<8>(b, h, qb, (const bf16_t*)(ws + RG_Q), (const bf16_t*)(ws + RG_K), (const bf16_t*)(ws + RG_V), (bf16_t*)(ws + RG_A2), (char*)lds_raw); }
        for (int p = gw; p < (MT / 32) * 2; p += NGW)
#pragma unroll 1
            for (int k = 0; k < 2; ++k) pool_task(p >> 1, (p & 1) ? 1 + k : 3 * k, (const bf16_t*)(ws + RG_P), (const bf16_t*)(ws + WS_WPOOL), a.in[I_POOLS], (bf16_t*)(ws + RG_A2), lane); }
    GRID_BAR(3);
    PH(4) {   pg8::SchedGrid S{4, 128 * 4, G, vcu};
        pg8::EpiResid E{a.in[I_X], H, mod + 2 * 1024};
        pg8::gemm_phase<pg8::EpiResid, pg8::SchedGrid, false>(lds, (const bf16_t*)(ws + RG_A2), (const bf16_t*)(ws + WS_WOUT0), 1024, S, E); }
    GRID_BAR(4);
#if MK_STAGE == 1
    copy_rows(H, a.out, lane, gw, NGW); return;
#endif
#if MK_STAGE >= 2
    PH(5) router_phase(a, 0, lds, tid, lane, wave, G);
    GRID_BAR(5);
    build_tp(a, 0, lds, tid);
    PH(6) {   pg8::SchedMoE S{(const volatile LAS int*)(lds + TP_OFF), (const int*)(ws + RT_LIST), 2, G, vcu, true};
        pg8::EpiGateUp E{(bf16_t*)(ws + WS_ACT)};
        pg8::gemm_phase<pg8::EpiGateUp, pg8::SchedMoE, true>(lds, ABUF, (const bf16_t*)(ws + WS_WGU), 1024, S, E); }
    GRID_BAR(6);
    PH(7) {   pg8::SchedMoE S{(const volatile LAS int*)(lds + TP_OFF), (const int*)(ws + RT_LIST), 4, G, vcu, false};
        pg8::EpiBf16 E{(bf16_t*)(ws + WS_RGN), 1024, true};
        pg8::gemm_phase<pg8::EpiBf16, pg8::SchedMoE, false>(lds, (const bf16_t*)(ws + WS_ACT), (const bf16_t*)(ws + WS_WDN), 256, S, E); }
    GRID_BAR(7);
    PH(8) combine_phase<false>(a, 0, lds, lane, gw, NGW);
    GRID_BAR(8);
#endif
#if MK_STAGE == 2
    copy_rows(H, a.out, lane, gw, NGW); return;
#endif
#if MK_STAGE >= 3
    PH(9) {   pg8::SchedGrid S{10, 128 * 10, G, vcu};
        pg8::EpiBf16 E{(bf16_t*)(ws + WS_RGN), 2560, false};
        pg8::gemm_phase<pg8::EpiBf16, pg8::SchedGrid, false>(lds, ABUF, (const bf16_t*)(ws + WS_WIN1), 1024, S, E); }
    GRID_BAR(9);
    PH(10) sgconv_phase(a, lds, tid, lane, wave, G);
    GRID_BAR(10);
    PH(11) {   pg8::SchedGrid S{4, 128 * 4, G, vcu};
        pg8::EpiResid E{H, H, mod + (size_t)9 * 6144 + 2 * 1024};
        pg8::gemm_phase<pg8::EpiResid, pg8::SchedGrid, false>(lds, ABUF, (const bf16_t*)(ws + WS_WOUT1), 1024, S, E); }
    GRID_BAR(11);
#endif
#if MK_STAGE == 3
    copy_rows(H, a.out, lane, gw, NGW); return;
#endif
#if MK_STAGE >= 4
    router_phase(a, 1, lds, tid, lane, wave, G);
    GRID_BAR(12);
    build_tp(a, 1, lds, tid);
    {   pg8::SchedMoE S{(const volatile LAS int*)(lds + TP_OFF), (const int*)(ws + RT_LIST), 2, G, vcu, true};
        pg8::EpiGateUp E{(bf16_t*)(ws + WS_ACT)};
        pg8::gemm_phase<pg8::EpiGateUp, pg8::SchedMoE, true>(lds, ABUF, (const bf16_t*)(ws + WS_WGU) + (size_t)8192 * 1024, 1024, S, E); }
    GRID_BAR(13);
    {   pg8::SchedMoE S{(const volatile LAS int*)(lds + TP_OFF), (const int*)(ws + RT_LIST), 4, G, vcu, false};
        pg8::EpiBf16 E{(bf16_t*)(ws + WS_RGN), 1024, true};
        pg8::gemm_phase<pg8::EpiBf16, pg8::SchedMoE, false>(lds, (const bf16_t*)(ws + WS_ACT), (const bf16_t*)(ws + WS_WDN) + (size_t)16384 * 256, 256, S, E); }
    GRID_BAR(14);
    combine_phase<true>(a, 1, lds, lane, gw, NGW);
    PROBE_IDLE(15);
#endif
#undef tid
#undef lane
}

extern "C" void kernel_launch(void* const* d_in, const int* in_sizes, int n_in, void* d_out, int out_size, void* d_ws, size_t ws_size, hipStream_t stream) {
    static int grid = 0;
    if (grid == 0) {
        if (n_in != 27 || out_size != MT * DM || ws_size < WS_END) { fprintf(stderr, "kernel_launch: unexpected problem (n_in %d, out %d, ws %zu)\n", n_in, out_size, ws_size); grid = -1; return; }
        int dev = 0, cus = 0, per_cu = 0;
        if (hipGetDevice(&dev) != hipSuccess || hipDeviceGetAttribute(&cus, hipDeviceAttributeMultiprocessorCount, dev) != hipSuccess) { grid = -1; return; }
        if (hipFuncSetAttribute((const void*)mk_fwd, hipFuncAttributeMaxDynamicSharedMemorySize, LDS_BYTES) != hipSuccess) { fprintf(stderr, "kernel_launch: hipFuncSetAttribute failed\n"); grid = -1; return; }
        if (hipOccupancyMaxActiveBlocksPerMultiprocessor(&per_cu, (const void*)mk_fwd, NWAVES * 64, LDS_BYTES) != hipSuccess || per_cu < 1) { fprintf(stderr, "kernel_launch: occupancy query says %d blocks per CU\n", per_cu); }
        (void)hipGetLastError();
        grid = cus;
    }
    if (grid < 0) return;
    if (hipMemsetAsync((char*)d_ws + WS_CTL, 0, CTL_ZERO_BYTES, stream) != hipSuccess) return;
    Args a{};
    for (int i = 0; i < 27; ++i) a.in[i] = (const float*)d_in[i];
    a.out = (float*)d_out; a.ws = (unsigned char*)d_ws;
    hipLaunchKernelGGL(mk_fwd, dim3(grid), dim3(NWAVES * 64), LDS_BYTES, stream, a);
}
```

```cpp
#include <hip/hip_runtime.h>
#include <cstdio>
#include <cstdint>

#ifndef MK_PH
#define MK_PH 0xffffffffu
#endif
#define PH(n) if constexpr (((MK_PH) >> (n)) & 1u)
#ifndef MK_PROBE
#define MK_PROBE 0u
#endif
#ifndef MK_STAGE
#define MK_STAGE 4
#endif

#define LAS __attribute__((address_space(3)))
#define GAS __attribute__((address_space(1)))
typedef unsigned short bf16_t;
typedef short bf16x8 __attribute__((ext_vector_type(8)));
typedef short s16x4 __attribute__((ext_vector_type(4)));
typedef float f32x2 __attribute__((ext_vector_type(2)));
typedef float f32x4 __attribute__((ext_vector_type(4)));
typedef float f32x16 __attribute__((ext_vector_type(16)));
typedef unsigned u32x2 __attribute__((ext_vector_type(2)));
typedef unsigned u32x4 __attribute__((ext_vector_type(4)));

constexpr int NB = 8, SEQ = 4096, DM = 1024, MT = NB * SEQ, CTX = 256, MC = NB * CTX, MA = MT + MC, NKV = SEQ + CTX;
constexpr int NEXP = 16, DEXP = 256, NCLS = 24, LISTCAP = MT;
constexpr int SLOT_ROWS = MT + NCLS * 256;
constexpr float EPS = 1e-6f;
constexpr float C2 = 0.125f * 1.4426950408889634f;

constexpr size_t MiB = 1u << 20;
constexpr size_t WS_CTL = 0, CTL_ZERO_BYTES = 1 * MiB;
constexpr size_t WS_MOD = 512 * 1024;
constexpr size_t WS_WIN0 = 2 * MiB;
constexpr size_t WS_WOUT0 = 5 * MiB;
constexpr size_t WS_WIN1 = 7 * MiB;
constexpr size_t WS_WOUT1 = 12 * MiB;
constexpr size_t WS_WGU = 14 * MiB;
constexpr size_t WS_WDN = 46 * MiB;
constexpr size_t WS_WPOOL = 62 * MiB;
constexpr size_t WS_WSG = 62 * MiB + 512 * 1024;
constexpr size_t WS_ABUF = 64 * MiB;
constexpr size_t WS_H = 132 * MiB;
constexpr size_t WS_ACT = 260 * MiB;
constexpr size_t WS_RGN = 294 * MiB;
constexpr size_t RG_Q = WS_RGN, RG_K = RG_Q + 32 * MiB, RG_V = RG_K + 9 * MiB, RG_P = RG_V + 9 * MiB, RG_A2 = RG_P + 32 * MiB;
constexpr size_t WS_ROUTE = 462 * MiB;
constexpr size_t RT_LIST = WS_ROUTE;
constexpr size_t RT_WSLOT = WS_ACT;
constexpr size_t WS_END = 466 * MiB;
static_assert(RG_A2 + (size_t)MT * 1024 * 2 <= WS_ROUTE && WS_RGN + (size_t)SLOT_ROWS * 512 * 2 <= WS_ROUTE && WS_RGN + (size_t)MT * 2560 * 2 <= WS_ROUTE && RT_LIST + (size_t)NCLS * LISTCAP * 4 <= WS_END && RT_WSLOT + (size_t)NCLS * LISTCAP * 8 <= WS_RGN, "region map");
static_assert(WS_ABUF + (size_t)MA * 1024 * 2 <= WS_H && WS_H + (size_t)MT * 1024 * 4 <= WS_ACT, "ws map");
constexpr int CW_CNT = 64;
constexpr int CW_BAR = 4096;

constexpr int RING_BYTES = 131072;
constexpr int LDSCTL_OFF = RING_BYTES, MISC_OFF = LDSCTL_OFF + 320;
constexpr int SIDE_OFF = LDSCTL_OFF + 1024;
constexpr int LDS_BYTES = 147456;
constexpr int NWAVES = 8;

__device__ __forceinline__ unsigned cvt_pk_bf16(float lo, float hi) { unsigned r; asm volatile("v_cvt_pk_bf16_f32 %0, %1, %2" : "=v"(r) : "v"(lo), "v"(hi)); return r; }
__device__ __forceinline__ float bf_lo(unsigned w) { return __uint_as_float(w << 16); }
__device__ __forceinline__ float bf_hi(unsigned w) { return __uint_as_float(w & 0xffff0000u); }
__device__ __forceinline__ float wave_sum(float v) {
#pragma unroll
    for (int o = 1; o < 64; o <<= 1) v += __shfl_xor(v, o);
    return v;
}
__device__ __forceinline__ float fast_rcp(float x) { return __builtin_amdgcn_rcpf(x); }
__device__ __forceinline__ float silu_f(float v) { return v * fast_rcp(1.f + __builtin_amdgcn_exp2f(-1.4426950408889634f * v)); }

__device__ __forceinline__ int opaque_tid() { int t = threadIdx.x; asm volatile("" : "+v"(t)); return t; }

#define XB_TMO      128
#define XB_XCNT(j)  (256  + 64 * (j))
#define XB_XSUB(j)  (1280 + 64 * (j))
#define XB_XGEN(j)  (2304 + 64 * (j))
#define XB_TOP      3328
#define XB_TOPGEN   3392
#define XCD_BAR_WORDS 3456
#define XB_SPIN_CAP (1u << 18)
__device__ __forceinline__ unsigned xb_ld(unsigned* p)              { return __hip_atomic_load(p, __ATOMIC_RELAXED, __HIP_MEMORY_SCOPE_AGENT); }
__device__ __forceinline__ unsigned xb_add(unsigned* p, unsigned v) { return __hip_atomic_fetch_add(p, v, __ATOMIC_RELAXED, __HIP_MEMORY_SCOPE_AGENT); }
__device__ __forceinline__ unsigned xb_xcc_id() { return (unsigned)__builtin_amdgcn_s_getreg((3 << 11) | 20) & 0xFu; }
#define XB_SPIN(cond, bar) do { unsigned _sp = 0; while (cond) { __builtin_amdgcn_s_sleep(1); \
    if ((++_sp & 255u) == 0u) { if (xb_ld(&(bar)[XB_TMO])) break; if (_sp > XB_SPIN_CAP) { atomicAdd(&(bar)[XB_TMO], 1u); break; } } } } while (0)
struct XcdBarrier { unsigned* bar; unsigned x; volatile LAS unsigned* st; };
__device__ __forceinline__ XcdBarrier xcd_barrier_post(unsigned* bar, volatile LAS unsigned* st) {
    XcdBarrier b; b.bar = bar; b.x = xb_xcc_id(); b.st = st;
    if (threadIdx.x == 0) (void)xb_add(&bar[XB_XCNT(b.x)], 1u);
    return b;
}
__device__ __forceinline__ void xcd_barrier_complete(unsigned* bar, unsigned x, unsigned& nloc, unsigned& nx) {
    const unsigned G = gridDim.x * gridDim.y * gridDim.z;
    unsigned sum, cnt, mine, sp = 0u;
    for (;;) {
        sum = 0u; cnt = 0u; mine = 0u;
#pragma unroll
        for (unsigned j = 0; j < 16; ++j) { const unsigned c = xb_ld(&bar[XB_XCNT(j)]); sum += c; cnt += (c > 0u) ? 1u : 0u; mine = (j == x) ? c : mine; }
        if (sum == G) break;
        __builtin_amdgcn_s_sleep(1);
        if ((++sp & 255u) == 0u) { if (xb_ld(&bar[XB_TMO])) break; if (sp > XB_SPIN_CAP) { atomicAdd(&bar[XB_TMO], 1u); break; } }
    }
    nloc = mine > 0u ? mine : 1u; nx = cnt > 0u ? cnt : 1u;
}
__device__ __forceinline__ void xcd_barrier(const XcdBarrier& b) {
    asm volatile("s_waitcnt vmcnt(0)" ::: "memory");
    __syncthreads();
    if (threadIdx.x == 0) {
        unsigned* bar = b.bar;
        __builtin_amdgcn_s_waitcnt(0);
        unsigned nloc = b.st[0], nx = b.st[1];
        if (nloc == 0u) { xcd_barrier_complete(bar, b.x, nloc, nx); b.st[0] = nloc; b.st[1] = nx; }
        const unsigned old = xb_add(&bar[XB_XSUB(b.x)], 1u);
        const unsigned gen = old / nloc;
        if (old + 1u == (gen + 1u) * nloc) {
            __builtin_amdgcn_fence(__ATOMIC_RELEASE, "agent");
            asm volatile("s_waitcnt vmcnt(0)" ::: "memory");
            const unsigned og = xb_add(&bar[XB_TOP], 1u);
            const unsigned tg = og / nx;
            if (og + 1u == (tg + 1u) * nx) xb_add(&bar[XB_TOPGEN], 1u);
            else XB_SPIN(xb_ld(&bar[XB_TOPGEN]) == tg, bar);
            __builtin_amdgcn_fence(__ATOMIC_ACQUIRE, "agent");
            xb_add(&bar[XB_XGEN(b.x)], 1u);
            asm volatile("s_waitcnt vmcnt(0)" ::: "memory");
        } else {
            XB_SPIN(xb_ld(&bar[XB_XGEN(b.x)]) == gen, bar);
            __builtin_amdgcn_fence(__ATOMIC_ACQUIRE, "agent");
            asm volatile("s_waitcnt vmcnt(0)" ::: "memory");
        }
    }
    __syncthreads();
}

namespace pg8 {
constexpr int BM = 256, BK = 64, HALF = 128, HTB = HALF * BK * 2;
__device__ __forceinline__ int lds_byte(int r, int c) { const int st = (r >> 4) * 2 + (c >> 5), rr = r & 15, cc = c & 31, ob = rr * 64 + cc * 2; return st * 1024 + (ob ^ (((ob >> 9) & 1) << 5)); }
__device__ __forceinline__ void stage_rc(int b, int& R, int& C) { const int st = b / 1024, sb = b % 1024, swz = sb ^ (((sb >> 9) & 1) << 5); R = (st >> 1) * 16 + swz / 64; C = (st & 1) * 32 + (swz % 64) / 2; }
__device__ __forceinline__ int perm32(int rho) { const int n = rho >> 4, i = rho & 15; return 8 * (i >> 2) + 4 * n + (i & 3); }

struct Unit { int pm, pn, pn2, aux, e, r, slot; };

template <class Epi, class Sched, bool GATHER, bool SPLITB = false>
__device__ __forceinline__ void gemm_phase(LAS unsigned char* lds, const bf16_t* A, const bf16_t* Bt, const int K, const Sched& S, const Epi& E) {
    const int tid = opaque_tid(), wid = __builtin_amdgcn_readfirstlane(tid >> 6), lane = tid & 63, wr = wid >> 2, wc = wid & 3, fr = lane & 15, fq = lane >> 4;
    const int nt = K / BK, KB = SPLITB ? K / 2 : K, ntb = SPLITB ? nt / 2 : nt;
    unsigned voffB[2]; int RA[2], CA[2];
#pragma unroll
    for (int i = 0; i < 2; ++i) { int R, C; stage_rc(tid * 16 + i * 8192, R, C); const int Rb = Epi::PERM ? ((R & ~31) + perm32(R & 31)) : R;
        voffB[i] = (unsigned)(Rb * KB + C) * 2u; RA[i] = R; CA[i] = C; }
    const size_t kstep = (size_t)(BK * 2);
    const size_t hstep = (size_t)HALF * K * 2;
    const size_t tstep = 2 * hstep;
    const size_t hstepB = (size_t)HALF * KB * 2, tstepB = 2 * hstepB;
    const unsigned ldsw = (unsigned)wid * 1024u;
    const int aoff = lds_byte(wr * 64 + fr, fq * 8), boff = lds_byte(wc * 32 + fr, fq * 8);
#define PG8_SA(b, h) (((b) * 2 + (h)) * HTB)
#define PG8_SB(b, h) ((4 + (b) * 2 + (h)) * HTB)
#define PG8_STAGE(bufoff, gbase, voff) do { _Pragma("unroll") for (int _i = 0; _i < 2; ++_i) \
        __builtin_amdgcn_global_load_lds((const unsigned*)((const char*)(gbase) + (voff)[_i]), (LAS unsigned*)(lds + (bufoff) + ldsw + _i * 8192), 16, 0, 0); } while (0)
#define PG8_LDA(dst, b, h) do { _Pragma("unroll") for (int m = 0; m < 4; ++m) _Pragma("unroll") for (int k = 0; k < 2; ++k) dst[m][k] = *(const LAS bf16x8*)(lds + PG8_SA(b, h) + aoff + m * 2048 + k * 1024); } while (0)
#define PG8_LDB(dst, b, h) do { _Pragma("unroll") for (int n = 0; n < 2; ++n) _Pragma("unroll") for (int k = 0; k < 2; ++k) dst[n][k] = *(const LAS bf16x8*)(lds + PG8_SB(b, h) + boff + n * 2048 + k * 1024); } while (0)
#define PG8_MMA(ai, bj, At, Bt_) do { __builtin_amdgcn_s_setprio(1); _Pragma("unroll") for (int m = 0; m < 4; ++m) _Pragma("unroll") for (int n = 0; n < 2; ++n) _Pragma("unroll") for (int k = 0; k < 2; ++k) \
        acc[ai][bj][m][n] = __builtin_amdgcn_mfma_f32_16x16x32_bf16(Bt_[n][k], At[m][k], acc[ai][bj][m][n], 0, 0, 0); __builtin_amdgcn_s_setprio(0); } while (0)
#define PG8_WAIT_V(n) asm volatile("s_waitcnt vmcnt(" #n ")" ::: "memory")
#define PG8_WAIT_L(n) asm volatile("s_waitcnt lgkmcnt(" #n ")" ::: "memory")
#define PG8_BAR __builtin_amdgcn_s_barrier()
#define PG8_SCHED __builtin_amdgcn_sched_barrier(0)
    Unit cur, nxt; int ui = 0;
    if (!S.next(0, cur)) return;
    cur.slot = 0; S.prep(cur, tid);
    unsigned voA[2][2], voN[2][2];
    if constexpr (GATHER) S.rows(cur, RA, CA, K, voA);
    else {
#pragma unroll
        for (int h = 0; h < 2; ++h)
#pragma unroll
            for (int i = 0; i < 2; ++i) voA[h][i] = (unsigned)((h * HALF + RA[i]) * K + CA[i]) * 2u;
    }
    f32x4 acc[2][2][4][2];
#pragma unroll
    for (int a = 0; a < 2; ++a)
#pragma unroll
        for (int b = 0; b < 2; ++b)
#pragma unroll
            for (int m = 0; m < 4; ++m)
#pragma unroll
                for (int n = 0; n < 2; ++n) acc[a][b][m][n] = (f32x4){0.f, 0.f, 0.f, 0.f};
    bf16x8 At[4][2], B0[2][2], B1[2][2];
    const char* cA = GATHER ? (const char*)A : (const char*)A + (size_t)cur.pm * tstep;
    const char* cB = (const char*)Bt + (size_t)cur.pn * tstepB;
    const char* cB2 = SPLITB ? (const char*)Bt + (size_t)cur.pn2 * tstepB : cB;
    PG8_STAGE(PG8_SB(0, 0), cB, voffB); PG8_STAGE(PG8_SB(0, 1), cB + hstepB, voffB); PG8_STAGE(PG8_SA(0, 0), cA, voA[0]); PG8_STAGE(PG8_SA(0, 1), cA, voA[1]);
    if (wr == 1) PG8_BAR;
    PG8_WAIT_V(2); PG8_BAR;
    PG8_STAGE(PG8_SB(1, 0), cB + kstep, voffB); PG8_STAGE(PG8_SA(1, 0), cA + kstep, voA[0]); PG8_STAGE(PG8_SB(1, 1), cB + hstepB + kstep, voffB);
    PG8_WAIT_V(6); PG8_BAR;
    for (;;) {
        const bool has_next = S.next(ui + 1, nxt);
        if (has_next) { nxt.slot = (cur.slot == 2) ? 0 : cur.slot + 1; S.prep(nxt, tid); }
        const char* nA = cA; const char* nB = cB; const char* nB2 = cB2;
        if (has_next) { nA = GATHER ? (const char*)A : (const char*)A + (size_t)nxt.pm * tstep; nB = (const char*)Bt + (size_t)nxt.pn * tstepB; nB2 = SPLITB ? (const char*)Bt + (size_t)nxt.pn2 * tstepB : nB; }
        if constexpr (GATHER) {
            if (has_next) S.rows(nxt, RA, CA, K, voN);
            else {
#pragma unroll
                for (int h = 0; h < 2; ++h)
#pragma unroll
                    for (int i = 0; i < 2; ++i) voN[h][i] = voA[h][i];
            }
        }
#pragma unroll 1
        for (int t = 0; t < nt; t += 2) {
            const bool last = (t == nt - 2);
            const char* a1 = cA + (size_t)(t + 1) * kstep;
            const char* a2 = last ? nA : cA + (size_t)(t + 2) * kstep;
            const char* b2 = last ? nB : (SPLITB && t + 2 >= ntb) ? cB2 + (size_t)(t + 2 - ntb) * kstep : cB + (size_t)(t + 2) * kstep;
            const char* a3 = a2 + kstep; const char* b3 = b2 + kstep;
            unsigned sel[2][2];
#pragma unroll
            for (int h = 0; h < 2; ++h)
#pragma unroll
                for (int i = 0; i < 2; ++i) sel[h][i] = (GATHER && last) ? voN[h][i] : voA[h][i];
            PG8_LDB(B0, 0, 0); PG8_LDB(B1, 0, 1); PG8_SCHED; PG8_LDA(At, 0, 0); PG8_STAGE(PG8_SA(1, 1), a1, voA[1]);
            PG8_WAIT_V(8); PG8_WAIT_L(0); PG8_BAR; PG8_MMA(0, 0, At, B0); PG8_MMA(0, 1, At, B1); PG8_BAR; PG8_SCHED;
            PG8_LDA(At, 0, 1); PG8_STAGE(PG8_SB(0, 0), b2, voffB); PG8_STAGE(PG8_SB(0, 1), b2 + hstepB, voffB); PG8_STAGE(PG8_SA(0, 0), a2, sel[0]);
            PG8_WAIT_V(8); PG8_WAIT_L(0); PG8_BAR; PG8_MMA(1, 0, At, B0); PG8_MMA(1, 1, At, B1); PG8_BAR; PG8_SCHED;
            PG8_LDB(B0, 1, 0); PG8_LDB(B1, 1, 1); PG8_SCHED; PG8_LDA(At, 1, 0); PG8_STAGE(PG8_SA(0, 1), a2, sel[1]);
            PG8_WAIT_V(8); PG8_WAIT_L(0); PG8_BAR; PG8_MMA(0, 0, At, B0); PG8_MMA(0, 1, At, B1); PG8_BAR; PG8_SCHED;
            PG8_LDA(At, 1, 1); PG8_STAGE(PG8_SB(1, 0), b3, voffB); PG8_STAGE(PG8_SB(1, 1), b3 + hstepB, voffB); PG8_STAGE(PG8_SA(1, 0), a3, sel[0]);
            PG8_WAIT_V(8); PG8_WAIT_L(0); PG8_BAR; PG8_MMA(1, 0, At, B0); PG8_MMA(1, 1, At, B1); PG8_BAR; PG8_SCHED;
        }
        if constexpr (Epi::ALIGN) { if (wr == 0) PG8_BAR; }
        E(acc, cur, wr, wc, fr, fq);
        if (!has_next) break;
#pragma unroll
        for (int a = 0; a < 2; ++a)
#pragma unroll
            for (int b = 0; b < 2; ++b)
#pragma unroll
                for (int m = 0; m < 4; ++m)
#pragma unroll
                    for (int n = 0; n < 2; ++n) acc[a][b][m][n] = (f32x4){0.f, 0.f, 0.f, 0.f};
        cur = nxt; cA = nA; cB = nB; cB2 = nB2; ++ui;
        if constexpr (GATHER) {
#pragma unroll
            for (int h = 0; h < 2; ++h)
#pragma unroll
                for (int i = 0; i < 2; ++i) voA[h][i] = voN[h][i];
        }
        if constexpr (Epi::ALIGN) { if (wr == 1) PG8_BAR; }
    }
    PG8_WAIT_V(0);
    if constexpr (!Epi::ALIGN) { if (wr == 0) PG8_BAR; }
    PG8_BAR;
#undef PG8_SA
#undef PG8_SB
#undef PG8_STAGE
#undef PG8_LDA
#undef PG8_LDB
#undef PG8_MMA
#undef PG8_WAIT_V
#undef PG8_WAIT_L
#undef PG8_BAR
#undef PG8_SCHED
}

struct SchedGrid {
    int nN, total, G, c;
    __device__ __forceinline__ bool next(int i, Unit& u) const { const int L = i * G + c; if (L >= total) return false; u.pm = L / nN; u.pn = L % nN; u.pn2 = 0; u.aux = u.pn; u.e = 0; u.r = 0; return true; }
    __device__ __forceinline__ void prep(const Unit&, int) const {}
};
struct SchedInProj0 {
    int G, c;
    __device__ __forceinline__ bool next(int i, Unit& u) const { const int L = i * G + c; if (L >= 648) return false;
        if (L < 640) { u.pm = L / 5; u.pn = L % 5; } else { u.pm = 128 + (L - 640); u.pn = 2; } u.pn2 = 0; u.aux = u.pn; u.e = 0; u.r = 0; return true; }
    __device__ __forceinline__ void prep(const Unit&, int) const {}
};
struct SchedMoE {
    const volatile LAS int* tp; const int* list; int G, c; bool down; const f32x2* wslot; LAS unsigned char* side;
    __device__ __forceinline__ void prep(const Unit& u, int tid) const {
        if (tid < 256) { const int idx = u.r * 256 + tid; const bool ok = idx < tp[NCLS + 1 + u.e];
            ((LAS int*)(side + u.slot * 3072))[tid] = ok ? list[u.e * LISTCAP + idx] : -1;
            if (!down) ((LAS f32x2*)(side + u.slot * 3072 + 1024))[tid] = ok ? wslot[(size_t)u.e * LISTCAP + idx] : (f32x2){0.f, 0.f}; }
    }
    __device__ __forceinline__ bool next(int i, Unit& u) const {
        const int L = i * G + c; const int total = tp[NCLS] * 4; if (L >= total) return false;
        const int rt = L >> 2, ct = L & 3; int cl = 0;
#pragma unroll
        for (int j = 1; j < NCLS; ++j) cl += (rt >= tp[j]) ? 1 : 0;
        cl = __builtin_amdgcn_readfirstlane(cl);
        const int g = cl / 6, p = cl % 6; const int lo = (p < 3) ? 0 : (p < 5) ? 1 : 2, hi = (p < 3) ? p + 1 : (p < 5) ? p - 1 : 3;
        const int elo = 4 * g + lo, ehi = 4 * g + hi;
        u.pm = rt; u.aux = ct; u.e = cl; u.r = rt - tp[cl];
        if (down) { u.pn = elo * 4 + ct; u.pn2 = ehi * 4 + ct; }
        else { u.pn = ((ct < 2) ? elo : ehi) * 2 + (ct & 1); u.pn2 = 0; }
        return true;
    }
    __device__ __forceinline__ void rows(const Unit& u, const int (&RA)[2], const int (&CA)[2], int K, unsigned (&vo)[2][2]) const {
        const int cnt = tp[NCLS + 1 + u.e];
#pragma unroll
        for (int h = 0; h < 2; ++h)
#pragma unroll
            for (int i = 0; i < 2; ++i) { const int idx = u.r * 256 + h * HALF + RA[i]; const int tok = (idx < cnt) ? list[u.e * LISTCAP + idx] : 0;
                vo[h][i] = (unsigned)(tok * K + CA[i]) * 2u; }
    }
};

typedef f32x4 Acc[2][2][4][2];
struct EpiBf16 {
    static constexpr bool PERM = true, ALIGN = true;
    bf16_t* O; int ldc; bool use_aux;
    __device__ __forceinline__ void operator()(const Acc& acc, const Unit& u, int wr, int wc, int fr_, int fq_) const {
        int ln_ = fr_ | (fq_ << 4); asm volatile("" : "+v"(ln_)); const int fr = ln_ & 15, fq = ln_ >> 4;
        const int row0 = u.pm * BM + wr * 64 + fr; const int col0 = (use_aux ? u.aux : u.pn) * BM + wc * 32 + 8 * fq;
#pragma unroll
        for (int ai = 0; ai < 2; ++ai)
#pragma unroll
            for (int m = 0; m < 4; ++m) { bf16_t* rowp = O + (size_t)(row0 + ai * HALF + m * 16) * ldc + col0;
#pragma unroll
                for (int bj = 0; bj < 2; ++bj) { const f32x4 v0 = acc[ai][bj][m][0], v1 = acc[ai][bj][m][1];
                    u32x4 w; w.x = cvt_pk_bf16(v0[0], v0[1]); w.y = cvt_pk_bf16(v0[2], v0[3]); w.z = cvt_pk_bf16(v1[0], v1[1]); w.w = cvt_pk_bf16(v1[2], v1[3]);
                    *(u32x4*)(rowp + bj * HALF) = w; } }
    }
};
struct EpiGateUp {
    static constexpr bool PERM = true, ALIGN = true;
    bf16_t* O; LAS unsigned char* side;
    __device__ __forceinline__ void operator()(const Acc& acc, const Unit& u, int wr, int wc, int fr_, int fq_) const {
        int ln_ = fr_ | (fq_ << 4); asm volatile("" : "+v"(ln_)); const int fr = ln_ & 15, fq = ln_ >> 4;
        const int row0 = u.pm * BM + wr * 64 + fr; const int col0 = u.aux * HALF + wc * 32 + 8 * fq;
        const LAS float* wp = (const LAS float*)(side + u.slot * 3072 + 1024) + 2 * (wr * 64 + fr) + ((u.aux < 2) ? 0 : 1);
#pragma unroll
        for (int ai = 0; ai < 2; ++ai)
#pragma unroll
            for (int m = 0; m < 4; ++m) { const int rl = ai * HALF + m * 16; bf16_t* rowp = O + (size_t)(row0 + rl) * 512 + col0;
                const float w = wp[2 * rl];
                float o[8];
#pragma unroll
                for (int n = 0; n < 2; ++n)
#pragma unroll
                    for (int j = 0; j < 4; ++j) o[n * 4 + j] = w * silu_f(acc[ai][0][m][n][j]) * acc[ai][1][m][n][j];
                u32x4 wv; wv.x = cvt_pk_bf16(o[0], o[1]); wv.y = cvt_pk_bf16(o[2], o[3]); wv.z = cvt_pk_bf16(o[4], o[5]); wv.w = cvt_pk_bf16(o[6], o[7]);
                *(u32x4*)rowp = wv; }
    }
};
template <bool FINAL> struct EpiCombine {
    static constexpr bool PERM = true, ALIGN = true;
    bf16_t* H; float* out; const float* gate; LAS unsigned char* side;
    __device__ __forceinline__ void operator()(const Acc& acc, const Unit& u, int wr, int wc, int fr_, int fq_) const {
        int ln_ = fr_ | (fq_ << 4); asm volatile("" : "+v"(ln_)); const int fr = ln_ & 15, fq = ln_ >> 4;
        const int col0 = u.aux * BM + wc * 32 + 8 * fq;
        const LAS int* tk = (const LAS int*)(side + u.slot * 3072) + wr * 64 + fr;
#pragma unroll
        for (int ai = 0; ai < 2; ++ai)
#pragma unroll
          for (int mp = 0; mp < 4; mp += 2) {
            int tok[2]; u32x4 hw[2][2]; f32x4 gg[2][2][2];
#pragma unroll
            for (int mm = 0; mm < 2; ++mm) { tok[mm] = tk[ai * HALF + (mp + mm) * 16]; const int tc = tok[mm] < 0 ? 0 : tok[mm];
                const float* gb = gate + (size_t)(tc >> 12) * 6144 + col0; const size_t off = (size_t)tc * DM + col0;
#pragma unroll
                for (int bj = 0; bj < 2; ++bj) { hw[mm][bj] = *(const u32x4*)(H + off + bj * HALF); gg[mm][bj][0] = *(const f32x4*)(gb + bj * HALF); gg[mm][bj][1] = *(const f32x4*)(gb + bj * HALF + 4); } }
#pragma unroll
            for (int mm = 0; mm < 2; ++mm) { const int m = mp + mm; const size_t off = (size_t)(tok[mm] < 0 ? 0 : tok[mm]) * DM + col0;
#pragma unroll
                for (int bj = 0; bj < 2; ++bj) { const u32x4 w = hw[mm][bj];
                    const f32x4 h0 = (f32x4){bf_lo(w.x), bf_hi(w.x), bf_lo(w.y), bf_hi(w.y)} + gg[mm][bj][0] * acc[ai][bj][m][0], h1 = (f32x4){bf_lo(w.z), bf_hi(w.z), bf_lo(w.w), bf_hi(w.w)} + gg[mm][bj][1] * acc[ai][bj][m][1];
                    if (tok[mm] >= 0) {
                        if constexpr (FINAL) { *(f32x4*)(out + off + bj * HALF) = h0; *(f32x4*)(out + off + bj * HALF + 4) = h1; }
                        else { u32x4 o; o.x = cvt_pk_bf16(h0[0], h0[1]); o.y = cvt_pk_bf16(h0[2], h0[3]); o.z = cvt_pk_bf16(h1[0], h1[1]); o.w = cvt_pk_bf16(h1[2], h1[3]); *(u32x4*)(H + off + bj * HALF) = o; } } } }
          }
    }
};
template <bool IN_F32> struct EpiResid {
    static constexpr bool PERM = true, ALIGN = true;
    const void* Hin; bf16_t* Hout; const float* gate;
    __device__ __forceinline__ void operator()(const Acc& acc, const Unit& u, int wr, int wc, int fr_, int fq_) const {
        int ln_ = fr_ | (fq_ << 4); asm volatile("" : "+v"(ln_)); const int fr = ln_ & 15, fq = ln_ >> 4;
        const int b = u.pm >> 4; const int col0 = u.pn * BM + wc * 32 + 8 * fq; const float* gb = gate + (size_t)b * 6144 + col0;
        f32x4 gv[2][2];
#pragma unroll
        for (int bj = 0; bj < 2; ++bj)
#pragma unroll
            for (int n = 0; n < 2; ++n) gv[bj][n] = *(const f32x4*)(gb + bj * HALF + 4 * n);
#pragma unroll
        for (int ai = 0; ai < 2; ++ai)
#pragma unroll
            for (int m = 0; m < 4; ++m) { const size_t off = (size_t)(u.pm * BM + ai * HALF + wr * 64 + m * 16 + fr) * DM + col0;
#pragma unroll
                for (int bj = 0; bj < 2; ++bj) { f32x4 h0, h1;
                    if constexpr (IN_F32) { h0 = *(const f32x4*)((const float*)Hin + off + bj * HALF); h1 = *(const f32x4*)((const float*)Hin + off + bj * HALF + 4); }
                    else { const u32x4 w = *(const u32x4*)((const bf16_t*)Hin + off + bj * HALF); h0 = (f32x4){bf_lo(w.x), bf_hi(w.x), bf_lo(w.y), bf_hi(w.y)}; h1 = (f32x4){bf_lo(w.z), bf_hi(w.z), bf_lo(w.w), bf_hi(w.w)}; }
                    h0 = h0 + gv[bj][0] * acc[ai][bj][m][0]; h1 = h1 + gv[bj][1] * acc[ai][bj][m][1];
                    u32x4 o; o.x = cvt_pk_bf16(h0[0], h0[1]); o.y = cvt_pk_bf16(h0[2], h0[3]); o.z = cvt_pk_bf16(h1[0], h1[1]); o.w = cvt_pk_bf16(h1[2], h1[3]);
                    *(u32x4*)(Hout + off + bj * HALF) = o; } }
    }
};
struct EpiQKV {
    static constexpr bool PERM = true, ALIGN = true;
    bf16_t *Q, *Kb, *Vb, *P; const float *qg, *kg;
    __device__ __forceinline__ void operator()(const Acc& acc, const Unit& u, int wr, int wc, int fr_, int fq_) const {
        int ln_ = fr_ | (fq_ << 4); asm volatile("" : "+v"(ln_)); const int fr = ln_ & 15, fq = ln_ >> 4;
        const int pn = u.pn; const bool isctx = u.pm >= 128;
        const int rloc0 = wr * 64 + fr;
        if (pn >= 3) {
#pragma unroll
            for (int ai = 0; ai < 2; ++ai)
#pragma unroll
                for (int m = 0; m < 4; ++m) { bf16_t* rowp = P + (size_t)(u.pm * BM + rloc0 + ai * HALF + m * 16) * 512 + (pn - 3) * BM + wc * 32 + 8 * fq;
#pragma unroll
                    for (int bj = 0; bj < 2; ++bj) { const f32x4 v0 = acc[ai][bj][m][0], v1 = acc[ai][bj][m][1];
                        u32x4 w; w.x = cvt_pk_bf16(v0[0], v0[1]); w.y = cvt_pk_bf16(v0[2], v0[3]); w.z = cvt_pk_bf16(v1[0], v1[1]); w.w = cvt_pk_bf16(v1[2], v1[3]);
                        *(u32x4*)(rowp + bj * HALF) = w; } }
            return;
        }
        if (pn == 2 && wc >= 2) {
            const int vh = wc - 2;
#pragma unroll
            for (int ai = 0; ai < 2; ++ai)
#pragma unroll
                for (int m = 0; m < 4; ++m) { const int rl = rloc0 + ai * HALF + m * 16; int b, krow;
                    if (isctx) { const int cr = (u.pm - 128) * BM + rl; b = cr >> 8; krow = cr & 255; } else { const int mt = u.pm * BM + rl; b = mt >> 12; krow = CTX + (mt & 4095); }
                    bf16_t* rowp = Vb + ((size_t)(b * 2 + vh) * NKV + krow) * 64 + 8 * fq;
#pragma unroll
                    for (int bj = 0; bj < 2; ++bj) { const f32x4 v0 = acc[ai][bj][m][0], v1 = acc[ai][bj][m][1];
                        u32x4 w; w.x = cvt_pk_bf16(v0[0], v0[1]); w.y = cvt_pk_bf16(v0[2], v0[3]); w.z = cvt_pk_bf16(v1[0], v1[1]); w.w = cvt_pk_bf16(v1[2], v1[3]);
                        *(u32x4*)(rowp + bj * 32) = w; } }
            return;
        }
        const bool isq = pn < 2; const int head = isq ? pn * 4 + wc : wc;
        const float* gsrc = (isq ? qg : kg) + 32 * (fq >> 1) + 8 * (fq & 1);
        float g1[8], g2[8], inv[8];
#pragma unroll
        for (int j = 0; j < 8; ++j) { g1[j] = gsrc[j]; g2[j] = gsrc[16 + j];
            inv[j] = __builtin_amdgcn_exp2f(-(float)(8 * (fq & 1) + j) * (13.287712379549449f / 16.0f)) * 0.15915494309189535f; }
        const float osc = isq ? C2 : 1.0f;
#pragma unroll
        for (int ai = 0; ai < 2; ++ai)
#pragma unroll
            for (int m = 0; m < 4; ++m) {
                const int rl = rloc0 + ai * HALF + m * 16;
                float x1[8], x2[8];
#pragma unroll
                for (int n = 0; n < 2; ++n)
#pragma unroll
                    for (int j = 0; j < 4; ++j) { x1[n * 4 + j] = acc[ai][0][m][n][j]; x2[n * 4 + j] = acc[ai][1][m][n][j]; }
                float ss = 0.f;
#pragma unroll
                for (int j = 0; j < 8; ++j) ss += x1[j] * x1[j] + x2[j] * x2[j];
                ss += __shfl_xor(ss, 16); ss += __shfl_xor(ss, 32);
                const float rstd = __builtin_amdgcn_rsqf(ss * (1.0f / 64.0f) + EPS) * osc;
                int b, krow, mt = 0; float pos = 0.f;
                if (isctx) { const int cr = (u.pm - 128) * BM + rl; b = cr >> 8; krow = cr & 255; }
                else { mt = u.pm * BM + rl; b = mt >> 12; const int t = mt & 4095; krow = CTX + t; pos = (float)((fq >> 1) ? (t & 63) : (t >> 6)); }
                float o1[8], o2[8];
#pragma unroll
                for (int j = 0; j < 8; ++j) { const float y1 = x1[j] * rstd * g1[j], y2 = x2[j] * rstd * g2[j];
                    if (isctx) { o1[j] = y1; o2[j] = y2; }
                    else { const float rev = pos * inv[j]; const float cs = __builtin_amdgcn_cosf(rev), sn = __builtin_amdgcn_sinf(rev);
                        o1[j] = y1 * cs - y2 * sn; o2[j] = y2 * cs + y1 * sn; } }
                bf16_t* rowp = isq ? (Q + (size_t)mt * 512 + head * 64 + 8 * fq) : (Kb + ((size_t)(b * 2 + head) * NKV + krow) * 64 + 8 * fq);
                u32x4 w; w.x = cvt_pk_bf16(o1[0], o1[1]); w.y = cvt_pk_bf16(o1[2], o1[3]); w.z = cvt_pk_bf16(o1[4], o1[5]); w.w = cvt_pk_bf16(o1[6], o1[7]);
                *(u32x4*)rowp = w;
                w.x = cvt_pk_bf16(o2[0], o2[1]); w.y = cvt_pk_bf16(o2[2], o2[3]); w.z = cvt_pk_bf16(o2[4], o2[5]); w.w = cvt_pk_bf16(o2[6], o2[7]);
                *(u32x4*)(rowp + 32) = w;
            }
    }
};
}

namespace attn_body {
constexpr int NW = 8, QBLK = 32, QB = QBLK * NW, KVBLK = 64, NT = NKV / KVBLK;
constexpr int QP = 512, KP = 64, OP = 1024;
static_assert(NT % 2 == 0 && NT >= 8, "tile count");
__device__ __forceinline__ int crow(int r, int hi) { return (r & 3) + 8 * (r >> 2) + 4 * hi; }
#define SBAR() __builtin_amdgcn_sched_barrier(0)
constexpr int NSLOT = 3, SLOTB = 8192;
constexpr int LDS_K = 0, LDS_V = NSLOT * SLOTB, LDS_WS = 2 * NSLOT * SLOTB, LDS_OST = LDS_WS + NW * 64 * 4, ATT_LDS_BYTES = LDS_OST + NW * 4096;
__device__ __forceinline__ void glds16(const void* gsrc, unsigned lds_dst) { unsigned keep;
    asm volatile("s_mov_b32 %0, m0\n\ts_mov_b32 m0, %2\n\ts_nop 0\n\tglobal_load_lds_dwordx4 %1, off\n\ts_mov_b32 m0, %0" : "=&s"(keep) : "v"(gsrc), "s"(lds_dst) : "memory"); }
__device__ __forceinline__ float max3f(float a, float b, float c) { float r; asm("v_max3_f32 %0, %1, %2, %3" : "=v"(r) : "v"(a), "v"(b), "v"(c)); return r; }
__device__ __forceinline__ float max2f(float a, float b) { float r; asm("v_max_f32_e32 %0, %1, %2" : "=v"(r) : "v"(a), "v"(b)); return r; }
__device__ __forceinline__ float fadd_s(float a, float b) { float r; asm("v_add_f32_e32 %0, %1, %2" : "=v"(r) : "v"(a), "v"(b)); return r; }
__device__ __forceinline__ float fsub_s(float a, float b) { float r; asm("v_sub_f32_e32 %0, %1, %2" : "=v"(r) : "v"(a), "v"(b)); return r; }
typedef __bf16 bf16x2_t __attribute__((ext_vector_type(2)));
__device__ __forceinline__ unsigned cvtpk_s(float lo, float hi) { f32x2 v = {lo, hi}; bf16x2_t b = __builtin_convertvector(v, bf16x2_t); return __builtin_bit_cast(unsigned, b); }
#define WAIT_BAR(N) asm volatile("s_waitcnt vmcnt(" #N ") lgkmcnt(0)\n\ts_barrier" ::: "memory")
__device__ __forceinline__ void qkt(f32x16& p0, f32x16& p1, const char* Kslot, const bf16x8* qr, const f32x16& negm, int r32, int hi) {
    const char* kb = Kslot + hi * 1024 + r32 * 16;
#pragma unroll
    for (int d0 = 0; d0 < 4; ++d0) {
        const bf16x8 b0 = *reinterpret_cast<const bf16x8*>(kb + d0 * 2048);
        const bf16x8 b1 = *reinterpret_cast<const bf16x8*>(kb + d0 * 2048 + 512);
        if (d0 == 0) { p0 = __builtin_amdgcn_mfma_f32_32x32x16_bf16(b0, qr[0], negm, 0, 0, 0); p1 = __builtin_amdgcn_mfma_f32_32x32x16_bf16(b1, qr[0], negm, 0, 0, 0); }
        else { p0 = __builtin_amdgcn_mfma_f32_32x32x16_bf16(b0, qr[d0], p0, 0, 0, 0); p1 = __builtin_amdgcn_mfma_f32_32x32x16_bf16(b1, qr[d0], p1, 0, 0, 0); } }
}
typedef __attribute__((address_space(3))) const char* lds_cptr;
typedef short v4i16_t __attribute__((ext_vector_type(4)));
__device__ __forceinline__ void kload8(bf16x8* kf, lds_cptr kp) {
    kf[0] = *(const LAS bf16x8*)(kp);        kf[1] = *(const LAS bf16x8*)(kp + 512);
    kf[2] = *(const LAS bf16x8*)(kp + 2048); kf[3] = *(const LAS bf16x8*)(kp + 2560);
    kf[4] = *(const LAS bf16x8*)(kp + 4096); kf[5] = *(const LAS bf16x8*)(kp + 4608);
    kf[6] = *(const LAS bf16x8*)(kp + 6144); kf[7] = *(const LAS bf16x8*)(kp + 6656);
}
__device__ __forceinline__ void kload2(bf16x8* kf, lds_cptr kp, int j) { kf[2 * j] = *(const LAS bf16x8*)(kp + j * 2048); kf[2 * j + 1] = *(const LAS bf16x8*)(kp + j * 2048 + 512); }
__device__ __forceinline__ s16x4 vtr(lds_cptr p) { return __builtin_bit_cast(s16x4, __builtin_amdgcn_ds_read_tr16_b64_v4i16((LAS v4i16_t*)p)); }
__device__ __forceinline__ float rowmax(const f32x16& p0, const f32x16& p1) {
    float a = max3f(p0[0], p0[1], p1[0]), b = max3f(p0[2], p0[3], p1[1]); a = max3f(a, p1[2], p1[3]);
#pragma unroll
    for (int r = 4; r < 16; r += 4) { a = max3f(a, p0[r], p0[r + 1]); b = max3f(b, p0[r + 2], p0[r + 3]); a = max3f(a, p1[r], p1[r + 1]); b = max3f(b, p1[r + 2], p1[r + 3]); }
    const float m = max2f(a, b);
    auto rr = __builtin_amdgcn_permlane32_swap(__float_as_uint(m), __float_as_uint(m), false, false);
    return max2f(__uint_as_float(rr[0]), __uint_as_float(rr[1]));
}
__device__ __forceinline__ void pv(f32x16* o, int vb, bf16x8 pa0, bf16x8 pa1, bf16x8 pa2, bf16x8 pa3) {
#pragma unroll
    for (int d0 = 0; d0 < 2; ++d0) { s16x4 lo[4], hi[4];
#pragma unroll
        for (int ks = 0; ks < 4; ++ks) {
            asm volatile("ds_read_b64_tr_b16 %0,%1 offset:%c2" : "=&v"(lo[ks]) : "v"(vb), "i"(d0 * 4096 + ks * 1024) : "memory");
            asm volatile("ds_read_b64_tr_b16 %0,%1 offset:%c2" : "=&v"(hi[ks]) : "v"(vb), "i"(d0 * 4096 + ks * 1024 + 512) : "memory"); }
        asm volatile("s_waitcnt lgkmcnt(0)" ::: "memory"); SBAR();
#define PK(k) (bf16x8){lo[k][0], lo[k][1], lo[k][2], lo[k][3], hi[k][0], hi[k][1], hi[k][2], hi[k][3]}
        o[d0] = __builtin_amdgcn_mfma_f32_32x32x16_bf16(pa0, PK(0), o[d0], 0, 0, 0);
        o[d0] = __builtin_amdgcn_mfma_f32_32x32x16_bf16(pa1, PK(1), o[d0], 0, 0, 0);
        o[d0] = __builtin_amdgcn_mfma_f32_32x32x16_bf16(pa2, PK(2), o[d0], 0, 0, 0);
        o[d0] = __builtin_amdgcn_mfma_f32_32x32x16_bf16(pa3, PK(3), o[d0], 0, 0, 0);
#undef PK
    }
}
template <int THRL> __device__ __forceinline__ void attn_unit(int b, int h, int qb, const bf16_t* Q, const bf16_t* __restrict__ K, const bf16_t* __restrict__ V, bf16_t* O, char* shm) {
    const int tid = opaque_tid(), lane = tid & 63, r32 = lane & 31, hi = lane >> 5; const int wid = __builtin_amdgcn_readfirstlane(tid >> 6);
    const long rowq = (long)b * SEQ + qb * QB + wid * QBLK;
    const bf16_t* Qw = Q + rowq * QP + h * 64;
    const bf16_t* Kh = K + (long)(b * 2 + (h >> 2)) * NKV * KP, *Vh = V + (long)(b * 2 + (h >> 2)) * NKV * KP;
    const unsigned lds0 = (unsigned)(uintptr_t)shm;
    float* wsf = (float*)(shm + LDS_WS) + wid * 64;
    const bf16_t* ksrc = Kh + (long)lane * KP + wid * 8;
    const bf16_t* vsrc = Vh + (long)(16 * (wid & 3) + (lane >> 2)) * KP + (wid >> 2) * 32 + (lane & 3) * 8;
    const unsigned kdst = lds0 + LDS_K + wid * 1024, vdst = lds0 + LDS_V + wid * 1024;
#define DMA_K(t, slot) glds16(ksrc + (long)(t) * KVBLK * KP, (unsigned)__builtin_amdgcn_readfirstlane(kdst + (slot)))
#define DMA_V(t, slot) glds16(vsrc + (long)(t) * KVBLK * KP, (unsigned)__builtin_amdgcn_readfirstlane(vdst + (slot)))
    const int vb0 = (int)(lds0 + LDS_V) + ((lane >> 4) & 1) * 32 + (lane & 3) * 8 + (4 * hi + ((lane & 15) >> 2)) * 64;
    const char* Kbase = shm + LDS_K; bf16x8 kf[8];
    const lds_cptr shm3 = (lds_cptr)shm; const lds_cptr kp0 = shm3 + LDS_K + hi * 1024 + r32 * 16; const lds_cptr vp0 = shm3 + LDS_V + ((lane >> 4) & 1) * 32 + (lane & 3) * 8 + (4 * hi + ((lane & 15) >> 2)) * 64;
    DMA_K(0, 0); DMA_V(0, 0); DMA_K(1, SLOTB);
    bf16x8 qr[4];
#pragma unroll
    for (int d0 = 0; d0 < 4; ++d0) qr[d0] = *reinterpret_cast<const bf16x8*>(&Qw[(long)r32 * QP + d0 * 16 + hi * 8]);
    float mhat = 0.f, l_reg = 0.f; f32x16 o[2]; o[0] = f32x16{}; o[1] = f32x16{}; f32x16 negm = f32x16{}; asm volatile("" : "+v"(negm));
    bool resc = false;
#define START(P0, P1) do { const float rm = rowmax(P0, P1); resc = false; \
    { const float dl = rm; mhat = fadd_s(mhat, dl); \
      _Pragma("unroll") for (int r = 0; r < 16; ++r) { P0[r] = fsub_s(P0[r], dl); P1[r] = fsub_s(P1[r], dl); } \
      _Pragma("unroll") for (int r = 0; r < 16; ++r) negm[r] = -mhat; asm volatile("" : "+v"(negm)); } \
    _Pragma("unroll") for (int r = 0; r < 16; ++r) P0[r] = __builtin_amdgcn_exp2f(P0[r]); } while (0)
#define RESC() do { if (resc) { asm volatile("s_waitcnt lgkmcnt(0)" ::: "memory"); \
      _Pragma("unroll") for (int d_ = 0; d_ < 2; ++d_) _Pragma("unroll") for (int r = 0; r < 16; ++r) o[d_][r] *= wsf[crow(r, hi)]; } } while (0)
    f32x16 pA0, pA1, pB0, pB1;
    int sl_prev = 0, sl_cur = 0, sl_next = SLOTB;
#define ROT() do { sl_prev = sl_cur; sl_cur = sl_next; sl_next = (sl_next == (NSLOT - 1) * SLOTB) ? 0 : sl_next + SLOTB; } while (0)
    DMA_K(2, 2 * SLOTB);
    WAIT_BAR(3);
    qkt(pA0, pA1, Kbase, qr, negm, r32, hi); asm volatile("s_nop 15\n\ts_nop 7" : "+v"(pA0), "+v"(pA1));
    START(pA0, pA1);
    _Pragma("unroll") for (int r = 0; r < 16; ++r) pA1[r] = __builtin_amdgcn_exp2f(pA1[r]);
    WAIT_BAR(0);
    DMA_K(3, 0); DMA_V(1, SLOTB);
    ROT();
    kload8(kf, kp0 + sl_cur);
    WAIT_BAR(2);
    s16x4 vlo[8], vhi[8]; u32x4 pw0, pw1, pw2, pw3;
#define PKW(P, B) cvtpk_s(P[B], P[B + 1])
#define PAF(k) __builtin_bit_cast(bf16x8, pw##k)
#define VFR(i) (bf16x8){vlo[i][0], vlo[i][1], vlo[i][2], vlo[i][3], vhi[i][0], vhi[i][1], vhi[i][2], vhi[i][3]}
#define PIN(x) asm volatile("" : "+v"(x))
#define MX3(a, b, c) __builtin_fmaxf(__builtin_fmaxf((a), (b)), (c))
#define GAPA(MF, A0, A1, A2, A3, W0, W1, PW) do { MF; sacc += A0; sacc += A1; sacc += A2; sacc += A3; PIN(sacc); W0; W1; PIN(PW); SBAR(); } while (0)
#define EX(v) __builtin_amdgcn_exp2f(v)
#define GAPB(MF, X, B) do { MF; X[B] = EX(X[B]); X[B + 1] = EX(X[B + 1]); X[B + 2] = EX(X[B + 2]); X[B + 3] = EX(X[B + 3]); PIN(X); SBAR(); } while (0)
#define VRD(i) do { vlo[i] = vtr(vp_ + (((i) >> 2) * 4096 + ((i) & 3) * 1024)); vhi[i] = vtr(vp_ + (((i) >> 2) * 4096 + ((i) & 3) * 1024 + 512)); } while (0)
#define KRD(G, j) do { if (G) { kload2(kf, kp0 + sl_next, j); SBAR(); } } while (0)
#define STEP(C0, C1, P0, P1, t, GK, GV, GL) do { SBAR(); \
    const lds_cptr vp_ = vp0 + sl_prev; \
    VRD(0); SBAR(); float sacc = (P0[0] + P0[1]); \
    GAPA(C0 = __builtin_amdgcn_mfma_f32_32x32x16_bf16(kf[0], qr[0], negm, 0, 0, 0), P0[2], P0[3], P0[4], P0[5],     pw0[0] = PKW(P0, 0), pw0[1] = PKW(P0, 2), pw0); \
    VRD(4); SBAR(); GAPA(C1 = __builtin_amdgcn_mfma_f32_32x32x16_bf16(kf[1], qr[0], negm, 0, 0, 0), P0[6], P0[7], P0[8], P0[9],     pw0[2] = PKW(P0, 4), pw0[3] = PKW(P0, 6), pw0); \
    VRD(1); SBAR(); GAPA(C0 = __builtin_amdgcn_mfma_f32_32x32x16_bf16(kf[2], qr[1], C0, 0, 0, 0),   P0[10], P0[11], P0[12], P0[13], pw1[0] = PKW(P0, 8), pw1[1] = PKW(P0, 10), pw1); \
    VRD(5); SBAR(); GAPA(C1 = __builtin_amdgcn_mfma_f32_32x32x16_bf16(kf[3], qr[1], C1, 0, 0, 0),   P0[14], P0[15], P1[0], P1[1],   pw1[2] = PKW(P0, 12), pw1[3] = PKW(P0, 14), pw1); \
    VRD(2); SBAR(); GAPA(C0 = __builtin_amdgcn_mfma_f32_32x32x16_bf16(kf[4], qr[2], C0, 0, 0, 0),   P1[2], P1[3], P1[4], P1[5],     pw2[0] = PKW(P1, 0), pw2[1] = PKW(P1, 2), pw2); \
    VRD(6); SBAR(); GAPA(C1 = __builtin_amdgcn_mfma_f32_32x32x16_bf16(kf[5], qr[2], C1, 0, 0, 0),   P1[6], P1[7], P1[8], P1[9],     pw2[2] = PKW(P1, 4), pw2[3] = PKW(P1, 6), pw2); \
    VRD(3); SBAR(); GAPA(C0 = __builtin_amdgcn_mfma_f32_32x32x16_bf16(kf[6], qr[3], C0, 0, 0, 0),   P1[10], P1[11], P1[12], P1[13], pw3[0] = PKW(P1, 8), pw3[1] = PKW(P1, 10), pw3); \
    VRD(7); SBAR(); GAPA(C1 = __builtin_amdgcn_mfma_f32_32x32x16_bf16(kf[7], qr[3], C1, 0, 0, 0),   P1[14], P1[15], 0.f, 0.f,       pw3[2] = PKW(P1, 12), pw3[3] = PKW(P1, 14), pw3); \
    l_reg += sacc; \
    if (GK) { DMA_K((t) + 3, sl_cur); } if (GV) { DMA_V((t) + 1, sl_next); } \
    { float a = MX3(C0[0], C0[1], C1[0]), b_ = MX3(C0[2], C0[3], C1[1]); a = MX3(a, C1[2], C1[3]); \
      _Pragma("unroll") for (int r = 4; r < 16; r += 4) { a = MX3(a, C0[r], C0[r + 1]); b_ = MX3(b_, C0[r + 2], C0[r + 3]); a = MX3(a, C1[r], C1[r + 1]); b_ = MX3(b_, C1[r + 2], C1[r + 3]); } \
      float rm = __builtin_fmaxf(a, b_); { auto rr = __builtin_amdgcn_permlane32_swap(__float_as_uint(rm), __float_as_uint(rm), false, false); rm = __builtin_fmaxf(__uint_as_float(rr[0]), __uint_as_float(rr[1])); } \
      resc = false; \
      if (__builtin_expect(__any(rm > (float)THRL), 0)) { const float dl = __builtin_fmaxf(rm, 0.f); mhat += dl; \
        _Pragma("unroll") for (int r = 0; r < 16; ++r) { C0[r] -= dl; C1[r] -= dl; } \
        _Pragma("unroll") for (int r = 0; r < 16; ++r) negm[r] = -mhat; asm volatile("" : "+v"(negm)); \
        const float f = __builtin_amdgcn_exp2f(-dl); l_reg *= f; if (hi == 0) wsf[r32] = f; resc = true; } } \
    SBAR(); \
    GAPB(o[0] = __builtin_amdgcn_mfma_f32_32x32x16_bf16(PAF(0), VFR(0), o[0], 0, 0, 0), C0, 0); \
    GAPB(o[1] = __builtin_amdgcn_mfma_f32_32x32x16_bf16(PAF(0), VFR(4), o[1], 0, 0, 0), C0, 4); \
    KRD(GL, 0); GAPB(o[0] = __builtin_amdgcn_mfma_f32_32x32x16_bf16(PAF(1), VFR(1), o[0], 0, 0, 0), C0, 8); \
    KRD(GL, 1); GAPB(o[1] = __builtin_amdgcn_mfma_f32_32x32x16_bf16(PAF(1), VFR(5), o[1], 0, 0, 0), C0, 12); \
    KRD(GL, 2); GAPB(o[0] = __builtin_amdgcn_mfma_f32_32x32x16_bf16(PAF(2), VFR(2), o[0], 0, 0, 0), C1, 0); \
    KRD(GL, 3); GAPB(o[1] = __builtin_amdgcn_mfma_f32_32x32x16_bf16(PAF(2), VFR(6), o[1], 0, 0, 0), C1, 4); \
    GAPB(o[0] = __builtin_amdgcn_mfma_f32_32x32x16_bf16(PAF(3), VFR(3), o[0], 0, 0, 0), C1, 8); \
    GAPB(o[1] = __builtin_amdgcn_mfma_f32_32x32x16_bf16(PAF(3), VFR(7), o[1], 0, 0, 0), C1, 12); \
    } while (0)
    int t = 1;
    for (; t + 5 < NT; t += 2) {
        STEP(pB0, pB1, pA0, pA1, t, true, true, true);     WAIT_BAR(2); RESC(); ROT();
        STEP(pA0, pA1, pB0, pB1, t + 1, true, true, true); WAIT_BAR(2); RESC(); ROT();
    }
#define ENDW(tt) do { if ((tt) + 3 < NT) { WAIT_BAR(2); } else if ((tt) + 2 < NT) { WAIT_BAR(1); } else { WAIT_BAR(0); } } while (0)
    for (; t + 1 < NT; t += 2) {
        STEP(pB0, pB1, pA0, pA1, t, (t + 3 < NT), (t + 1 < NT), (t + 1 < NT));         ENDW(t);     RESC(); ROT();
        STEP(pA0, pA1, pB0, pB1, t + 1, (t + 4 < NT), (t + 2 < NT), (t + 2 < NT));     ENDW(t + 1); RESC(); ROT();
    }
    STEP(pB0, pB1, pA0, pA1, NT - 1, false, false, false); RESC();
    { float sacc = pB0[0] + pB0[1]; _Pragma("unroll") for (int r = 2; r < 16; ++r) sacc += pB0[r]; _Pragma("unroll") for (int r = 0; r < 16; ++r) sacc += pB1[r]; l_reg += sacc;
      pw0 = (u32x4){PKW(pB0, 0), PKW(pB0, 2), PKW(pB0, 4), PKW(pB0, 6)}; pw1 = (u32x4){PKW(pB0, 8), PKW(pB0, 10), PKW(pB0, 12), PKW(pB0, 14)}; pw2 = (u32x4){PKW(pB1, 0), PKW(pB1, 2), PKW(pB1, 4), PKW(pB1, 6)}; pw3 = (u32x4){PKW(pB1, 8), PKW(pB1, 10), PKW(pB1, 12), PKW(pB1, 14)};
      SBAR(); pv(o, vb0 + sl_cur, PAF(0), PAF(1), PAF(2), PAF(3)); }
#undef PKW
#undef PAF
#undef VFR
#undef PIN
#undef MX3
#undef GAPA
#undef GAPB
#undef EX
#undef VRD
#undef KRD
#undef STEP
#undef ENDW
    { auto rr = __builtin_amdgcn_permlane32_swap(__float_as_uint(l_reg), __float_as_uint(l_reg), false, false); l_reg = __uint_as_float(rr[0]) + __uint_as_float(rr[1]); }
    if (hi == 0) wsf[32 + r32] = l_reg; asm volatile("s_waitcnt lgkmcnt(0)" ::: "memory");
    float rli[16];
#pragma unroll
    for (int r = 0; r < 16; ++r) rli[r] = __builtin_amdgcn_rcpf(wsf[32 + crow(r, hi)]);
    bf16_t* Ow = O + rowq * OP + h * 64;
    { bf16_t* stg = (bf16_t*)(shm + LDS_OST) + wid * 2048;
#pragma unroll
      for (int r = 0; r < 16; ++r) { const int orow = crow(r, hi);
#pragma unroll
        for (int d0 = 0; d0 < 2; ++d0) stg[orow * 64 + d0 * 32 + r32] = (bf16_t)(cvtpk_s(o[d0][r] * rli[r], 0.f) & 0xffffu); }
      asm volatile("s_waitcnt lgkmcnt(0)" ::: "memory");
#pragma unroll
      for (int i = 0; i < 4; ++i) { const int row = i * 8 + (lane >> 3), ch = lane & 7; const u32x4 v = *(const u32x4*)(stg + row * 64 + ch * 8); *(u32x4*)(Ow + (long)row * OP + ch * 8) = v; } }
    asm volatile("s_waitcnt lgkmcnt(0)\n\ts_barrier" ::: "memory");
#undef DMA_K
#undef DMA_V
#undef START
#undef RESC
#undef ROT
}
#undef SBAR
#undef WAIT_BAR
}

#define LDS_WAIT() asm volatile("s_waitcnt lgkmcnt(0)" ::: "memory")
constexpr int TP_OFF = LDSCTL_OFF + 512;
struct Args { const float* in[27]; float* out; unsigned char* ws; };
enum { I_X = 0, I_C, I_CTX, I_CCTX, I_MODW, I_MODB, I_N1G, I_N2G, I_EWIN, I_QG, I_KG, I_POOLW, I_POOLS, I_EWOUT, I_OWIN, I_SGG, I_SGW, I_SGB, I_CONVW, I_OWOUT,
       I_RGW, I_RGB, I_REW, I_REB, I_WG, I_WU, I_WD };

__device__ __forceinline__ int map_in0(int n) {
    if (n < 640) { const int hd = n >> 6, e = n & 63; const int s = e >> 5, r = e & 31, bj = r >> 4, i = r & 15, j = 16 * s + i;
        const int pn = (hd < 8) ? (hd >> 2) : 2, wc = (hd < 8) ? (hd & 3) : (hd - 8); return 256 * pn + 128 * bj + 32 * wc + j; }
    if (n < 768) { const int vh = (n - 640) >> 6, e = n & 63, bj = e >> 5, j = e & 31; return 512 + 128 * bj + 32 * (2 + vh) + j; }
    return n;
}
struct TrItem { const float* W; int K, N; bf16_t* WT; int kind, off, item; };
__device__ __forceinline__ void tr_load(const TrItem& t, int lane, float (&tv)[32]) {
    const int nblk = t.N / 32, kb = t.item / nblk, nb = t.item % nblk, k0 = 64 * kb, n0 = 32 * nb;
#pragma unroll
    for (int i = 0; i < 32; ++i) tv[i] = t.W[(size_t)(k0 + 2 * i + (lane >> 5)) * t.N + n0 + (lane & 31)];
}
__device__ __forceinline__ void tr_store(const TrItem& t, int lane, const float (&tv)[32], LAS float* scr) {
    const int nblk = t.N / 32, kb = t.item / nblk, nb = t.item % nblk, k0 = 64 * kb, n0 = 32 * nb;
#pragma unroll
    for (int i = 0; i < 32; ++i) scr[(2 * i + (lane >> 5)) * 33 + (lane & 31)] = tv[i];
    LDS_WAIT(); asm volatile("" ::: "memory");
    const int c = lane & 7;
#pragma unroll
    for (int j = 0; j < 4; ++j) { const int n = (lane >> 3) + 8 * j; const LAS float* s = scr + (8 * c) * 33 + n; const int ng = n0 + n;
        const int dst = (t.kind == 1) ? map_in0(ng) : (t.kind == 2) ? t.off + 256 * (ng >> 7) + (ng & 127) : t.off + ng;
        u32x4 o; o.x = cvt_pk_bf16(s[0 * 33], s[1 * 33]); o.y = cvt_pk_bf16(s[2 * 33], s[3 * 33]); o.z = cvt_pk_bf16(s[4 * 33], s[5 * 33]); o.w = cvt_pk_bf16(s[6 * 33], s[7 * 33]);
        *(u32x4*)(t.WT + (size_t)dst * t.K + k0 + 8 * c) = o; }
    LDS_WAIT(); asm volatile("" ::: "memory");
}
__device__ __forceinline__ void p0_prologue(const Args& a, LAS unsigned char* lds, int tid, int lane, int wave, int vcu, int G) {
    unsigned char* ws = a.ws;
    {
        LAS float* sc = (LAS float*)lds;
        LAS float* red = (LAS float*)(lds + 36864);
        for (int idx = tid; idx < 9 * 1024; idx += 512) { const int r = idx >> 10, k = idx & 1023; const float v = (r < 8) ? a.in[I_C][r * 1024 + k] : a.in[I_CCTX][k]; sc[idx] = silu_f(v); }
        __syncthreads();
        float* MOD = (float*)(ws + WS_MOD);
        for (int unit = blockIdx.x; unit < 256; unit += G) {
            const int l = unit >> 7, n0 = (unit & 127) * 48;
            const int ks = lane / 12, c4 = lane % 12; const bool act = lane < 60;
            const float* Wm = a.in[I_MODW] + (size_t)l * 1024 * 6144 + n0 + 4 * c4;
            f32x4 acc4[9];
#pragma unroll
            for (int r = 0; r < 9; ++r) acc4[r] = (f32x4){0.f, 0.f, 0.f, 0.f};
#pragma unroll 1
            for (int it0 = 0; it0 < 26; it0 += 13) {
                f32x4 wv[13];
#pragma unroll
                for (int i = 0; i < 13; ++i) { const int kr = 5 * (it0 + i) + ks; const bool ok = act && kr < 128;
                    wv[i] = ok ? *(const f32x4*)(Wm + (size_t)(wave * 128 + kr) * 6144) : (f32x4){0.f, 0.f, 0.f, 0.f}; }
#pragma unroll
                for (int i = 0; i < 13; ++i) { const int kr = 5 * (it0 + i) + ks; const int kk = wave * 128 + (kr < 128 ? kr : 127);
#pragma unroll
                    for (int r = 0; r < 9; ++r) acc4[r] += sc[r * 1024 + kk] * wv[i]; }
            }
            if (act) {
#pragma unroll
                for (int r = 0; r < 9; ++r) *(LAS f32x4*)(red + ((wave * 5 + ks) * 9 + r) * 48 + 4 * c4) = acc4[r]; }
            __syncthreads();
            for (int idx = tid; idx < 9 * 48; idx += 512) { const int r = idx / 48, cl = idx % 48; float sum = a.in[I_MODB][l * 6144 + n0 + cl];
#pragma unroll 8
                for (int w = 0; w < 40; ++w) sum += red[(w * 9 + r) * 48 + cl];
                MOD[(size_t)(l * 9 + r) * 6144 + n0 + cl] = sum; }
            __syncthreads();
        }
    }
}
__device__ __forceinline__ void convert_weights(const Args& a, LAS unsigned char* lds, int set, int lane, int wave, int worker, int nworkers) {
    unsigned char* ws = a.ws;
    LAS float* scr = (LAS float*)(lds + wave * 16384);
    constexpr int I0 = 16 * 40, I1 = 16 * 32, I2 = 16 * 80, I3 = 16 * 32, IGU = 128, IDN = 128, IPL = 8, HL = 16 * 128;
    constexpr int E0 = I0, E1 = E0 + I1, E2 = E1 + I2, E3 = E2 + I3, E4 = E3 + 32 * IGU, E5 = E4 + 32 * IGU, E6 = E5 + 32 * IDN, E7 = E6 + 4 * IPL;
    constexpr int N1A = E3 - E0, N1 = N1A + 3 * HL + 4 * IPL, N2 = 3 * HL;
    const int nitems = (set == 0) ? E0 : (set == 1) ? N1 : N2;
    auto remap = [&](int v) -> int {
        if (set == 0) return v;
        if (set == 1) { if (v < N1A) return E0 + v; v -= N1A; if (v < HL) return E3 + v; v -= HL; if (v < HL) return E4 + v; v -= HL; if (v < HL) return E5 + v; v -= HL; return E6 + v; }
        if (v < HL) return E3 + HL + v; v -= HL; if (v < HL) return E4 + HL + v; v -= HL; return E5 + HL + v; };
    auto mk = [&](int v) -> TrItem { const int it = remap(v); TrItem t;
        if (it < E0) t = TrItem{a.in[I_EWIN], 1024, 1280, (bf16_t*)(ws + WS_WIN0), 1, 0, it};
        else if (it < E1) t = TrItem{a.in[I_EWOUT], 1024, 1024, (bf16_t*)(ws + WS_WOUT0), 0, 0, it - E0};
        else if (it < E2) t = TrItem{a.in[I_OWIN], 1024, 2560, (bf16_t*)(ws + WS_WIN1), 0, 0, it - E1};
        else if (it < E3) t = TrItem{a.in[I_OWOUT], 1024, 1024, (bf16_t*)(ws + WS_WOUT1), 0, 0, it - E2};
        else if (it < E4) { const int r = it - E3, le = r / IGU;
            t = TrItem{a.in[I_WG] + (size_t)le * 1024 * 256, 1024, 256, (bf16_t*)(ws + WS_WGU) + (size_t)(le >> 4) * 8192 * 1024, 2, (le & 15) * 512, r % IGU}; }
        else if (it < E5) { const int r = it - E4, le = r / IGU;
            t = TrItem{a.in[I_WU] + (size_t)le * 1024 * 256, 1024, 256, (bf16_t*)(ws + WS_WGU) + (size_t)(le >> 4) * 8192 * 1024, 2, (le & 15) * 512 + 128, r % IGU}; }
        else if (it < E6) { const int r = it - E5, le = r / IDN;
            t = TrItem{a.in[I_WD] + (size_t)le * 256 * 1024, 256, 1024, (bf16_t*)(ws + WS_WDN) + (size_t)(le >> 4) * 16384 * 256, 0, (le & 15) * 1024, r % IDN}; }
        else { const int r = it - E6, g = r / IPL;
            t = TrItem{a.in[I_POOLW] + (size_t)g * 128 * 128, 128, 128, (bf16_t*)(ws + WS_WPOOL), 0, g * 128, r % IPL}; }
        return t; };
    {   float tvA[32], tvB[32];
        int it = worker; TrItem cur{}; if (it < nitems) { cur = mk(it); tr_load(cur, lane, tvA); }
        for (; it < nitems; it += 2 * nworkers) {
            const int itB = it + nworkers, itC = it + 2 * nworkers; TrItem tb{}, tc{};
            if (itB < nitems) { tb = mk(itB); tr_load(tb, lane, tvB); }
            tr_store(cur, lane, tvA, scr);
            if (itC < nitems) { tc = mk(itC); tr_load(tc, lane, tvA); }
            if (itB < nitems) tr_store(tb, lane, tvB, scr);
            cur = tc;
        }
    }
    if (set == 1) {
        for (int idx = worker * 64 + lane; idx < 4 * 128 * 128; idx += nworkers * 64) { const int x = idx & 15; const int q = (x & 3) + 8 * ((x >> 2) & 1) + 4 * (x >> 3);
            const float v = a.in[I_SGW][(idx & ~15) + q]; ((bf16_t*)(ws + WS_WSG))[idx] = (bf16_t)(cvt_pk_bf16(v, 0.f) & 0xffffu); } }
}

__device__ __forceinline__ void load_vec16(const float* p, int lane, f32x4 (&v)[4]) {
#pragma unroll
    for (int j = 0; j < 2; ++j)
#pragma unroll
        for (int q = 0; q < 2; ++q) v[2 * j + q] = *(const f32x4*)(p + 8 * lane + 512 * j + 4 * q);
}
__device__ __forceinline__ void load_row_bf16(const bf16_t* p, int lane, f32x4 (&v)[4]) {
#pragma unroll
    for (int j = 0; j < 2; ++j) { const u32x4 w = *(const u32x4*)(p + 8 * lane + 512 * j);
        v[2 * j] = (f32x4){bf_lo(w.x), bf_hi(w.x), bf_lo(w.y), bf_hi(w.y)}; v[2 * j + 1] = (f32x4){bf_lo(w.z), bf_hi(w.z), bf_lo(w.w), bf_hi(w.w)}; }
}
__device__ __forceinline__ void store_row_bf16(bf16_t* p, int lane, const f32x4 (&v)[4]) {
#pragma unroll
    for (int j = 0; j < 2; ++j) { u32x4 w; w.x = cvt_pk_bf16(v[2 * j][0], v[2 * j][1]); w.y = cvt_pk_bf16(v[2 * j][2], v[2 * j][3]); w.z = cvt_pk_bf16(v[2 * j + 1][0], v[2 * j + 1][1]); w.w = cvt_pk_bf16(v[2 * j + 1][2], v[2 * j + 1][3]);
        *(u32x4*)(p + 8 * lane + 512 * j) = w; }
}
__device__ __forceinline__ float sumsq16(const f32x4 (&v)[4]) { float s = 0.f;
#pragma unroll
    for (int i = 0; i < 4; ++i) s += (v[i][0] * v[i][0] + v[i][1] * v[i][1]) + (v[i][2] * v[i][2] + v[i][3] * v[i][3]);
    return s; }
__device__ __forceinline__ void load_mod(const float* mod, const float* gain, int l, int r, int cs, int lane, f32x4 (&gm)[4], f32x4 (&sh)[4]) {
    const float* mr = mod + (size_t)(l * 9 + r) * 6144 + cs * 1024; f32x4 g[4], s[4];
    load_vec16(gain + l * 1024, lane, g); load_vec16(mr + 1024, lane, s); load_vec16(mr, lane, sh);
#pragma unroll
    for (int i = 0; i < 4; ++i) gm[i] = g[i] * (1.0f + s[i]);
}
__device__ __forceinline__ void p1_ln_rows(const Args& a, int lane, int gw, int NGW) {
    const float* mod = (const float*)(a.ws + WS_MOD); bf16_t* AB = (bf16_t*)(a.ws + WS_ABUF);
    const int rpw = (MA + NGW - 1) / NGW, m0 = gw * rpw, m1 = (m0 + rpw < MA) ? m0 + rpw : MA;
    int curb = -1; f32x4 gm[4], sh[4];
    for (int mm = m0; mm < m1; mm += 2) {
        const int mB = (mm + 1 < m1) ? mm + 1 : mm;
        f32x4 vv[2][4];
        load_vec16((mm < MT) ? a.in[I_X] + (size_t)mm * 1024 : a.in[I_CTX] + (size_t)(mm - MT) * 1024, lane, vv[0]);
        load_vec16((mB < MT) ? a.in[I_X] + (size_t)mB * 1024 : a.in[I_CTX] + (size_t)(mB - MT) * 1024, lane, vv[1]);
#pragma unroll
        for (int r = 0; r < 2; ++r) { const int m = r ? mB : mm; if (r && mB == mm) break;
            const int b = (m < MT) ? (m >> 12) : 8;
            if (b != curb) { load_mod(mod, a.in[I_N1G], 0, b, 0, lane, gm, sh); curb = b; }
            const float rstd = __builtin_amdgcn_rsqf(wave_sum(sumsq16(vv[r])) * (1.0f / 1024.0f) + EPS);
#pragma unroll
            for (int i = 0; i < 4; ++i) vv[r][i] = vv[r][i] * rstd * gm[i] + sh[i];
            store_row_bf16(AB + (size_t)m * 1024, lane, vv[r]); }
    }
}
template <class T> __device__ __forceinline__ void copy_rows(const T* src, float* dst, int lane, int gw, int NGW) {
    for (int m = gw; m < MT; m += NGW) { f32x4 v[4]; if constexpr (sizeof(T) == 4) load_vec16((const float*)src + (size_t)m * 1024, lane, v); else load_row_bf16((const bf16_t*)src + (size_t)m * 1024, lane, v);
#pragma unroll
        for (int j = 0; j < 2; ++j)
#pragma unroll
            for (int q = 0; q < 2; ++q) *(f32x4*)(dst + (size_t)m * 1024 + 8 * lane + 512 * j + 4 * q) = v[2 * j + q]; }
}

__device__ __forceinline__ void pool_task(int rb, int g, const bf16_t* P, const bf16_t* Wp, const float* pscale, bf16_t* A2, int lane) {
    const int r = lane & 31, hh = lane >> 5;
    const int m0 = rb * 32, b = m0 >> 12, t = (m0 & 4095) + r;
    const int half = 1 << g;
    const int lo = (t - half > 0) ? t - half : 0, hi = (t + half < SEQ) ? t + half : SEQ;
    const float invc = 1.0f / (float)(hi - lo);
    const bf16_t* Pb = P + (size_t)b * SEQ * 512 + g * 128 + 8 * hh;
    float sum[8][8];
#pragma unroll
    for (int s = 0; s < 8; ++s)
#pragma unroll
        for (int j = 0; j < 8; ++j) sum[s][j] = 0.f;
#pragma unroll 2
    for (int d2 = -half; d2 < half; d2 += 2)
#pragma unroll
    for (int dd = 0; dd < 2; ++dd) { const int d = d2 + dd;
        const int tt = t + d; const bool ok = (tt >= 0) && (tt < SEQ); const int tc = ok ? tt : t;
        const float msk = ok ? 1.0f : 0.0f;
#pragma unroll
        for (int s = 0; s < 8; ++s) { const u32x4 w = *(const u32x4*)(Pb + (size_t)tc * 512 + 16 * s);
            sum[s][0] += msk * bf_lo(w.x); sum[s][1] += msk * bf_hi(w.x); sum[s][2] += msk * bf_lo(w.y); sum[s][3] += msk * bf_hi(w.y);
            sum[s][4] += msk * bf_lo(w.z); sum[s][5] += msk * bf_hi(w.z); sum[s][6] += msk * bf_lo(w.w); sum[s][7] += msk * bf_hi(w.w); }
    }
    bf16x8 afrag[8];
#pragma unroll
    for (int s = 0; s < 8; ++s) { const u32x4 w = *(const u32x4*)(Pb + (size_t)t * 512 + 16 * s);
        u32x4 o; o.x = cvt_pk_bf16(sum[s][0] * invc - bf_lo(w.x), sum[s][1] * invc - bf_hi(w.x)); o.y = cvt_pk_bf16(sum[s][2] * invc - bf_lo(w.y), sum[s][3] * invc - bf_hi(w.y));
        o.z = cvt_pk_bf16(sum[s][4] * invc - bf_lo(w.z), sum[s][5] * invc - bf_hi(w.z)); o.w = cvt_pk_bf16(sum[s][6] * invc - bf_lo(w.w), sum[s][7] * invc - bf_hi(w.w));
        afrag[s] = __builtin_bit_cast(bf16x8, o); }
    bf16_t* orow = A2 + (size_t)(m0 + r) * 1024 + 512 + g * 128;
#pragma unroll
    for (int nb = 0; nb < 4; ++nb) {
        f32x16 acc = f32x16{};
#pragma unroll
        for (int s = 0; s < 8; ++s) { const bf16x8 bfr = *(const bf16x8*)(Wp + (size_t)(g * 128 + 32 * nb + r) * 128 + 16 * s + 8 * hh);
            acc = __builtin_amdgcn_mfma_f32_32x32x16_bf16(bfr, afrag[s], acc, 0, 0, 0); }
#pragma unroll
        for (int rg = 0; rg < 4; ++rg) { const int n = 32 * nb + 8 * rg + 4 * hh; const f32x4 ps = *(const f32x4*)(pscale + g * 128 + n);
            u32x2 w; w.x = cvt_pk_bf16(acc[4 * rg] * ps[0], acc[4 * rg + 1] * ps[1]); w.y = cvt_pk_bf16(acc[4 * rg + 2] * ps[2], acc[4 * rg + 3] * ps[3]);
            *(u32x2*)(orow + n) = w; }
    }
}

template <int N, int SZ> __device__ __forceinline__ void halve(float (&v)[SZ], int mask, bool upper) {
#pragma unroll
    for (int i = 0; i < N / 2; ++i) { const float send = upper ? v[i] : v[i + N / 2]; const float keep = upper ? v[i + N / 2] : v[i]; v[i] = keep + __shfl_xor(send, mask); }
}
__device__ __forceinline__ void reduce16(float (&v)[16], int lane, float (&out)[16]) {
    halve<16, 16>(v, 32, (lane & 32) != 0); halve<8, 16>(v, 16, (lane & 16) != 0); halve<4, 16>(v, 8, (lane & 8) != 0); halve<2, 16>(v, 4, (lane & 4) != 0);
    float x = v[0]; x += __shfl_xor(x, 2); x += __shfl_xor(x, 1);
#pragma unroll
    for (int i = 0; i < 16; ++i) out[i] = __builtin_bit_cast(float, __builtin_amdgcn_readlane(__builtin_bit_cast(int, x), 4 * i));
}
__device__ __forceinline__ void router_phase(const Args& a, int l, LAS unsigned char* lds, int tid, int lane_unused, int wave, int G) {
    unsigned char* ws = a.ws;
    const bf16_t* H = (const bf16_t*)(ws + WS_H); bf16_t* T = (bf16_t*)(ws + WS_ABUF); const float* mod = (const float*)(ws + WS_MOD);
    LAS float* WG1 = (LAS float*)lds;
    LAS float* WE = (LAS float*)(lds + 16384);
    LAS int* REC_E = (LAS int*)(lds + 92160); LAS int* REC_P = REC_E + 256; LAS float* REC_W = (LAS float*)(REC_P + 256);
    LAS int* CNT = (LAS int*)(lds + 95232); LAS int* GBASE = CNT + 32;
    const float* rgw = a.in[I_RGW] + (size_t)l * 1024 * 4; const float* rew = a.in[I_REW] + (size_t)l * 1024 * 16;
    {   f32x4 wg[2], we[2][4];
#pragma unroll
        for (int i = 0; i < 2; ++i) { const int col = tid + 512 * i; wg[i] = *(const f32x4*)(rgw + col * 4);
#pragma unroll
            for (int g = 0; g < 4; ++g) we[i][g] = *(const f32x4*)(rew + col * 16 + 4 * g); }
#pragma unroll
        for (int i = 0; i < 2; ++i) { const int col = tid + 512 * i, jp = col >> 9, ln = (col & 511) >> 3, cc = col & 7; const int pos = ((jp * 8 + cc) * 64 + ln) * 4;
            *(LAS f32x4*)(WG1 + pos) = wg[i];
#pragma unroll
            for (int g = 0; g < 4; ++g) *(LAS f32x4*)(WE + g * 4096 + pos) = we[i][g]; } }
    if (tid < NCLS) CNT[tid] = 0;
    __syncthreads();
    unsigned* counts = (unsigned*)(ws + WS_CTL) + CW_CNT + 64 * l;
    int* list = (int*)(ws + RT_LIST); f32x2* wsl = (f32x2*)(ws + RT_WSLOT);
    const float* rgb = a.in[I_RGB] + l * 4; const float* reb = a.in[I_REB] + l * 16;
    for (int blk = blockIdx.x; blk < MT / 128; blk += G) {
        const int tok0 = blk * 128 + wave * 16, b = (blk * 128) >> 12;
        f32x4 gm[4], sh[4]; load_mod(mod, a.in[I_N2G], l, b, 3, opaque_tid() & 63, gm, sh);
        u32x4 nx[4][2];
        { const int lane = opaque_tid() & 63;
#pragma unroll
          for (int tk = 0; tk < 4; ++tk)
#pragma unroll
            for (int j = 0; j < 2; ++j) nx[tk][j] = *(const u32x4*)(H + (size_t)(tok0 + tk) * 1024 + 8 * lane + 512 * j); }
#pragma unroll 1
        for (int grp = 0; grp < 4; ++grp) {
            const int lane = opaque_tid() & 63;
            f32x4 hv[4][4];
#pragma unroll
            for (int tk = 0; tk < 4; ++tk)
#pragma unroll
                for (int j = 0; j < 2; ++j) { const u32x4 w = nx[tk][j]; hv[tk][2 * j] = (f32x4){bf_lo(w.x), bf_hi(w.x), bf_lo(w.y), bf_hi(w.y)}; hv[tk][2 * j + 1] = (f32x4){bf_lo(w.z), bf_hi(w.z), bf_lo(w.w), bf_hi(w.w)}; }
            if (grp < 3) {
#pragma unroll
                for (int tk = 0; tk < 4; ++tk)
#pragma unroll
                    for (int j = 0; j < 2; ++j) nx[tk][j] = *(const u32x4*)(H + (size_t)(tok0 + (grp + 1) * 4 + tk) * 1024 + 8 * lane + 512 * j); }
            {
#pragma unroll
                for (int tk = 0; tk < 4; ++tk) { const float rstd = __builtin_amdgcn_rsqf(wave_sum(sumsq16(hv[tk])) * (1.0f / 1024.0f) + EPS);
#pragma unroll
                    for (int i = 0; i < 4; ++i) hv[tk][i] = hv[tk][i] * rstd * gm[i] + sh[i];
                    store_row_bf16(T + (size_t)(tok0 + grp * 4 + tk) * 1024, lane, hv[tk]); } }
            float acc[16], tot[16];
#pragma unroll
            for (int i = 0; i < 16; ++i) acc[i] = 0.f;
#pragma unroll
            for (int jp = 0; jp < 2; ++jp)
#pragma unroll
                for (int cc = 0; cc < 8; ++cc) { const f32x4 w4 = *(const LAS f32x4*)(WG1 + ((jp * 8 + cc) * 64 + lane) * 4);
#pragma unroll
                    for (int tk = 0; tk < 4; ++tk) { const float tv = hv[tk][2 * jp + (cc >> 2)][cc & 3];
#pragma unroll
                        for (int q = 0; q < 4; ++q) acc[tk * 4 + q] += tv * w4[q]; } }
            reduce16(acc, lane, tot);
            int gi[4]; float gp[4];
#pragma unroll
            for (int tk = 0; tk < 4; ++tk) { float gl[4];
#pragma unroll
                for (int q = 0; q < 4; ++q) gl[q] = tot[tk * 4 + q] + rgb[q];
                int g = 0; float gmx = gl[0];
#pragma unroll
                for (int q = 1; q < 4; ++q) if (gl[q] > gmx) { gmx = gl[q]; g = q; }
                float gs = 0.f;
#pragma unroll
                for (int q = 0; q < 4; ++q) gs += __expf(gl[q] - gmx);
                gi[tk] = __builtin_amdgcn_readfirstlane(g); gp[tk] = 1.0f / gs; }
#pragma unroll
            for (int i = 0; i < 16; ++i) acc[i] = 0.f;
#pragma unroll
            for (int tk = 0; tk < 4; ++tk) { const LAS float* we = WE + gi[tk] * 4096 + lane * 4;
#pragma unroll
                for (int jp = 0; jp < 2; ++jp)
#pragma unroll
                    for (int cc = 0; cc < 8; ++cc) { const f32x4 w4 = *(const LAS f32x4*)(we + (jp * 8 + cc) * 256); const float tv = hv[tk][2 * jp + (cc >> 2)][cc & 3];
#pragma unroll
                        for (int q = 0; q < 4; ++q) acc[tk * 4 + q] += tv * w4[q]; } }
            reduce16(acc, lane, tot);
            if (lane == 0) {
#pragma unroll
                for (int tk = 0; tk < 4; ++tk) { float el[4];
#pragma unroll
                    for (int q = 0; q < 4; ++q) el[q] = tot[tk * 4 + q] + reb[gi[tk] * 4 + q];
                    int i1 = 0; float m1 = el[0];
#pragma unroll
                    for (int q = 1; q < 4; ++q) if (el[q] > m1) { m1 = el[q]; i1 = q; }
                    int i2 = -1; float m2 = -3.0e38f;
#pragma unroll
                    for (int q = 0; q < 4; ++q) if (q != i1 && el[q] > m2) { m2 = el[q]; i2 = q; }
                    const float ex = __expf(m2 - m1), den = 1.0f / (1.0f + ex);
                    const float w1 = gp[tk] * den, w2 = gp[tk] * ex * den;
                    const int lo = (i1 < i2) ? i1 : i2, hi = (i1 < i2) ? i2 : i1; const int cls = gi[tk] * 6 + ((lo == 0) ? 0 : (lo == 1) ? 3 : 5) + (hi - lo - 1);
                    const int tl = wave * 16 + grp * 4 + tk;
                    REC_E[tl] = cls; REC_W[tl * 2] = (i1 < i2) ? w1 : w2; REC_W[tl * 2 + 1] = (i1 < i2) ? w2 : w1;
                    REC_P[tl] = __hip_atomic_fetch_add(CNT + cls, 1, __ATOMIC_RELAXED, __HIP_MEMORY_SCOPE_WORKGROUP); } }
        }
        const int tid = opaque_tid();
        __syncthreads();
        if (tid < NCLS) { GBASE[tid] = (int)__hip_atomic_fetch_add(counts + tid, (unsigned)CNT[tid], __ATOMIC_RELAXED, __HIP_MEMORY_SCOPE_AGENT); }
        __syncthreads();
        if (tid < 128) { const int cls = REC_E[tid], pos = GBASE[cls] + REC_P[tid]; const int token = blk * 128 + tid;
            list[cls * LISTCAP + pos] = token; wsl[(size_t)cls * LISTCAP + pos] = (f32x2){REC_W[tid * 2], REC_W[tid * 2 + 1]}; }
        if (tid < NCLS) CNT[tid] = 0;
        __syncthreads();
    }
}
__device__ __forceinline__ void build_tp(const Args& a, int l, LAS unsigned char* lds, int tid) {
    volatile LAS int* tp = (volatile LAS int*)(lds + TP_OFF);
    if (tid == 0) { const unsigned* counts = (const unsigned*)(a.ws + WS_CTL) + CW_CNT + 64 * l; int acc = 0;
        for (int e = 0; e < NCLS; ++e) { const int c = (int)__hip_atomic_load(counts + e, __ATOMIC_RELAXED, __HIP_MEMORY_SCOPE_AGENT); tp[e] = acc; tp[NCLS + 1 + e] = c; acc += (c + 255) >> 8; }
        tp[NCLS] = acc; }
    __syncthreads();
}
__device__ __forceinline__ void ln1_phase(const Args& a, int lane, int gw, int NGW) {
    unsigned char* ws = a.ws; const float* mod = (const float*)(ws + WS_MOD); const bf16_t* H = (const bf16_t*)(ws + WS_H); bf16_t* AB = (bf16_t*)(ws + WS_ABUF);
    const int rpw = (((MT + NGW - 1) / NGW) + 1) & ~1, m0 = gw * rpw, m1 = (m0 + rpw < MT) ? m0 + rpw : MT;
    int curb = -1; f32x4 gm[4], sh[4];
    for (int m = m0; m < m1; m += 2) {
        f32x4 hv[2][4];
#pragma unroll
        for (int r = 0; r < 2; ++r) load_row_bf16(H + (size_t)(m + r) * 1024, lane, hv[r]);
        const int b = m >> 12;
        if (b != curb) { load_mod(mod, a.in[I_N1G], 1, b, 0, lane, gm, sh); curb = b; }
#pragma unroll
        for (int r = 0; r < 2; ++r) { const float rstd = __builtin_amdgcn_rsqf(wave_sum(sumsq16(hv[r])) * (1.0f / 1024.0f) + EPS);
#pragma unroll
            for (int i = 0; i < 4; ++i) hv[r][i] = hv[r][i] * rstd * gm[i] + sh[i];
            store_row_bf16(AB + (size_t)(m + r) * 1024, lane, hv[r]); }
    }
}
__device__ __forceinline__ void sgconv_phase(const Args& a, LAS unsigned char* lds, int tid_unused, int lane_unused, int wave, int G) {
    unsigned char* ws = a.ws; const bf16_t* UV = (const bf16_t*)(ws + WS_RGN); bf16_t* MIX = (bf16_t*)(ws + WS_ABUF); const bf16_t* WSG = (const bf16_t*)(ws + WS_WSG);
    for (int blk = blockIdx.x; blk < MT / 128; blk += G) {
        const int tok0 = blk * 128;
        {
            const int lane = opaque_tid() & 63;
            const int g = wave >> 1, ch = lane & 15; float gn[8];
            u32x4 wv[16];
#pragma unroll
            for (int it = 0; it < 16; ++it) wv[it] = *(const u32x4*)(UV + (size_t)(tok0 + 64 * (wave & 1) + 4 * it + (lane >> 4)) * 2560 + 512 + g * 128 + 8 * ch);
#pragma unroll
            for (int j = 0; j < 8; ++j) gn[j] = a.in[I_SGG][g * 128 + 8 * ch + j];
#pragma unroll
            for (int it = 0; it < 16; ++it) { const int q = 64 * (wave & 1) + 4 * it + (lane >> 4); const u32x4 w = wv[it];
                float v[8] = {bf_lo(w.x), bf_hi(w.x), bf_lo(w.y), bf_hi(w.y), bf_lo(w.z), bf_hi(w.z), bf_lo(w.w), bf_hi(w.w)};
                float ss = 0.f;
#pragma unroll
                for (int j = 0; j < 8; ++j) ss += v[j] * v[j];
                ss += __shfl_xor(ss, 1); ss += __shfl_xor(ss, 2); ss += __shfl_xor(ss, 4); ss += __shfl_xor(ss, 8);
                const float rstd = __builtin_amdgcn_rsqf(ss * (1.0f / 128.0f) + EPS);
                u32x4 o; o.x = cvt_pk_bf16(v[0] * rstd * gn[0], v[1] * rstd * gn[1]); o.y = cvt_pk_bf16(v[2] * rstd * gn[2], v[3] * rstd * gn[3]);
                o.z = cvt_pk_bf16(v[4] * rstd * gn[4], v[5] * rstd * gn[5]); o.w = cvt_pk_bf16(v[6] * rstd * gn[6], v[7] * rstd * gn[7]);
                *(LAS u32x4*)(lds + g * 32768 + (ch >> 2) * 8192 + q * 64 + (ch & 3) * 16) = o; }
        }
        {
            const int lane = opaque_tid() & 63;
            float cw[3][8];
#pragma unroll
            for (int k = 0; k < 3; ++k)
#pragma unroll
                for (int j = 0; j < 8; ++j) cw[k][j] = a.in[I_CONVW][k * 512 + 8 * lane + j];
#pragma unroll 1
            for (int hf = 0; hf < 4; ++hf) { const int t0 = tok0 + wave * 16 + hf * 4;
                u32x4 hx[6], cg[6], bg[4];
#pragma unroll
                for (int i = 0; i < 6; ++i) { const bool ok = !((i == 0 && ((t0 & 4095) == 0)) || (i == 5 && (((t0 + 3) & 4095) == 4095))); const int tok = ok ? t0 - 1 + i : t0;
                    hx[i] = *(const u32x4*)(UV + (size_t)tok * 2560 + 1024 + 8 * lane); cg[i] = *(const u32x4*)(UV + (size_t)tok * 2560 + 2048 + 8 * lane);
                    if (!ok) hx[i] = (u32x4){0u, 0u, 0u, 0u}; }
#pragma unroll
                for (int i = 0; i < 4; ++i) bg[i] = *(const u32x4*)(UV + (size_t)(t0 + i) * 2560 + 1536 + 8 * lane);
                float z[6][8];
#pragma unroll
                for (int i = 0; i < 6; ++i) { z[i][0] = bf_lo(hx[i].x) * bf_lo(cg[i].x); z[i][1] = bf_hi(hx[i].x) * bf_hi(cg[i].x); z[i][2] = bf_lo(hx[i].y) * bf_lo(cg[i].y); z[i][3] = bf_hi(hx[i].y) * bf_hi(cg[i].y);
                    z[i][4] = bf_lo(hx[i].z) * bf_lo(cg[i].z); z[i][5] = bf_hi(hx[i].z) * bf_hi(cg[i].z); z[i][6] = bf_lo(hx[i].w) * bf_lo(cg[i].w); z[i][7] = bf_hi(hx[i].w) * bf_hi(cg[i].w); }
#pragma unroll
                for (int i = 0; i < 4; ++i) { const u32x4 b4 = bg[i];
                    const float bgv[8] = {bf_lo(b4.x), bf_hi(b4.x), bf_lo(b4.y), bf_hi(b4.y), bf_lo(b4.z), bf_hi(b4.z), bf_lo(b4.w), bf_hi(b4.w)};
                    float y[8];
#pragma unroll
                    for (int j = 0; j < 8; ++j) y[j] = bgv[j] * (cw[0][j] * z[i][j] + cw[1][j] * z[i + 1][j] + cw[2][j] * z[i + 2][j]);
                    u32x4 o; o.x = cvt_pk_bf16(y[0], y[1]); o.y = cvt_pk_bf16(y[2], y[3]); o.z = cvt_pk_bf16(y[4], y[5]); o.w = cvt_pk_bf16(y[6], y[7]);
                    *(u32x4*)(MIX + (size_t)(t0 + i) * 1024 + 512 + 8 * lane) = o; } }
        }
        __syncthreads();
        {
            const int lane = opaque_tid() & 63, r32 = lane & 31, hi = lane >> 5;
            const int g = wave >> 1, ph = wave & 1;
            f32x16 acc[2][4];
#pragma unroll
            for (int pb = 0; pb < 2; ++pb)
#pragma unroll
                for (int cb = 0; cb < 4; ++cb) acc[pb][cb] = f32x16{};
            const LAS unsigned char* vbase = lds + g * 32768 + ((lane >> 4) & 1) * 32 + (lane & 3) * 8 + (4 * hi + ((lane & 15) >> 2)) * 64;
#pragma unroll 4
            for (int s = 0; s < 8; ++s) {
                bf16x8 wf[2];
#pragma unroll
                for (int pb = 0; pb < 2; ++pb) wf[pb] = *(const bf16x8*)(WSG + (size_t)(g * 128 + 64 * ph + 32 * pb + r32) * 128 + 16 * s + 8 * hi);
#pragma unroll
                for (int cb = 0; cb < 4; ++cb) {
                    const s16x4 lo = attn_body::vtr((attn_body::lds_cptr)(vbase + cb * 8192 + s * 1024)), hh = attn_body::vtr((attn_body::lds_cptr)(vbase + cb * 8192 + s * 1024 + 512));
                    const bf16x8 vf = (bf16x8){lo[0], lo[1], lo[2], lo[3], hh[0], hh[1], hh[2], hh[3]};
#pragma unroll
                    for (int pb = 0; pb < 2; ++pb) acc[pb][cb] = __builtin_amdgcn_mfma_f32_32x32x16_bf16(vf, wf[pb], acc[pb][cb], 0, 0, 0);
                }
            }
#pragma unroll
            for (int pb = 0; pb < 2; ++pb) { const int p = 64 * ph + 32 * pb + r32; const float bias = a.in[I_SGB][g * 128 + p];
                const bf16_t* urow = UV + (size_t)(tok0 + p) * 2560 + g * 128; bf16_t* orow = MIX + (size_t)(tok0 + p) * 1024 + g * 128;
                u32x2 uu[4][4];
#pragma unroll
                for (int cb = 0; cb < 4; ++cb)
#pragma unroll
                    for (int rg = 0; rg < 4; ++rg) uu[cb][rg] = *(const u32x2*)(urow + 32 * cb + 8 * rg + 4 * hi);
#pragma unroll
                for (int cb = 0; cb < 4; ++cb)
#pragma unroll
                    for (int rg = 0; rg < 4; ++rg) { const int c0 = 32 * cb + 8 * rg + 4 * hi; const u32x2 u2 = uu[cb][rg];
                        u32x2 w; w.x = cvt_pk_bf16(bf_lo(u2.x) * (acc[pb][cb][4 * rg] + bias), bf_hi(u2.x) * (acc[pb][cb][4 * rg + 1] + bias));
                        w.y = cvt_pk_bf16(bf_lo(u2.y) * (acc[pb][cb][4 * rg + 2] + bias), bf_hi(u2.y) * (acc[pb][cb][4 * rg + 3] + bias));
                        *(u32x2*)(orow + c0) = w; } }
        }
        __syncthreads();
    }
}

__global__ void __launch_bounds__(NWAVES * 64, 2) mk_fwd(Args a) {
    extern __shared__ __attribute__((aligned(16))) unsigned char lds_raw[];
    LAS unsigned char* lds = (LAS unsigned char*)lds_raw;
    const int tid0 = threadIdx.x, wave = __builtin_amdgcn_readfirstlane(tid0 >> 6);
#define tid opaque_tid()
#define lane (opaque_tid() & 63)
    const int G = gridDim.x; const int bx = blockIdx.x; const int vcu = (G % 8 == 0) ? (bx % 8) * (G / 8) + bx / 8 : bx;
    const int gw = vcu * NWAVES + wave, NGW = G * NWAVES;
    unsigned char* ws = a.ws;
    for (int u = tid0; u < (LDS_BYTES - LDSCTL_OFF) / 4; u += NWAVES * 64) ((LAS unsigned*)(lds + LDSCTL_OFF))[u] = 0u;
    __syncthreads();
    volatile LAS unsigned* MISC = (volatile LAS unsigned*)(lds + MISC_OFF);
    XcdBarrier bar = xcd_barrier_post((unsigned*)(ws + WS_CTL) + CW_BAR, MISC + 8);
    unsigned long long t_ph = 0; if constexpr (MK_PROBE != 0u) t_ph = __builtin_amdgcn_s_memrealtime();
#define PROBE_IDLE(n) do { if constexpr (MK_PROBE != 0u) { if constexpr (((MK_PROBE) >> (n)) & 1u) { const unsigned long long t1_ = __builtin_amdgcn_s_memrealtime(), d_ = t1_ - t_ph; \
        while (__builtin_amdgcn_s_memrealtime() - t1_ < d_) __builtin_amdgcn_s_sleep(8); } t_ph = __builtin_amdgcn_s_memrealtime(); } } while (0)
#define GRID_BAR(n) do { xcd_barrier(bar); PROBE_IDLE(n); } while (0)
    const float* mod = (const float*)(ws + WS_MOD);
    bf16_t* H = (bf16_t*)(ws + WS_H);
    bf16_t* ABUF = (bf16_t*)(ws + WS_ABUF);

    PH(0) { p0_prologue(a, lds, tid, lane, wave, vcu, G); convert_weights(a, lds, 0, lane, wave, gw, NGW); }
    GRID_BAR(0);
#if MK_STAGE == 0
    copy_rows(a.in[I_X], a.out, lane, gw, NGW); return;
#endif
    PH(1) p1_ln_rows(a, lane, gw, NGW);
    GRID_BAR(1);
    PH(2) {   pg8::SchedInProj0 S{G, vcu};
        pg8::EpiQKV E{(bf16_t*)(ws + RG_Q), (bf16_t*)(ws + RG_K), (bf16_t*)(ws + RG_V), (bf16_t*)(ws + RG_P), a.in[I_QG], a.in[I_KG]};
        pg8::gemm_phase<pg8::EpiQKV, pg8::SchedInProj0, false>(lds, ABUF, (const bf16_t*)(ws + WS_WIN0), 1024, S, E); }
    PH(2) {   const int nfull = 648 % G;
        if (nfull != 0 && vcu >= nfull) convert_weights(a, lds, 1, lane, wave, (vcu - nfull) * NWAVES + wave, (G - nfull) * NWAVES);
        else if (nfull == 0) convert_weights(a, lds, 1, lane, wave, gw, NGW); }
    GRID_BAR(2);
    PH(3) {   const int nper = (NB * 8 * (SEQ / 256)) / G;
        for (int i = 0; i < nper; ++i) { const int uidx = vcu * nper + i; const int b = uidx >> 7, rem = uidx & 127, h = rem & 7, qb = rem >> 3;
            attn_body::attn_unit<8>(b, h, qb, (const bf16_t*)(ws + RG_Q), (const bf16_t*)(ws + RG_K), (const bf16_t*)(ws + RG_V), (bf16_t*)(ws + RG_A2), (char*)lds_raw); }
        for (int p = gw; p < (MT / 32) * 2; p += NGW)
#pragma unroll 1
            for (int k = 0; k < 2; ++k) pool_task(p >> 1, (p & 1) ? 1 + k : 3 * k, (const bf16_t*)(ws + RG_P), (const bf16_t*)(ws + WS_WPOOL), a.in[I_POOLS], (bf16_t*)(ws + RG_A2), lane); }
    GRID_BAR(3);
    PH(4) {   pg8::SchedGrid S{4, 128 * 4, G, vcu};
        pg8::EpiResid<true> E{a.in[I_X], H, mod + 2 * 1024};
        pg8::gemm_phase<pg8::EpiResid<true>, pg8::SchedGrid, false>(lds, (const bf16_t*)(ws + RG_A2), (const bf16_t*)(ws + WS_WOUT0), 1024, S, E); }
    GRID_BAR(4);
#if MK_STAGE == 1
    copy_rows(H, a.out, lane, gw, NGW); return;
#endif
#if MK_STAGE >= 2
    PH(5) router_phase(a, 0, lds, tid, lane, wave, G);
    GRID_BAR(5);
    build_tp(a, 0, lds, tid);
    PH(6) {   pg8::SchedMoE S{(const volatile LAS int*)(lds + TP_OFF), (const int*)(ws + RT_LIST), G, vcu, false, (const f32x2*)(ws + RT_WSLOT), lds + SIDE_OFF};
        pg8::EpiGateUp E{(bf16_t*)(ws + WS_RGN), lds + SIDE_OFF};
        pg8::gemm_phase<pg8::EpiGateUp, pg8::SchedMoE, true>(lds, ABUF, (const bf16_t*)(ws + WS_WGU), 1024, S, E); }
    PH(6) {   const int nun = ((const volatile LAS int*)(lds + TP_OFF))[NCLS] * 4, nfull = nun % G;
        if (nfull != 0 && vcu >= nfull) convert_weights(a, lds, 2, lane, wave, (vcu - nfull) * NWAVES + wave, (G - nfull) * NWAVES);
        else if (nfull == 0) convert_weights(a, lds, 2, lane, wave, gw, NGW); }
    GRID_BAR(6);
    PH(7) {   pg8::SchedMoE S{(const volatile LAS int*)(lds + TP_OFF), (const int*)(ws + RT_LIST), G, vcu, true, (const f32x2*)(ws + RT_WSLOT), lds + SIDE_OFF};
        pg8::EpiCombine<false> E{H, a.out, mod + 5 * 1024, lds + SIDE_OFF};
        pg8::gemm_phase<pg8::EpiCombine<false>, pg8::SchedMoE, false, true>(lds, (const bf16_t*)(ws + WS_RGN), (const bf16_t*)(ws + WS_WDN), 512, S, E); }
    GRID_BAR(7);
#endif
#if MK_STAGE >= 3
    PH(8) ln1_phase(a, lane, gw, NGW);
    GRID_BAR(8);
#endif
#if MK_STAGE == 2
    copy_rows(H, a.out, lane, gw, NGW); return;
#endif
#if MK_STAGE >= 3
    PH(9) {   pg8::SchedGrid S{10, 128 * 10, G, vcu};
        pg8::EpiBf16 E{(bf16_t*)(ws + WS_RGN), 2560, false};
        pg8::gemm_phase<pg8::EpiBf16, pg8::SchedGrid, false>(lds, ABUF, (const bf16_t*)(ws + WS_WIN1), 1024, S, E); }
    GRID_BAR(9);
    PH(10) sgconv_phase(a, lds, tid, lane, wave, G);
    GRID_BAR(10);
    PH(11) {   pg8::SchedGrid S{4, 128 * 4, G, vcu};
        pg8::EpiResid<false> E{H, H, mod + (size_t)9 * 6144 + 2 * 1024};
        pg8::gemm_phase<pg8::EpiResid<false>, pg8::SchedGrid, false>(lds, ABUF, (const bf16_t*)(ws + WS_WOUT1), 1024, S, E); }
    GRID_BAR(11);
#endif
#if MK_STAGE == 3
    copy_rows(H, a.out, lane, gw, NGW); return;
#endif
#if MK_STAGE >= 4
    router_phase(a, 1, lds, tid, lane, wave, G);
    GRID_BAR(12);
    build_tp(a, 1, lds, tid);
    {   pg8::SchedMoE S{(const volatile LAS int*)(lds + TP_OFF), (const int*)(ws + RT_LIST), G, vcu, false, (const f32x2*)(ws + RT_WSLOT), lds + SIDE_OFF};
        pg8::EpiGateUp E{(bf16_t*)(ws + WS_RGN), lds + SIDE_OFF};
        pg8::gemm_phase<pg8::EpiGateUp, pg8::SchedMoE, true>(lds, ABUF, (const bf16_t*)(ws + WS_WGU) + (size_t)8192 * 1024, 1024, S, E); }
    GRID_BAR(13);
    {   pg8::SchedMoE S{(const volatile LAS int*)(lds + TP_OFF), (const int*)(ws + RT_LIST), G, vcu, true, (const f32x2*)(ws + RT_WSLOT), lds + SIDE_OFF};
        pg8::EpiCombine<true> E{H, a.out, mod + (size_t)9 * 6144 + 5 * 1024, lds + SIDE_OFF};
        pg8::gemm_phase<pg8::EpiCombine<true>, pg8::SchedMoE, false, true>(lds, (const bf16_t*)(ws + WS_RGN), (const bf16_t*)(ws + WS_WDN) + (size_t)16384 * 256, 512, S, E); }
    PROBE_IDLE(15);
#endif
#undef tid
#undef lane
}

extern "C" void kernel_launch(void* const* d_in, const int* in_sizes, int n_in, void* d_out, int out_size, void* d_ws, size_t ws_size, hipStream_t stream) {
    static int grid = 0;
    if (grid == 0) {
        if (n_in != 27 || out_size != MT * DM || ws_size < WS_END) { fprintf(stderr, "kernel_launch: unexpected problem (n_in %d, out %d, ws %zu)\n", n_in, out_size, ws_size); grid = -1; return; }
        int dev = 0, cus = 0, per_cu = 0;
        if (hipGetDevice(&dev) != hipSuccess || hipDeviceGetAttribute(&cus, hipDeviceAttributeMultiprocessorCount, dev) != hipSuccess) { grid = -1; return; }
        if (hipFuncSetAttribute((const void*)mk_fwd, hipFuncAttributeMaxDynamicSharedMemorySize, LDS_BYTES) != hipSuccess) { fprintf(stderr, "kernel_launch: hipFuncSetAttribute failed\n"); grid = -1; return; }
        if (hipOccupancyMaxActiveBlocksPerMultiprocessor(&per_cu, (const void*)mk_fwd, NWAVES * 64, LDS_BYTES) != hipSuccess || per_cu < 1) { fprintf(stderr, "kernel_launch: occupancy query says %d blocks per CU\n", per_cu); }
        (void)hipGetLastError();
        grid = cus;
    }
    if (grid < 0) return;
    if (hipMemsetAsync((char*)d_ws + WS_CTL, 0, CTL_ZERO_BYTES, stream) != hipSuccess) return;
    Args a{};
    for (int i = 0; i < 27; ++i) a.in[i] = (const float*)d_in[i];
    a.out = (float*)d_out; a.ws = (unsigned char*)d_ws;
    hipLaunchKernelGGL(mk_fwd, dim3(grid), dim3(NWAVES * 64), LDS_BYTES, stream, a);
}
```

```cpp
#include <hip/hip_runtime.h>
#include <cstdio>
#include <cstdint>

#ifndef MK_PH
#define MK_PH 0xffffffffu
#endif
#define PH(n) if constexpr (((MK_PH) >> (n)) & 1u)
#ifndef MK_PROBE
#define MK_PROBE 0u
#endif
#ifndef MK_STAGE
#define MK_STAGE 4
#endif

#define LAS __attribute__((address_space(3)))
#define GAS __attribute__((address_space(1)))
typedef unsigned short bf16_t;
typedef short bf16x8 __attribute__((ext_vector_type(8)));
typedef short s16x4 __attribute__((ext_vector_type(4)));
typedef float f32x2 __attribute__((ext_vector_type(2)));
typedef float f32x4 __attribute__((ext_vector_type(4)));
typedef float f32x16 __attribute__((ext_vector_type(16)));
typedef unsigned u32x2 __attribute__((ext_vector_type(2)));
typedef unsigned u32x4 __attribute__((ext_vector_type(4)));

constexpr int NB = 8, SEQ = 4096, DM = 1024, MT = NB * SEQ, CTX = 256, MC = NB * CTX, MA = MT + MC, NKV = SEQ + CTX;
constexpr int NEXP = 16, DEXP = 256, NCLS = 24, LISTCAP = MT;
constexpr int SLOT_ROWS = MT + NCLS * 256;
constexpr float EPS = 1e-6f;
constexpr float C2 = 0.125f * 1.4426950408889634f;

constexpr size_t MiB = 1u << 20;
constexpr size_t WS_CTL = 0, CTL_ZERO_BYTES = 65536;
constexpr size_t WS_MOD = 512 * 1024;
constexpr size_t WS_WIN0 = 2 * MiB;
constexpr size_t WS_WOUT0 = 5 * MiB;
constexpr size_t WS_WIN1 = 7 * MiB;
constexpr size_t WS_WOUT1 = 12 * MiB;
constexpr size_t WS_WGU = 14 * MiB;
constexpr size_t WS_WDN = 46 * MiB;
constexpr size_t WS_WPOOL = 62 * MiB;
constexpr size_t WS_WSG = 62 * MiB + 512 * 1024;
constexpr size_t WS_ABUF = 64 * MiB;
constexpr size_t WS_H = 132 * MiB;
constexpr size_t WS_ACT = 260 * MiB;
constexpr size_t WS_RGN = 294 * MiB;
constexpr size_t RG_Q = WS_RGN, RG_K = RG_Q + 32 * MiB, RG_V = RG_K + 9 * MiB, RG_P = RG_V + 9 * MiB, RG_A2 = RG_P + 32 * MiB;
constexpr size_t WS_ROUTE = 462 * MiB;
constexpr size_t RT_LIST = WS_ROUTE;
constexpr size_t RT_WSLOT = WS_ACT;
constexpr size_t WS_END = 466 * MiB;
static_assert(RG_A2 + (size_t)MT * 1024 * 2 <= WS_ROUTE && WS_RGN + (size_t)SLOT_ROWS * 512 * 2 <= WS_ROUTE && WS_RGN + (size_t)MT * 2560 * 2 <= WS_ROUTE && RT_LIST + (size_t)NCLS * LISTCAP * 4 <= WS_END && RT_WSLOT + (size_t)NCLS * LISTCAP * 8 <= WS_RGN, "region map");
static_assert(WS_ABUF + (size_t)MA * 1024 * 2 <= WS_H && WS_H + (size_t)MT * 1024 * 4 <= WS_ACT, "ws map");
constexpr int CW_CNT = 64;
constexpr int CW_BAR = 4096;

constexpr int RING_BYTES = 131072;
constexpr int LDSCTL_OFF = RING_BYTES, MISC_OFF = LDSCTL_OFF + 320;
constexpr int SIDE_OFF = LDSCTL_OFF + 1024;
constexpr int LDS_BYTES = 147456;
constexpr int NWAVES = 8;

__device__ __forceinline__ unsigned cvt_pk_bf16(float lo, float hi) { unsigned r; asm volatile("v_cvt_pk_bf16_f32 %0, %1, %2" : "=v"(r) : "v"(lo), "v"(hi)); return r; }
__device__ __forceinline__ float bf_lo(unsigned w) { return __uint_as_float(w << 16); }
__device__ __forceinline__ float bf_hi(unsigned w) { return __uint_as_float(w & 0xffff0000u); }
__device__ __forceinline__ float wave_sum(float v) {
#pragma unroll
    for (int o = 1; o < 64; o <<= 1) v += __shfl_xor(v, o);
    return v;
}
__device__ __forceinline__ float fast_rcp(float x) { return __builtin_amdgcn_rcpf(x); }
__device__ __forceinline__ float silu_f(float v) { return v * fast_rcp(1.f + __builtin_amdgcn_exp2f(-1.4426950408889634f * v)); }

__device__ __forceinline__ int opaque_tid() { int t = threadIdx.x; asm volatile("" : "+v"(t)); return t; }

#define XB_TMO      128
#define XB_XCNT(j)  (256  + 64 * (j))
#define XB_XSUB(j)  (1280 + 64 * (j))
#define XB_XGEN(j)  (2304 + 64 * (j))
#define XB_TOP      3328
#define XB_TOPGEN   3392
#define XCD_BAR_WORDS 3456
#define XB_SPIN_CAP (1u << 18)
__device__ __forceinline__ unsigned xb_ld(unsigned* p)              { return __hip_atomic_load(p, __ATOMIC_RELAXED, __HIP_MEMORY_SCOPE_AGENT); }
__device__ __forceinline__ unsigned xb_add(unsigned* p, unsigned v) { return __hip_atomic_fetch_add(p, v, __ATOMIC_RELAXED, __HIP_MEMORY_SCOPE_AGENT); }
__device__ __forceinline__ unsigned xb_xcc_id() { return (unsigned)__builtin_amdgcn_s_getreg((3 << 11) | 20) & 0xFu; }
#define XB_SPIN(cond, bar) do { unsigned _sp = 0; while (cond) { __builtin_amdgcn_s_sleep(1); \
    if ((++_sp & 255u) == 0u) { if (xb_ld(&(bar)[XB_TMO])) break; if (_sp > XB_SPIN_CAP) { atomicAdd(&(bar)[XB_TMO], 1u); break; } } } } while (0)
struct XcdBarrier { unsigned* bar; unsigned x; volatile LAS unsigned* st; };
__device__ __forceinline__ XcdBarrier xcd_barrier_post(unsigned* bar, volatile LAS unsigned* st) {
    XcdBarrier b; b.bar = bar; b.x = xb_xcc_id(); b.st = st;
    if (threadIdx.x == 0) (void)xb_add(&bar[XB_XCNT(b.x)], 1u);
    return b;
}
__device__ __forceinline__ void xcd_barrier_complete(unsigned* bar, unsigned x, unsigned& nloc, unsigned& nx) {
    const unsigned G = gridDim.x * gridDim.y * gridDim.z;
    unsigned sum, cnt, mine, sp = 0u;
    for (;;) {
        sum = 0u; cnt = 0u; mine = 0u;
#pragma unroll
        for (unsigned j = 0; j < 16; ++j) { const unsigned c = xb_ld(&bar[XB_XCNT(j)]); sum += c; cnt += (c > 0u) ? 1u : 0u; mine = (j == x) ? c : mine; }
        if (sum == G) break;
        __builtin_amdgcn_s_sleep(1);
        if ((++sp & 255u) == 0u) { if (xb_ld(&bar[XB_TMO])) break; if (sp > XB_SPIN_CAP) { atomicAdd(&bar[XB_TMO], 1u); break; } }
    }
    nloc = mine > 0u ? mine : 1u; nx = cnt > 0u ? cnt : 1u;
}
__device__ __forceinline__ void xcd_barrier(const XcdBarrier& b) {
    asm volatile("s_waitcnt vmcnt(0)" ::: "memory");
    __syncthreads();
    if (threadIdx.x == 0) {
        unsigned* bar = b.bar;
        __builtin_amdgcn_s_waitcnt(0);
        unsigned nloc = b.st[0], nx = b.st[1];
        if (nloc == 0u) { xcd_barrier_complete(bar, b.x, nloc, nx); b.st[0] = nloc; b.st[1] = nx; }
        const unsigned old = xb_add(&bar[XB_XSUB(b.x)], 1u);
        const unsigned gen = old / nloc;
        if (old + 1u == (gen + 1u) * nloc) {
            __builtin_amdgcn_fence(__ATOMIC_RELEASE, "agent");
            asm volatile("s_waitcnt vmcnt(0)" ::: "memory");
            const unsigned og = xb_add(&bar[XB_TOP], 1u);
            const unsigned tg = og / nx;
            if (og + 1u == (tg + 1u) * nx) xb_add(&bar[XB_TOPGEN], 1u);
            else XB_SPIN(xb_ld(&bar[XB_TOPGEN]) == tg, bar);
            __builtin_amdgcn_fence(__ATOMIC_ACQUIRE, "agent");
            xb_add(&bar[XB_XGEN(b.x)], 1u);
            asm volatile("s_waitcnt vmcnt(0)" ::: "memory");
        } else {
            XB_SPIN(xb_ld(&bar[XB_XGEN(b.x)]) == gen, bar);
            __builtin_amdgcn_fence(__ATOMIC_ACQUIRE, "agent");
            asm volatile("s_waitcnt vmcnt(0)" ::: "memory");
        }
    }
    __syncthreads();
}

namespace pg8 {
constexpr int BM = 256, BK = 64, HALF = 128, HTB = HALF * BK * 2;
__device__ __forceinline__ int lds_byte(int r, int c) { const int st = (r >> 4) * 2 + (c >> 5), rr = r & 15, cc = c & 31, ob = rr * 64 + cc * 2; return st * 1024 + (ob ^ (((ob >> 9) & 1) << 5)); }
__device__ __forceinline__ void stage_rc(int b, int& R, int& C) { const int st = b / 1024, sb = b % 1024, swz = sb ^ (((sb >> 9) & 1) << 5); R = (st >> 1) * 16 + swz / 64; C = (st & 1) * 32 + (swz % 64) / 2; }
__device__ __forceinline__ int perm32(int rho) { const int n = rho >> 4, i = rho & 15; return 8 * (i >> 2) + 4 * n + (i & 3); }

struct Unit { int pm, pn, pn2, aux, e, r, slot; };

template <class Epi, class Sched, bool GATHER, bool SPLITB = false>
__device__ __forceinline__ void gemm_phase(LAS unsigned char* lds, const bf16_t* A, const bf16_t* Bt, const int K, const Sched& S, const Epi& E) {
    const int tid = opaque_tid(), wid = __builtin_amdgcn_readfirstlane(tid >> 6), lane = tid & 63, wr = wid >> 2, wc = wid & 3, fr = lane & 15, fq = lane >> 4;
    const int nt = K / BK, KB = SPLITB ? K / 2 : K, ntb = SPLITB ? nt / 2 : nt;
    unsigned voffB[2]; int RA[2], CA[2];
#pragma unroll
    for (int i = 0; i < 2; ++i) { int R, C; stage_rc(tid * 16 + i * 8192, R, C); const int Rb = Epi::PERM ? ((R & ~31) + perm32(R & 31)) : R;
        voffB[i] = (unsigned)(Rb * KB + C) * 2u; RA[i] = R; CA[i] = C; }
    const size_t kstep = (size_t)(BK * 2);
    const size_t hstep = (size_t)HALF * K * 2;
    const size_t tstep = 2 * hstep;
    const size_t hstepB = (size_t)HALF * KB * 2, tstepB = 2 * hstepB;
    const unsigned ldsw = (unsigned)wid * 1024u;
    const int aoff = lds_byte(wr * 64 + fr, fq * 8), boff = lds_byte(wc * 32 + fr, fq * 8);
#define PG8_SA(b, h) (((b) * 2 + (h)) * HTB)
#define PG8_SB(b, h) ((4 + (b) * 2 + (h)) * HTB)
#define PG8_STAGE(bufoff, gbase, voff) do { _Pragma("unroll") for (int _i = 0; _i < 2; ++_i) \
        __builtin_amdgcn_global_load_lds((const unsigned*)((const char*)(gbase) + (voff)[_i]), (LAS unsigned*)(lds + (bufoff) + ldsw + _i * 8192), 16, 0, 0); } while (0)
#define PG8_LDA(dst, b, h) do { _Pragma("unroll") for (int m = 0; m < 4; ++m) _Pragma("unroll") for (int k = 0; k < 2; ++k) dst[m][k] = *(const LAS bf16x8*)(lds + PG8_SA(b, h) + aoff + m * 2048 + k * 1024); } while (0)
#define PG8_LDB(dst, b, h) do { _Pragma("unroll") for (int n = 0; n < 2; ++n) _Pragma("unroll") for (int k = 0; k < 2; ++k) dst[n][k] = *(const LAS bf16x8*)(lds + PG8_SB(b, h) + boff + n * 2048 + k * 1024); } while (0)
#define PG8_MMA(ai, bj, At, Bt_) do { __builtin_amdgcn_s_setprio(1); _Pragma("unroll") for (int m = 0; m < 4; ++m) _Pragma("unroll") for (int n = 0; n < 2; ++n) _Pragma("unroll") for (int k = 0; k < 2; ++k) \
        acc[ai][bj][m][n] = __builtin_amdgcn_mfma_f32_16x16x32_bf16(Bt_[n][k], At[m][k], acc[ai][bj][m][n], 0, 0, 0); __builtin_amdgcn_s_setprio(0); } while (0)
#define PG8_WAIT_V(n) asm volatile("s_waitcnt vmcnt(" #n ")" ::: "memory")
#define PG8_WAIT_L(n) asm volatile("s_waitcnt lgkmcnt(" #n ")" ::: "memory")
#define PG8_BAR __builtin_amdgcn_s_barrier()
#define PG8_SCHED __builtin_amdgcn_sched_barrier(0)
    Unit cur, nxt; int ui = 0;
    if (!S.next(0, cur)) return;
    cur.slot = 0; S.prep(cur, tid);
    unsigned voA[2][2], voN[2][2];
    if constexpr (GATHER) S.rows(cur, RA, CA, K, voA);
    else {
#pragma unroll
        for (int h = 0; h < 2; ++h)
#pragma unroll
            for (int i = 0; i < 2; ++i) voA[h][i] = (unsigned)((h * HALF + RA[i]) * K + CA[i]) * 2u;
    }
    f32x4 acc[2][2][4][2];
#pragma unroll
    for (int a = 0; a < 2; ++a)
#pragma unroll
        for (int b = 0; b < 2; ++b)
#pragma unroll
            for (int m = 0; m < 4; ++m)
#pragma unroll
                for (int n = 0; n < 2; ++n) acc[a][b][m][n] = (f32x4){0.f, 0.f, 0.f, 0.f};
    bf16x8 At[4][2], B0[2][2], B1[2][2];
    const char* cA = GATHER ? (const char*)A : (const char*)A + (size_t)cur.pm * tstep;
    const char* cB = (const char*)Bt + (size_t)cur.pn * tstepB;
    const char* cB2 = SPLITB ? (const char*)Bt + (size_t)cur.pn2 * tstepB : cB;
    PG8_STAGE(PG8_SB(0, 0), cB, voffB); PG8_STAGE(PG8_SB(0, 1), cB + hstepB, voffB); PG8_STAGE(PG8_SA(0, 0), cA, voA[0]); PG8_STAGE(PG8_SA(0, 1), cA, voA[1]);
    if (wr == 1) PG8_BAR;
    PG8_WAIT_V(2); PG8_BAR;
    PG8_STAGE(PG8_SB(1, 0), cB + kstep, voffB); PG8_STAGE(PG8_SA(1, 0), cA + kstep, voA[0]); PG8_STAGE(PG8_SB(1, 1), cB + hstepB + kstep, voffB);
    PG8_WAIT_V(6); PG8_BAR;
    for (;;) {
        const bool has_next = S.next(ui + 1, nxt);
        if (has_next) { nxt.slot = (cur.slot == 2) ? 0 : cur.slot + 1; S.prep(nxt, tid); }
        const char* nA = cA; const char* nB = cB; const char* nB2 = cB2;
        if (has_next) { nA = GATHER ? (const char*)A : (const char*)A + (size_t)nxt.pm * tstep; nB = (const char*)Bt + (size_t)nxt.pn * tstepB; nB2 = SPLITB ? (const char*)Bt + (size_t)nxt.pn2 * tstepB : nB; }
        if constexpr (GATHER) {
            if (has_next) S.rows(nxt, RA, CA, K, voN);
            else {
#pragma unroll
                for (int h = 0; h < 2; ++h)
#pragma unroll
                    for (int i = 0; i < 2; ++i) voN[h][i] = voA[h][i];
            }
        }
#pragma unroll 1
        for (int t = 0; t < nt; t += 2) {
            const bool last = (t == nt - 2);
            const char* a1 = cA + (size_t)(t + 1) * kstep;
            const char* a2 = last ? nA : cA + (size_t)(t + 2) * kstep;
            const char* b2 = last ? nB : (SPLITB && t + 2 >= ntb) ? cB2 + (size_t)(t + 2 - ntb) * kstep : cB + (size_t)(t + 2) * kstep;
            const char* a3 = a2 + kstep; const char* b3 = b2 + kstep;
            unsigned sel[2][2];
#pragma unroll
            for (int h = 0; h < 2; ++h)
#pragma unroll
                for (int i = 0; i < 2; ++i) sel[h][i] = (GATHER && last) ? voN[h][i] : voA[h][i];
            PG8_LDB(B0, 0, 0); PG8_LDB(B1, 0, 1); PG8_SCHED; PG8_LDA(At, 0, 0); PG8_STAGE(PG8_SA(1, 1), a1, voA[1]);
            PG8_WAIT_V(8); PG8_WAIT_L(0); PG8_BAR; PG8_MMA(0, 0, At, B0); PG8_MMA(0, 1, At, B1); PG8_BAR; PG8_SCHED;
            PG8_LDA(At, 0, 1); PG8_STAGE(PG8_SB(0, 0), b2, voffB); PG8_STAGE(PG8_SB(0, 1), b2 + hstepB, voffB); PG8_STAGE(PG8_SA(0, 0), a2, sel[0]);
            PG8_WAIT_V(8); PG8_WAIT_L(0); PG8_BAR; PG8_MMA(1, 0, At, B0); PG8_MMA(1, 1, At, B1); PG8_BAR; PG8_SCHED;
            PG8_LDB(B0, 1, 0); PG8_LDB(B1, 1, 1); PG8_SCHED; PG8_LDA(At, 1, 0); PG8_STAGE(PG8_SA(0, 1), a2, sel[1]);
            PG8_WAIT_V(8); PG8_WAIT_L(0); PG8_BAR; PG8_MMA(0, 0, At, B0); PG8_MMA(0, 1, At, B1); PG8_BAR; PG8_SCHED;
            PG8_LDA(At, 1, 1); PG8_STAGE(PG8_SB(1, 0), b3, voffB); PG8_STAGE(PG8_SB(1, 1), b3 + hstepB, voffB); PG8_STAGE(PG8_SA(1, 0), a3, sel[0]);
            PG8_WAIT_V(8); PG8_WAIT_L(0); PG8_BAR; PG8_MMA(1, 0, At, B0); PG8_MMA(1, 1, At, B1); PG8_BAR; PG8_SCHED;
        }
        if constexpr (Epi::ALIGN) { if (wr == 0) PG8_BAR; }
        E(acc, cur, wr, wc, fr, fq);
        if (!has_next) break;
#pragma unroll
        for (int a = 0; a < 2; ++a)
#pragma unroll
            for (int b = 0; b < 2; ++b)
#pragma unroll
                for (int m = 0; m < 4; ++m)
#pragma unroll
                    for (int n = 0; n < 2; ++n) acc[a][b][m][n] = (f32x4){0.f, 0.f, 0.f, 0.f};
        cur = nxt; cA = nA; cB = nB; cB2 = nB2; ++ui;
        if constexpr (GATHER) {
#pragma unroll
            for (int h = 0; h < 2; ++h)
#pragma unroll
                for (int i = 0; i < 2; ++i) voA[h][i] = voN[h][i];
        }
        if constexpr (Epi::ALIGN) { if (wr == 1) PG8_BAR; }
    }
    PG8_WAIT_V(0);
    if constexpr (!Epi::ALIGN) { if (wr == 0) PG8_BAR; }
    PG8_BAR;
#undef PG8_SA
#undef PG8_SB
#undef PG8_STAGE
#undef PG8_LDA
#undef PG8_LDB
#undef PG8_MMA
#undef PG8_WAIT_V
#undef PG8_WAIT_L
#undef PG8_BAR
#undef PG8_SCHED
}

struct SchedGrid {
    int nN, total, G, c;
    __device__ __forceinline__ bool next(int i, Unit& u) const { const int L = i * G + c; if (L >= total) return false; u.pm = L / nN; u.pn = L % nN; u.pn2 = 0; u.aux = u.pn; u.e = 0; u.r = 0; return true; }
    __device__ __forceinline__ void prep(const Unit&, int) const {}
};
struct SchedInProj0 {
    int G, c;
    __device__ __forceinline__ bool next(int i, Unit& u) const { const int L = i * G + c; if (L >= 648) return false;
        if (L < 640) { u.pm = L / 5; u.pn = L % 5; } else { u.pm = 128 + (L - 640); u.pn = 2; } u.pn2 = 0; u.aux = u.pn; u.e = 0; u.r = 0; return true; }
    __device__ __forceinline__ void prep(const Unit&, int) const {}
};
struct SchedMoE {
    const volatile LAS int* tp; const int* list; int G, c; bool down; const f32x2* wslot; LAS unsigned char* side;
    __device__ __forceinline__ void prep(const Unit& u, int tid) const {
        if (tid < 256) { const int idx = u.r * 256 + tid; const bool ok = idx < tp[NCLS + 1 + u.e];
            ((LAS int*)(side + u.slot * 3072))[tid] = ok ? list[u.e * LISTCAP + idx] : -1;
            if (!down) ((LAS f32x2*)(side + u.slot * 3072 + 1024))[tid] = ok ? wslot[(size_t)u.e * LISTCAP + idx] : (f32x2){0.f, 0.f}; }
    }
    __device__ __forceinline__ bool next(int i, Unit& u) const {
        const int L = i * G + c; const int total = tp[NCLS] * 4; if (L >= total) return false;
        const int rt = L >> 2, ct = L & 3; int cl = 0;
#pragma unroll
        for (int j = 1; j < NCLS; ++j) cl += (rt >= tp[j]) ? 1 : 0;
        cl = __builtin_amdgcn_readfirstlane(cl);
        const int g = cl / 6, p = cl % 6; const int lo = (p < 3) ? 0 : (p < 5) ? 1 : 2, hi = (p < 3) ? p + 1 : (p < 5) ? p - 1 : 3;
        const int elo = 4 * g + lo, ehi = 4 * g + hi;
        u.pm = rt; u.aux = ct; u.e = cl; u.r = rt - tp[cl];
        if (down) { u.pn = elo * 4 + ct; u.pn2 = ehi * 4 + ct; }
        else { u.pn = ((ct < 2) ? elo : ehi) * 2 + (ct & 1); u.pn2 = 0; }
        return true;
    }
    __device__ __forceinline__ void rows(const Unit& u, const int (&RA)[2], const int (&CA)[2], int K, unsigned (&vo)[2][2]) const {
        const int cnt = tp[NCLS + 1 + u.e];
#pragma unroll
        for (int h = 0; h < 2; ++h)
#pragma unroll
            for (int i = 0; i < 2; ++i) { const int idx = u.r * 256 + h * HALF + RA[i]; const int tok = (idx < cnt) ? list[u.e * LISTCAP + idx] : 0;
                vo[h][i] = (unsigned)(tok * K + CA[i]) * 2u; }
    }
};

typedef f32x4 Acc[2][2][4][2];
struct EpiBf16 {
    static constexpr bool PERM = true, ALIGN = true;
    bf16_t* O; int ldc; bool use_aux;
    __device__ __forceinline__ void operator()(const Acc& acc, const Unit& u, int wr, int wc, int fr_, int fq_) const {
        int ln_ = fr_ | (fq_ << 4); asm volatile("" : "+v"(ln_)); const int fr = ln_ & 15, fq = ln_ >> 4;
        const int row0 = u.pm * BM + wr * 64 + fr; const int col0 = (use_aux ? u.aux : u.pn) * BM + wc * 32 + 8 * fq;
#pragma unroll
        for (int ai = 0; ai < 2; ++ai)
#pragma unroll
            for (int m = 0; m < 4; ++m) { bf16_t* rowp = O + (size_t)(row0 + ai * HALF + m * 16) * ldc + col0;
#pragma unroll
                for (int bj = 0; bj < 2; ++bj) { const f32x4 v0 = acc[ai][bj][m][0], v1 = acc[ai][bj][m][1];
                    u32x4 w; w.x = cvt_pk_bf16(v0[0], v0[1]); w.y = cvt_pk_bf16(v0[2], v0[3]); w.z = cvt_pk_bf16(v1[0], v1[1]); w.w = cvt_pk_bf16(v1[2], v1[3]);
                    *(u32x4*)(rowp + bj * HALF) = w; } }
    }
};
struct EpiGateUp {
    static constexpr bool PERM = true, ALIGN = true;
    bf16_t* O; LAS unsigned char* side;
    __device__ __forceinline__ void operator()(const Acc& acc, const Unit& u, int wr, int wc, int fr_, int fq_) const {
        int ln_ = fr_ | (fq_ << 4); asm volatile("" : "+v"(ln_)); const int fr = ln_ & 15, fq = ln_ >> 4;
        const int row0 = u.pm * BM + wr * 64 + fr; const int col0 = u.aux * HALF + wc * 32 + 8 * fq;
        const LAS float* wp = (const LAS float*)(side + u.slot * 3072 + 1024) + 2 * (wr * 64 + fr) + ((u.aux < 2) ? 0 : 1);
#pragma unroll
        for (int ai = 0; ai < 2; ++ai)
#pragma unroll
            for (int m = 0; m < 4; ++m) { const int rl = ai * HALF + m * 16; bf16_t* rowp = O + (size_t)(row0 + rl) * 512 + col0;
                const float w = wp[2 * rl];
                float o[8];
#pragma unroll
                for (int n = 0; n < 2; ++n)
#pragma unroll
                    for (int j = 0; j < 4; ++j) o[n * 4 + j] = w * silu_f(acc[ai][0][m][n][j]) * acc[ai][1][m][n][j];
                u32x4 wv; wv.x = cvt_pk_bf16(o[0], o[1]); wv.y = cvt_pk_bf16(o[2], o[3]); wv.z = cvt_pk_bf16(o[4], o[5]); wv.w = cvt_pk_bf16(o[6], o[7]);
                *(u32x4*)rowp = wv; }
    }
};
template <bool FINAL> struct EpiCombine {
    static constexpr bool PERM = true, ALIGN = true;
    bf16_t* H; float* out; const float* gate; LAS unsigned char* side;
    __device__ __forceinline__ void operator()(const Acc& acc, const Unit& u, int wr, int wc, int fr_, int fq_) const {
        int ln_ = fr_ | (fq_ << 4); asm volatile("" : "+v"(ln_)); const int fr = ln_ & 15, fq = ln_ >> 4;
        const int col0 = u.aux * BM + wc * 32 + 8 * fq;
        const LAS int* tk = (const LAS int*)(side + u.slot * 3072) + wr * 64 + fr;
#pragma unroll
        for (int ai = 0; ai < 2; ++ai)
#pragma unroll
          for (int mp = 0; mp < 4; mp += 2) {
            int tok[2]; u32x4 hw[2][2]; f32x4 gg[2][2][2];
#pragma unroll
            for (int mm = 0; mm < 2; ++mm) { tok[mm] = tk[ai * HALF + (mp + mm) * 16]; const int tc = tok[mm] < 0 ? 0 : tok[mm];
                const float* gb = gate + (size_t)(tc >> 12) * 6144 + col0; const size_t off = (size_t)tc * DM + col0;
#pragma unroll
                for (int bj = 0; bj < 2; ++bj) { hw[mm][bj] = *(const u32x4*)(H + off + bj * HALF); gg[mm][bj][0] = *(const f32x4*)(gb + bj * HALF); gg[mm][bj][1] = *(const f32x4*)(gb + bj * HALF + 4); } }
#pragma unroll
            for (int mm = 0; mm < 2; ++mm) { const int m = mp + mm; const size_t off = (size_t)(tok[mm] < 0 ? 0 : tok[mm]) * DM + col0;
#pragma unroll
                for (int bj = 0; bj < 2; ++bj) { const u32x4 w = hw[mm][bj];
                    const f32x4 h0 = (f32x4){bf_lo(w.x), bf_hi(w.x), bf_lo(w.y), bf_hi(w.y)} + gg[mm][bj][0] * acc[ai][bj][m][0], h1 = (f32x4){bf_lo(w.z), bf_hi(w.z), bf_lo(w.w), bf_hi(w.w)} + gg[mm][bj][1] * acc[ai][bj][m][1];
                    if (tok[mm] >= 0) {
                        if constexpr (FINAL) { *(f32x4*)(out + off + bj * HALF) = h0; *(f32x4*)(out + off + bj * HALF + 4) = h1; }
                        else { u32x4 o; o.x = cvt_pk_bf16(h0[0], h0[1]); o.y = cvt_pk_bf16(h0[2], h0[3]); o.z = cvt_pk_bf16(h1[0], h1[1]); o.w = cvt_pk_bf16(h1[2], h1[3]); *(u32x4*)(H + off + bj * HALF) = o; } } } }
          }
    }
};
template <bool IN_F32> struct EpiResid {
    static constexpr bool PERM = true, ALIGN = true;
    const void* Hin; bf16_t* Hout; const float* gate;
    __device__ __forceinline__ void operator()(const Acc& acc, const Unit& u, int wr, int wc, int fr_, int fq_) const {
        int ln_ = fr_ | (fq_ << 4); asm volatile("" : "+v"(ln_)); const int fr = ln_ & 15, fq = ln_ >> 4;
        const int b = u.pm >> 4; const int col0 = u.pn * BM + wc * 32 + 8 * fq; const float* gb = gate + (size_t)b * 6144 + col0;
        f32x4 gv[2][2];
#pragma unroll
        for (int bj = 0; bj < 2; ++bj)
#pragma unroll
            for (int n = 0; n < 2; ++n) gv[bj][n] = *(const f32x4*)(gb + bj * HALF + 4 * n);
#pragma unroll
        for (int ai = 0; ai < 2; ++ai)
#pragma unroll
          for (int mp = 0; mp < 4; mp += 2) {
            f32x4 hh[2][2][2];
#pragma unroll
            for (int mm = 0; mm < 2; ++mm) { const size_t off = (size_t)(u.pm * BM + ai * HALF + wr * 64 + (mp + mm) * 16 + fr) * DM + col0;
#pragma unroll
                for (int bj = 0; bj < 2; ++bj) {
                    if constexpr (IN_F32) { hh[mm][bj][0] = *(const f32x4*)((const float*)Hin + off + bj * HALF); hh[mm][bj][1] = *(const f32x4*)((const float*)Hin + off + bj * HALF + 4); }
                    else { const u32x4 w = *(const u32x4*)((const bf16_t*)Hin + off + bj * HALF); hh[mm][bj][0] = (f32x4){bf_lo(w.x), bf_hi(w.x), bf_lo(w.y), bf_hi(w.y)}; hh[mm][bj][1] = (f32x4){bf_lo(w.z), bf_hi(w.z), bf_lo(w.w), bf_hi(w.w)}; } } }
#pragma unroll
            for (int mm = 0; mm < 2; ++mm) { const int m = mp + mm; const size_t off = (size_t)(u.pm * BM + ai * HALF + wr * 64 + m * 16 + fr) * DM + col0;
#pragma unroll
                for (int bj = 0; bj < 2; ++bj) { const f32x4 h0 = hh[mm][bj][0] + gv[bj][0] * acc[ai][bj][m][0], h1 = hh[mm][bj][1] + gv[bj][1] * acc[ai][bj][m][1];
                    u32x4 o; o.x = cvt_pk_bf16(h0[0], h0[1]); o.y = cvt_pk_bf16(h0[2], h0[3]); o.z = cvt_pk_bf16(h1[0], h1[1]); o.w = cvt_pk_bf16(h1[2], h1[3]);
                    *(u32x4*)(Hout + off + bj * HALF) = o; } }
          }
    }
};
struct EpiQKV {
    static constexpr bool PERM = true, ALIGN = true;
    bf16_t *Q, *Kb, *Vb, *P; const float *qg, *kg;
    __device__ __forceinline__ void operator()(const Acc& acc, const Unit& u, int wr, int wc, int fr_, int fq_) const {
        int ln_ = fr_ | (fq_ << 4); asm volatile("" : "+v"(ln_)); const int fr = ln_ & 15, fq = ln_ >> 4;
        const int pn = u.pn; const bool isctx = u.pm >= 128;
        const int rloc0 = wr * 64 + fr;
        if (pn >= 3) {
#pragma unroll
            for (int ai = 0; ai < 2; ++ai)
#pragma unroll
                for (int m = 0; m < 4; ++m) { bf16_t* rowp = P + (size_t)(u.pm * BM + rloc0 + ai * HALF + m * 16) * 512 + (pn - 3) * BM + wc * 32 + 8 * fq;
#pragma unroll
                    for (int bj = 0; bj < 2; ++bj) { const f32x4 v0 = acc[ai][bj][m][0], v1 = acc[ai][bj][m][1];
                        u32x4 w; w.x = cvt_pk_bf16(v0[0], v0[1]); w.y = cvt_pk_bf16(v0[2], v0[3]); w.z = cvt_pk_bf16(v1[0], v1[1]); w.w = cvt_pk_bf16(v1[2], v1[3]);
                        *(u32x4*)(rowp + bj * HALF) = w; } }
            return;
        }
        if (pn == 2 && wc >= 2) {
            const int vh = wc - 2;
#pragma unroll
            for (int ai = 0; ai < 2; ++ai)
#pragma unroll
                for (int m = 0; m < 4; ++m) { const int rl = rloc0 + ai * HALF + m * 16; int b, krow;
                    if (isctx) { const int cr = (u.pm - 128) * BM + rl; b = cr >> 8; krow = cr & 255; } else { const int mt = u.pm * BM + rl; b = mt >> 12; krow = CTX + (mt & 4095); }
                    bf16_t* rowp = Vb + ((size_t)(b * 2 + vh) * NKV + krow) * 64 + 8 * fq;
#pragma unroll
                    for (int bj = 0; bj < 2; ++bj) { const f32x4 v0 = acc[ai][bj][m][0], v1 = acc[ai][bj][m][1];
                        u32x4 w; w.x = cvt_pk_bf16(v0[0], v0[1]); w.y = cvt_pk_bf16(v0[2], v0[3]); w.z = cvt_pk_bf16(v1[0], v1[1]); w.w = cvt_pk_bf16(v1[2], v1[3]);
                        *(u32x4*)(rowp + bj * 32) = w; } }
            return;
        }
        const bool isq = pn < 2; const int head = isq ? pn * 4 + wc : wc;
        const float* gsrc = (isq ? qg : kg) + 32 * (fq >> 1) + 8 * (fq & 1);
        float g1[8], g2[8], inv[8];
#pragma unroll
        for (int j = 0; j < 8; ++j) { g1[j] = gsrc[j]; g2[j] = gsrc[16 + j];
            inv[j] = __builtin_amdgcn_exp2f(-(float)(8 * (fq & 1) + j) * (13.287712379549449f / 16.0f)) * 0.15915494309189535f; }
        const float osc = isq ? C2 : 1.0f;
#pragma unroll
        for (int ai = 0; ai < 2; ++ai)
#pragma unroll
            for (int m = 0; m < 4; ++m) {
                const int rl = rloc0 + ai * HALF + m * 16;
                float x1[8], x2[8];
#pragma unroll
                for (int n = 0; n < 2; ++n)
#pragma unroll
                    for (int j = 0; j < 4; ++j) { x1[n * 4 + j] = acc[ai][0][m][n][j]; x2[n * 4 + j] = acc[ai][1][m][n][j]; }
                float ss = 0.f;
#pragma unroll
                for (int j = 0; j < 8; ++j) ss += x1[j] * x1[j] + x2[j] * x2[j];
                ss += __shfl_xor(ss, 16); ss += __shfl_xor(ss, 32);
                const float rstd = __builtin_amdgcn_rsqf(ss * (1.0f / 64.0f) + EPS) * osc;
                int b, krow, mt = 0; float pos = 0.f;
                if (isctx) { const int cr = (u.pm - 128) * BM + rl; b = cr >> 8; krow = cr & 255; }
                else { mt = u.pm * BM + rl; b = mt >> 12; const int t = mt & 4095; krow = CTX + t; pos = (float)((fq >> 1) ? (t & 63) : (t >> 6)); }
                float o1[8], o2[8];
#pragma unroll
                for (int j = 0; j < 8; ++j) { const float y1 = x1[j] * rstd * g1[j], y2 = x2[j] * rstd * g2[j];
                    if (isctx) { o1[j] = y1; o2[j] = y2; }
                    else { const float rev = pos * inv[j]; const float cs = __builtin_amdgcn_cosf(rev), sn = __builtin_amdgcn_sinf(rev);
                        o1[j] = y1 * cs - y2 * sn; o2[j] = y2 * cs + y1 * sn; } }
                bf16_t* rowp = isq ? (Q + (size_t)mt * 512 + head * 64 + 8 * fq) : (Kb + ((size_t)(b * 2 + head) * NKV + krow) * 64 + 8 * fq);
                u32x4 w; w.x = cvt_pk_bf16(o1[0], o1[1]); w.y = cvt_pk_bf16(o1[2], o1[3]); w.z = cvt_pk_bf16(o1[4], o1[5]); w.w = cvt_pk_bf16(o1[6], o1[7]);
                *(u32x4*)rowp = w;
                w.x = cvt_pk_bf16(o2[0], o2[1]); w.y = cvt_pk_bf16(o2[2], o2[3]); w.z = cvt_pk_bf16(o2[4], o2[5]); w.w = cvt_pk_bf16(o2[6], o2[7]);
                *(u32x4*)(rowp + 32) = w;
            }
    }
};
}

namespace attn_body {
constexpr int NW = 8, QBLK = 32, QB = QBLK * NW, KVBLK = 64, NT = NKV / KVBLK;
constexpr int QP = 512, KP = 64, OP = 1024;
static_assert(NT % 2 == 0 && NT >= 8, "tile count");
__device__ __forceinline__ int crow(int r, int hi) { return (r & 3) + 8 * (r >> 2) + 4 * hi; }
#define SBAR() __builtin_amdgcn_sched_barrier(0)
constexpr int NSLOT = 3, SLOTB = 8192;
constexpr int LDS_K = 0, LDS_V = NSLOT * SLOTB, LDS_WS = 2 * NSLOT * SLOTB, LDS_OST = LDS_WS + NW * 64 * 4, ATT_LDS_BYTES = LDS_OST + NW * 4096;
__device__ __forceinline__ void glds16(const void* gsrc, unsigned lds_dst) { unsigned keep;
    asm volatile("s_mov_b32 %0, m0\n\ts_mov_b32 m0, %2\n\ts_nop 0\n\tglobal_load_lds_dwordx4 %1, off\n\ts_mov_b32 m0, %0" : "=&s"(keep) : "v"(gsrc), "s"(lds_dst) : "memory"); }
__device__ __forceinline__ float max3f(float a, float b, float c) { float r; asm("v_max3_f32 %0, %1, %2, %3" : "=v"(r) : "v"(a), "v"(b), "v"(c)); return r; }
__device__ __forceinline__ float max2f(float a, float b) { float r; asm("v_max_f32_e32 %0, %1, %2" : "=v"(r) : "v"(a), "v"(b)); return r; }
__device__ __forceinline__ float fadd_s(float a, float b) { float r; asm("v_add_f32_e32 %0, %1, %2" : "=v"(r) : "v"(a), "v"(b)); return r; }
__device__ __forceinline__ float fsub_s(float a, float b) { float r; asm("v_sub_f32_e32 %0, %1, %2" : "=v"(r) : "v"(a), "v"(b)); return r; }
typedef __bf16 bf16x2_t __attribute__((ext_vector_type(2)));
__device__ __forceinline__ unsigned cvtpk_s(float lo, float hi) { f32x2 v = {lo, hi}; bf16x2_t b = __builtin_convertvector(v, bf16x2_t); return __builtin_bit_cast(unsigned, b); }
#define WAIT_BAR(N) asm volatile("s_waitcnt vmcnt(" #N ") lgkmcnt(0)\n\ts_barrier" ::: "memory")
__device__ __forceinline__ void qkt(f32x16& p0, f32x16& p1, const char* Kslot, const bf16x8* qr, const f32x16& negm, int r32, int hi) {
    const char* kb = Kslot + hi * 1024 + r32 * 16;
#pragma unroll
    for (int d0 = 0; d0 < 4; ++d0) {
        const bf16x8 b0 = *reinterpret_cast<const bf16x8*>(kb + d0 * 2048);
        const bf16x8 b1 = *reinterpret_cast<const bf16x8*>(kb + d0 * 2048 + 512);
        if (d0 == 0) { p0 = __builtin_amdgcn_mfma_f32_32x32x16_bf16(b0, qr[0], negm, 0, 0, 0); p1 = __builtin_amdgcn_mfma_f32_32x32x16_bf16(b1, qr[0], negm, 0, 0, 0); }
        else { p0 = __builtin_amdgcn_mfma_f32_32x32x16_bf16(b0, qr[d0], p0, 0, 0, 0); p1 = __builtin_amdgcn_mfma_f32_32x32x16_bf16(b1, qr[d0], p1, 0, 0, 0); } }
}
typedef __attribute__((address_space(3))) const char* lds_cptr;
typedef short v4i16_t __attribute__((ext_vector_type(4)));
__device__ __forceinline__ void kload8(bf16x8* kf, lds_cptr kp) {
    kf[0] = *(const LAS bf16x8*)(kp);        kf[1] = *(const LAS bf16x8*)(kp + 512);
    kf[2] = *(const LAS bf16x8*)(kp + 2048); kf[3] = *(const LAS bf16x8*)(kp + 2560);
    kf[4] = *(const LAS bf16x8*)(kp + 4096); kf[5] = *(const LAS bf16x8*)(kp + 4608);
    kf[6] = *(const LAS bf16x8*)(kp + 6144); kf[7] = *(const LAS bf16x8*)(kp + 6656);
}
__device__ __forceinline__ void kload2(bf16x8* kf, lds_cptr kp, int j) { kf[2 * j] = *(const LAS bf16x8*)(kp + j * 2048); kf[2 * j + 1] = *(const LAS bf16x8*)(kp + j * 2048 + 512); }
__device__ __forceinline__ s16x4 vtr(lds_cptr p) { return __builtin_bit_cast(s16x4, __builtin_amdgcn_ds_read_tr16_b64_v4i16((LAS v4i16_t*)p)); }
__device__ __forceinline__ float rowmax(const f32x16& p0, const f32x16& p1) {
    float a = max3f(p0[0], p0[1], p1[0]), b = max3f(p0[2], p0[3], p1[1]); a = max3f(a, p1[2], p1[3]);
#pragma unroll
    for (int r = 4; r < 16; r += 4) { a = max3f(a, p0[r], p0[r + 1]); b = max3f(b, p0[r + 2], p0[r + 3]); a = max3f(a, p1[r], p1[r + 1]); b = max3f(b, p1[r + 2], p1[r + 3]); }
    const float m = max2f(a, b);
    auto rr = __builtin_amdgcn_permlane32_swap(__float_as_uint(m), __float_as_uint(m), false, false);
    return max2f(__uint_as_float(rr[0]), __uint_as_float(rr[1]));
}
__device__ __forceinline__ void pv(f32x16* o, int vb, bf16x8 pa0, bf16x8 pa1, bf16x8 pa2, bf16x8 pa3) {
#pragma unroll
    for (int d0 = 0; d0 < 2; ++d0) { s16x4 lo[4], hi[4];
#pragma unroll
        for (int ks = 0; ks < 4; ++ks) {
            asm volatile("ds_read_b64_tr_b16 %0,%1 offset:%c2" : "=&v"(lo[ks]) : "v"(vb), "i"(d0 * 4096 + ks * 1024) : "memory");
            asm volatile("ds_read_b64_tr_b16 %0,%1 offset:%c2" : "=&v"(hi[ks]) : "v"(vb), "i"(d0 * 4096 + ks * 1024 + 512) : "memory"); }
        asm volatile("s_waitcnt lgkmcnt(0)" ::: "memory"); SBAR();
#define PK(k) (bf16x8){lo[k][0], lo[k][1], lo[k][2], lo[k][3], hi[k][0], hi[k][1], hi[k][2], hi[k][3]}
        o[d0] = __builtin_amdgcn_mfma_f32_32x32x16_bf16(pa0, PK(0), o[d0], 0, 0, 0);
        o[d0] = __builtin_amdgcn_mfma_f32_32x32x16_bf16(pa1, PK(1), o[d0], 0, 0, 0);
        o[d0] = __builtin_amdgcn_mfma_f32_32x32x16_bf16(pa2, PK(2), o[d0], 0, 0, 0);
        o[d0] = __builtin_amdgcn_mfma_f32_32x32x16_bf16(pa3, PK(3), o[d0], 0, 0, 0);
#undef PK
    }
}
template <int THRL> __device__ __forceinline__ void attn_unit(int b, int h, int qb, const bf16_t* Q, const bf16_t* __restrict__ K, const bf16_t* __restrict__ V, bf16_t* O, char* shm) {
    const int tid = opaque_tid(), lane = tid & 63, r32 = lane & 31, hi = lane >> 5; const int wid = __builtin_amdgcn_readfirstlane(tid >> 6);
    const long rowq = (long)b * SEQ + qb * QB + wid * QBLK;
    const bf16_t* Qw = Q + rowq * QP + h * 64;
    const bf16_t* Kh = K + (long)(b * 2 + (h >> 2)) * NKV * KP, *Vh = V + (long)(b * 2 + (h >> 2)) * NKV * KP;
    const unsigned lds0 = (unsigned)(uintptr_t)shm;
    float* wsf = (float*)(shm + LDS_WS) + wid * 64;
    const bf16_t* ksrc = Kh + (long)lane * KP + wid * 8;
    const bf16_t* vsrc = Vh + (long)(16 * (wid & 3) + (lane >> 2)) * KP + (wid >> 2) * 32 + (lane & 3) * 8;
    const unsigned kdst = lds0 + LDS_K + wid * 1024, vdst = lds0 + LDS_V + wid * 1024;
#define DMA_K(t, slot) glds16(ksrc + (long)(t) * KVBLK * KP, (unsigned)__builtin_amdgcn_readfirstlane(kdst + (slot)))
#define DMA_V(t, slot) glds16(vsrc + (long)(t) * KVBLK * KP, (unsigned)__builtin_amdgcn_readfirstlane(vdst + (slot)))
    const int vb0 = (int)(lds0 + LDS_V) + ((lane >> 4) & 1) * 32 + (lane & 3) * 8 + (4 * hi + ((lane & 15) >> 2)) * 64;
    const char* Kbase = shm + LDS_K; bf16x8 kf[8];
    const lds_cptr shm3 = (lds_cptr)shm; const lds_cptr kp0 = shm3 + LDS_K + hi * 1024 + r32 * 16; const lds_cptr vp0 = shm3 + LDS_V + ((lane >> 4) & 1) * 32 + (lane & 3) * 8 + (4 * hi + ((lane & 15) >> 2)) * 64;
    DMA_K(0, 0); DMA_V(0, 0); DMA_K(1, SLOTB);
    bf16x8 qr[4];
#pragma unroll
    for (int d0 = 0; d0 < 4; ++d0) qr[d0] = *reinterpret_cast<const bf16x8*>(&Qw[(long)r32 * QP + d0 * 16 + hi * 8]);
    float mhat = 0.f, l_reg = 0.f; f32x16 o[2]; o[0] = f32x16{}; o[1] = f32x16{}; f32x16 negm = f32x16{}; asm volatile("" : "+v"(negm));
    bool resc = false;
#define START(P0, P1) do { const float rm = rowmax(P0, P1); resc = false; \
    { const float dl = rm; mhat = fadd_s(mhat, dl); \
      _Pragma("unroll") for (int r = 0; r < 16; ++r) { P0[r] = fsub_s(P0[r], dl); P1[r] = fsub_s(P1[r], dl); } \
      _Pragma("unroll") for (int r = 0; r < 16; ++r) negm[r] = -mhat; asm volatile("" : "+v"(negm)); } \
    _Pragma("unroll") for (int r = 0; r < 16; ++r) P0[r] = __builtin_amdgcn_exp2f(P0[r]); } while (0)
#define RESC() do { if (resc) { asm volatile("s_waitcnt lgkmcnt(0)" ::: "memory"); \
      _Pragma("unroll") for (int d_ = 0; d_ < 2; ++d_) _Pragma("unroll") for (int r = 0; r < 16; ++r) o[d_][r] *= wsf[crow(r, hi)]; } } while (0)
    f32x16 pA0, pA1, pB0, pB1;
    int sl_prev = 0, sl_cur = 0, sl_next = SLOTB;
#define ROT() do { sl_prev = sl_cur; sl_cur = sl_next; sl_next = (sl_next == (NSLOT - 1) * SLOTB) ? 0 : sl_next + SLOTB; } while (0)
    DMA_K(2, 2 * SLOTB);
    WAIT_BAR(3);
    qkt(pA0, pA1, Kbase, qr, negm, r32, hi); asm volatile("s_nop 15\n\ts_nop 7" : "+v"(pA0), "+v"(pA1));
    START(pA0, pA1);
    _Pragma("unroll") for (int r = 0; r < 16; ++r) pA1[r] = __builtin_amdgcn_exp2f(pA1[r]);
    WAIT_BAR(0);
    DMA_K(3, 0); DMA_V(1, SLOTB);
    ROT();
    kload8(kf, kp0 + sl_cur);
    WAIT_BAR(2);
    s16x4 vlo[8], vhi[8]; u32x4 pw0, pw1, pw2, pw3;
#define PKW(P, B) cvtpk_s(P[B], P[B + 1])
#define PAF(k) __builtin_bit_cast(bf16x8, pw##k)
#define VFR(i) (bf16x8){vlo[i][0], vlo[i][1], vlo[i][2], vlo[i][3], vhi[i][0], vhi[i][1], vhi[i][2], vhi[i][3]}
#define PIN(x) asm volatile("" : "+v"(x))
#define MX3(a, b, c) __builtin_fmaxf(__builtin_fmaxf((a), (b)), (c))
#define GAPA(MF, A0, A1, A2, A3, W0, W1, PW) do { MF; sacc += A0; sacc += A1; sacc += A2; sacc += A3; PIN(sacc); W0; W1; PIN(PW); SBAR(); } while (0)
#define EX(v) __builtin_amdgcn_exp2f(v)
#define GAPB(MF, X, B) do { MF; X[B] = EX(X[B]); X[B + 1] = EX(X[B + 1]); X[B + 2] = EX(X[B + 2]); X[B + 3] = EX(X[B + 3]); PIN(X); SBAR(); } while (0)
#define VRD(i) do { vlo[i] = vtr(vp_ + (((i) >> 2) * 4096 + ((i) & 3) * 1024)); vhi[i] = vtr(vp_ + (((i) >> 2) * 4096 + ((i) & 3) * 1024 + 512)); } while (0)
#define KRD(G, j) do { if (G) { kload2(kf, kp0 + sl_next, j); SBAR(); } } while (0)
#define STEP(C0, C1, P0, P1, t, GK, GV, GL) do { SBAR(); \
    const lds_cptr vp_ = vp0 + sl_prev; \
    VRD(0); SBAR(); float sacc = (P0[0] + P0[1]); \
    GAPA(C0 = __builtin_amdgcn_mfma_f32_32x32x16_bf16(kf[0], qr[0], negm, 0, 0, 0), P0[2], P0[3], P0[4], P0[5],     pw0[0] = PKW(P0, 0), pw0[1] = PKW(P0, 2), pw0); \
    VRD(4); SBAR(); GAPA(C1 = __builtin_amdgcn_mfma_f32_32x32x16_bf16(kf[1], qr[0], negm, 0, 0, 0), P0[6], P0[7], P0[8], P0[9],     pw0[2] = PKW(P0, 4), pw0[3] = PKW(P0, 6), pw0); \
    VRD(1); SBAR(); GAPA(C0 = __builtin_amdgcn_mfma_f32_32x32x16_bf16(kf[2], qr[1], C0, 0, 0, 0),   P0[10], P0[11], P0[12], P0[13], pw1[0] = PKW(P0, 8), pw1[1] = PKW(P0, 10), pw1); \
    VRD(5); SBAR(); GAPA(C1 = __builtin_amdgcn_mfma_f32_32x32x16_bf16(kf[3], qr[1], C1, 0, 0, 0),   P0[14], P0[15], P1[0], P1[1],   pw1[2] = PKW(P0, 12), pw1[3] = PKW(P0, 14), pw1); \
    VRD(2); SBAR(); GAPA(C0 = __builtin_amdgcn_mfma_f32_32x32x16_bf16(kf[4], qr[2], C0, 0, 0, 0),   P1[2], P1[3], P1[4], P1[5],     pw2[0] = PKW(P1, 0), pw2[1] = PKW(P1, 2), pw2); \
    VRD(6); SBAR(); GAPA(C1 = __builtin_amdgcn_mfma_f32_32x32x16_bf16(kf[5], qr[2], C1, 0, 0, 0),   P1[6], P1[7], P1[8], P1[9],     pw2[2] = PKW(P1, 4), pw2[3] = PKW(P1, 6), pw2); \
    VRD(3); SBAR(); GAPA(C0 = __builtin_amdgcn_mfma_f32_32x32x16_bf16(kf[6], qr[3], C0, 0, 0, 0),   P1[10], P1[11], P1[12], P1[13], pw3[0] = PKW(P1, 8), pw3[1] = PKW(P1, 10), pw3); \
    VRD(7); SBAR(); GAPA(C1 = __builtin_amdgcn_mfma_f32_32x32x16_bf16(kf[7], qr[3], C1, 0, 0, 0),   P1[14], P1[15], 0.f, 0.f,       pw3[2] = PKW(P1, 12), pw3[3] = PKW(P1, 14), pw3); \
    l_reg += sacc; \
    if (GK) { DMA_K((t) + 3, sl_cur); } if (GV) { DMA_V((t) + 1, sl_next); } \
    { float a = MX3(C0[0], C0[1], C1[0]), b_ = MX3(C0[2], C0[3], C1[1]); a = MX3(a, C1[2], C1[3]); \
      _Pragma("unroll") for (int r = 4; r < 16; r += 4) { a = MX3(a, C0[r], C0[r + 1]); b_ = MX3(b_, C0[r + 2], C0[r + 3]); a = MX3(a, C1[r], C1[r + 1]); b_ = MX3(b_, C1[r + 2], C1[r + 3]); } \
      float rm = __builtin_fmaxf(a, b_); { auto rr = __builtin_amdgcn_permlane32_swap(__float_as_uint(rm), __float_as_uint(rm), false, false); rm = __builtin_fmaxf(__uint_as_float(rr[0]), __uint_as_float(rr[1])); } \
      resc = false; \
      if (__builtin_expect(__any(rm > (float)THRL), 0)) { const float dl = __builtin_fmaxf(rm, 0.f); mhat += dl; \
        _Pragma("unroll") for (int r = 0; r < 16; ++r) { C0[r] -= dl; C1[r] -= dl; } \
        _Pragma("unroll") for (int r = 0; r < 16; ++r) negm[r] = -mhat; asm volatile("" : "+v"(negm)); \
        const float f = __builtin_amdgcn_exp2f(-dl); l_reg *= f; if (hi == 0) wsf[r32] = f; resc = true; } } \
    SBAR(); \
    GAPB(o[0] = __builtin_amdgcn_mfma_f32_32x32x16_bf16(PAF(0), VFR(0), o[0], 0, 0, 0), C0, 0); \
    GAPB(o[1] = __builtin_amdgcn_mfma_f32_32x32x16_bf16(PAF(0), VFR(4), o[1], 0, 0, 0), C0, 4); \
    KRD(GL, 0); GAPB(o[0] = __builtin_amdgcn_mfma_f32_32x32x16_bf16(PAF(1), VFR(1), o[0], 0, 0, 0), C0, 8); \
    KRD(GL, 1); GAPB(o[1] = __builtin_amdgcn_mfma_f32_32x32x16_bf16(PAF(1), VFR(5), o[1], 0, 0, 0), C0, 12); \
    KRD(GL, 2); GAPB(o[0] = __builtin_amdgcn_mfma_f32_32x32x16_bf16(PAF(2), VFR(2), o[0], 0, 0, 0), C1, 0); \
    KRD(GL, 3); GAPB(o[1] = __builtin_amdgcn_mfma_f32_32x32x16_bf16(PAF(2), VFR(6), o[1], 0, 0, 0), C1, 4); \
    GAPB(o[0] = __builtin_amdgcn_mfma_f32_32x32x16_bf16(PAF(3), VFR(3), o[0], 0, 0, 0), C1, 8); \
    GAPB(o[1] = __builtin_amdgcn_mfma_f32_32x32x16_bf16(PAF(3), VFR(7), o[1], 0, 0, 0), C1, 12); \
    } while (0)
    int t = 1;
    for (; t + 5 < NT; t += 2) {
        STEP(pB0, pB1, pA0, pA1, t, true, true, true);     WAIT_BAR(2); RESC(); ROT();
        STEP(pA0, pA1, pB0, pB1, t + 1, true, true, true); WAIT_BAR(2); RESC(); ROT();
    }
#define ENDW(tt) do { if ((tt) + 3 < NT) { WAIT_BAR(2); } else if ((tt) + 2 < NT) { WAIT_BAR(1); } else { WAIT_BAR(0); } } while (0)
    for (; t + 1 < NT; t += 2) {
        STEP(pB0, pB1, pA0, pA1, t, (t + 3 < NT), (t + 1 < NT), (t + 1 < NT));         ENDW(t);     RESC(); ROT();
        STEP(pA0, pA1, pB0, pB1, t + 1, (t + 4 < NT), (t + 2 < NT), (t + 2 < NT));     ENDW(t + 1); RESC(); ROT();
    }
    STEP(pB0, pB1, pA0, pA1, NT - 1, false, false, false); RESC();
    { float sacc = pB0[0] + pB0[1]; _Pragma("unroll") for (int r = 2; r < 16; ++r) sacc += pB0[r]; _Pragma("unroll") for (int r = 0; r < 16; ++r) sacc += pB1[r]; l_reg += sacc;
      pw0 = (u32x4){PKW(pB0, 0), PKW(pB0, 2), PKW(pB0, 4), PKW(pB0, 6)}; pw1 = (u32x4){PKW(pB0, 8), PKW(pB0, 10), PKW(pB0, 12), PKW(pB0, 14)}; pw2 = (u32x4){PKW(pB1, 0), PKW(pB1, 2), PKW(pB1, 4), PKW(pB1, 6)}; pw3 = (u32x4){PKW(pB1, 8), PKW(pB1, 10), PKW(pB1, 12), PKW(pB1, 14)};
      SBAR(); pv(o, vb0 + sl_cur, PAF(0), PAF(1), PAF(2), PAF(3)); }
#undef PKW
#undef PAF
#undef VFR
#undef PIN
#undef MX3
#undef GAPA
#undef GAPB
#undef EX
#undef VRD
#undef KRD
#undef STEP
#undef ENDW
    { auto rr = __builtin_amdgcn_permlane32_swap(__float_as_uint(l_reg), __float_as_uint(l_reg), false, false); l_reg = __uint_as_float(rr[0]) + __uint_as_float(rr[1]); }
    if (hi == 0) wsf[32 + r32] = l_reg; asm volatile("s_waitcnt lgkmcnt(0)" ::: "memory");
    float rli[16];
#pragma unroll
    for (int r = 0; r < 16; ++r) rli[r] = __builtin_amdgcn_rcpf(wsf[32 + crow(r, hi)]);
    bf16_t* Ow = O + rowq * OP + h * 64;
    { bf16_t* stg = (bf16_t*)(shm + LDS_OST) + wid * 2048;
#pragma unroll
      for (int r = 0; r < 16; ++r) { const int orow = crow(r, hi);
#pragma unroll
        for (int d0 = 0; d0 < 2; ++d0) stg[orow * 64 + d0 * 32 + r32] = (bf16_t)(cvtpk_s(o[d0][r] * rli[r], 0.f) & 0xffffu); }
      asm volatile("s_waitcnt lgkmcnt(0)" ::: "memory");
#pragma unroll
      for (int i = 0; i < 4; ++i) { const int row = i * 8 + (lane >> 3), ch = lane & 7; const u32x4 v = *(const u32x4*)(stg + row * 64 + ch * 8); *(u32x4*)(Ow + (long)row * OP + ch * 8) = v; } }
    asm volatile("s_waitcnt lgkmcnt(0)\n\ts_barrier" ::: "memory");
#undef DMA_K
#undef DMA_V
#undef START
#undef RESC
#undef ROT
}
#undef SBAR
#undef WAIT_BAR
}

#define LDS_WAIT() asm volatile("s_waitcnt lgkmcnt(0)" ::: "memory")
constexpr int TP_OFF = LDSCTL_OFF + 512;
struct Args { const float* in[27]; float* out; unsigned char* ws; };
enum { I_X = 0, I_C, I_CTX, I_CCTX, I_MODW, I_MODB, I_N1G, I_N2G, I_EWIN, I_QG, I_KG, I_POOLW, I_POOLS, I_EWOUT, I_OWIN, I_SGG, I_SGW, I_SGB, I_CONVW, I_OWOUT,
       I_RGW, I_RGB, I_REW, I_REB, I_WG, I_WU, I_WD };

__device__ __forceinline__ int map_in0(int n) {
    if (n < 640) { const int hd = n >> 6, e = n & 63; const int s = e >> 5, r = e & 31, bj = r >> 4, i = r & 15, j = 16 * s + i;
        const int pn = (hd < 8) ? (hd >> 2) : 2, wc = (hd < 8) ? (hd & 3) : (hd - 8); return 256 * pn + 128 * bj + 32 * wc + j; }
    if (n < 768) { const int vh = (n - 640) >> 6, e = n & 63, bj = e >> 5, j = e & 31; return 512 + 128 * bj + 32 * (2 + vh) + j; }
    return n;
}
struct TrItem { const float* W; int K, N; bf16_t* WT; int kind, off, item; };
__device__ __forceinline__ void tr_load(const TrItem& t, int lane, float (&tv)[32]) {
    const int nblk = t.N / 32, kb = t.item / nblk, nb = t.item % nblk, k0 = 64 * kb, n0 = 32 * nb;
#pragma unroll
    for (int i = 0; i < 32; ++i) tv[i] = t.W[(size_t)(k0 + 2 * i + (lane >> 5)) * t.N + n0 + (lane & 31)];
}
__device__ __forceinline__ void tr_store(const TrItem& t, int lane, const float (&tv)[32], LAS float* scr) {
    const int nblk = t.N / 32, kb = t.item / nblk, nb = t.item % nblk, k0 = 64 * kb, n0 = 32 * nb;
#pragma unroll
    for (int i = 0; i < 32; ++i) scr[(2 * i + (lane >> 5)) * 33 + (lane & 31)] = tv[i];
    LDS_WAIT(); asm volatile("" ::: "memory");
    const int c = lane & 7;
#pragma unroll
    for (int j = 0; j < 4; ++j) { const int n = (lane >> 3) + 8 * j; const LAS float* s = scr + (8 * c) * 33 + n; const int ng = n0 + n;
        const int dst = (t.kind == 1) ? map_in0(ng) : (t.kind == 2) ? t.off + 256 * (ng >> 7) + (ng & 127) : t.off + ng;
        u32x4 o; o.x = cvt_pk_bf16(s[0 * 33], s[1 * 33]); o.y = cvt_pk_bf16(s[2 * 33], s[3 * 33]); o.z = cvt_pk_bf16(s[4 * 33], s[5 * 33]); o.w = cvt_pk_bf16(s[6 * 33], s[7 * 33]);
        *(u32x4*)(t.WT + (size_t)dst * t.K + k0 + 8 * c) = o; }
    LDS_WAIT(); asm volatile("" ::: "memory");
}
__device__ __forceinline__ void p0_prologue(const Args& a, LAS unsigned char* lds, int tid, int lane, int wave, int vcu, int G) {
    unsigned char* ws = a.ws;
    {
        LAS float* sc = (LAS float*)lds;
        LAS float* red = (LAS float*)(lds + 36864);
        for (int idx = tid; idx < 9 * 1024; idx += 512) { const int r = idx >> 10, k = idx & 1023; const float v = (r < 8) ? a.in[I_C][r * 1024 + k] : a.in[I_CCTX][k]; sc[idx] = silu_f(v); }
        __syncthreads();
        float* MOD = (float*)(ws + WS_MOD);
        for (int unit = blockIdx.x; unit < 256; unit += G) {
            const int l = unit >> 7, n0 = (unit & 127) * 48;
            const int ks = lane / 12, c4 = lane % 12; const bool act = lane < 60;
            const float* Wm = a.in[I_MODW] + (size_t)l * 1024 * 6144 + n0 + 4 * c4;
            f32x4 acc4[9];
#pragma unroll
            for (int r = 0; r < 9; ++r) acc4[r] = (f32x4){0.f, 0.f, 0.f, 0.f};
#pragma unroll 1
            for (int it0 = 0; it0 < 26; it0 += 13) {
                f32x4 wv[13];
#pragma unroll
                for (int i = 0; i < 13; ++i) { const int kr = 5 * (it0 + i) + ks; const bool ok = act && kr < 128;
                    wv[i] = ok ? *(const f32x4*)(Wm + (size_t)(wave * 128 + kr) * 6144) : (f32x4){0.f, 0.f, 0.f, 0.f}; }
#pragma unroll
                for (int i = 0; i < 13; ++i) { const int kr = 5 * (it0 + i) + ks; const int kk = wave * 128 + (kr < 128 ? kr : 127);
#pragma unroll
                    for (int r = 0; r < 9; ++r) acc4[r] += sc[r * 1024 + kk] * wv[i]; }
            }
            if (act) {
#pragma unroll
                for (int r = 0; r < 9; ++r) *(LAS f32x4*)(red + ((wave * 5 + ks) * 9 + r) * 48 + 4 * c4) = acc4[r]; }
            __syncthreads();
            for (int idx = tid; idx < 9 * 48; idx += 512) { const int r = idx / 48, cl = idx % 48; float sum = a.in[I_MODB][l * 6144 + n0 + cl];
#pragma unroll 8
                for (int w = 0; w < 40; ++w) sum += red[(w * 9 + r) * 48 + cl];
                MOD[(size_t)(l * 9 + r) * 6144 + n0 + cl] = sum; }
            __syncthreads();
        }
    }
}
__device__ __forceinline__ void convert_weights(const Args& a, LAS unsigned char* lds, int set, int lane, int wave, int worker, int nworkers) {
    unsigned char* ws = a.ws;
    LAS float* scr = (LAS float*)(lds + wave * 16384);
    constexpr int I0 = 16 * 40, I1 = 16 * 32, I2 = 16 * 80, I3 = 16 * 32, IGU = 128, IDN = 128, IPL = 8, HL = 16 * 128;
    constexpr int E0 = I0, E1 = E0 + I1, E2 = E1 + I2, E3 = E2 + I3, E4 = E3 + 32 * IGU, E5 = E4 + 32 * IGU, E6 = E5 + 32 * IDN, E7 = E6 + 4 * IPL;
    constexpr int N1A = E3 - E0, N1 = N1A + 3 * HL + 4 * IPL, N2 = 3 * HL;
    const int nitems = (set == 0) ? E0 : (set == 1) ? N1 : N2;
    auto remap = [&](int v) -> int {
        if (set == 0) return v;
        if (set == 1) { if (v < N1A) return E0 + v; v -= N1A; if (v < HL) return E3 + v; v -= HL; if (v < HL) return E4 + v; v -= HL; if (v < HL) return E5 + v; v -= HL; return E6 + v; }
        if (v < HL) return E3 + HL + v; v -= HL; if (v < HL) return E4 + HL + v; v -= HL; return E5 + HL + v; };
    auto mk = [&](int v) -> TrItem { const int it = remap(v); TrItem t;
        if (it < E0) t = TrItem{a.in[I_EWIN], 1024, 1280, (bf16_t*)(ws + WS_WIN0), 1, 0, it};
        else if (it < E1) t = TrItem{a.in[I_EWOUT], 1024, 1024, (bf16_t*)(ws + WS_WOUT0), 0, 0, it - E0};
        else if (it < E2) t = TrItem{a.in[I_OWIN], 1024, 2560, (bf16_t*)(ws + WS_WIN1), 0, 0, it - E1};
        else if (it < E3) t = TrItem{a.in[I_OWOUT], 1024, 1024, (bf16_t*)(ws + WS_WOUT1), 0, 0, it - E2};
        else if (it < E4) { const int r = it - E3, le = r / IGU;
            t = TrItem{a.in[I_WG] + (size_t)le * 1024 * 256, 1024, 256, (bf16_t*)(ws + WS_WGU) + (size_t)(le >> 4) * 8192 * 1024, 2, (le & 15) * 512, r % IGU}; }
        else if (it < E5) { const int r = it - E4, le = r / IGU;
            t = TrItem{a.in[I_WU] + (size_t)le * 1024 * 256, 1024, 256, (bf16_t*)(ws + WS_WGU) + (size_t)(le >> 4) * 8192 * 1024, 2, (le & 15) * 512 + 128, r % IGU}; }
        else if (it < E6) { const int r = it - E5, le = r / IDN;
            t = TrItem{a.in[I_WD] + (size_t)le * 256 * 1024, 256, 1024, (bf16_t*)(ws + WS_WDN) + (size_t)(le >> 4) * 16384 * 256, 0, (le & 15) * 1024, r % IDN}; }
        else { const int r = it - E6, g = r / IPL;
            t = TrItem{a.in[I_POOLW] + (size_t)g * 128 * 128, 128, 128, (bf16_t*)(ws + WS_WPOOL), 0, g * 128, r % IPL}; }
        return t; };
    {   float tvA[32], tvB[32];
        int it = worker; TrItem cur{}; if (it < nitems) { cur = mk(it); tr_load(cur, lane, tvA); }
        for (; it < nitems; it += 2 * nworkers) {
            const int itB = it + nworkers, itC = it + 2 * nworkers; TrItem tb{}, tc{};
            if (itB < nitems) { tb = mk(itB); tr_load(tb, lane, tvB); }
            tr_store(cur, lane, tvA, scr);
            if (itC < nitems) { tc = mk(itC); tr_load(tc, lane, tvA); }
            if (itB < nitems) tr_store(tb, lane, tvB, scr);
            cur = tc;
        }
    }
    if (set == 1) {
        for (int idx = worker * 64 + lane; idx < 4 * 128 * 128; idx += nworkers * 64) { const int x = idx & 15; const int q = (x & 3) + 8 * ((x >> 2) & 1) + 4 * (x >> 3);
            const float v = a.in[I_SGW][(idx & ~15) + q]; ((bf16_t*)(ws + WS_WSG))[idx] = (bf16_t)(cvt_pk_bf16(v, 0.f) & 0xffffu); } }
}

__device__ __forceinline__ void load_vec16(const float* p, int lane, f32x4 (&v)[4]) {
#pragma unroll
    for (int j = 0; j < 2; ++j)
#pragma unroll
        for (int q = 0; q < 2; ++q) v[2 * j + q] = *(const f32x4*)(p + 8 * lane + 512 * j + 4 * q);
}
__device__ __forceinline__ void load_vec16_nt(const float* p, int lane, f32x4 (&v)[4]) {
#pragma unroll
    for (int j = 0; j < 2; ++j)
#pragma unroll
        for (int q = 0; q < 2; ++q) v[2 * j + q] = __builtin_nontemporal_load((const f32x4*)(p + 8 * lane + 512 * j + 4 * q));
}
__device__ __forceinline__ void load_row_bf16(const bf16_t* p, int lane, f32x4 (&v)[4]) {
#pragma unroll
    for (int j = 0; j < 2; ++j) { const u32x4 w = *(const u32x4*)(p + 8 * lane + 512 * j);
        v[2 * j] = (f32x4){bf_lo(w.x), bf_hi(w.x), bf_lo(w.y), bf_hi(w.y)}; v[2 * j + 1] = (f32x4){bf_lo(w.z), bf_hi(w.z), bf_lo(w.w), bf_hi(w.w)}; }
}
__device__ __forceinline__ void store_row_bf16(bf16_t* p, int lane, const f32x4 (&v)[4]) {
#pragma unroll
    for (int j = 0; j < 2; ++j) { u32x4 w; w.x = cvt_pk_bf16(v[2 * j][0], v[2 * j][1]); w.y = cvt_pk_bf16(v[2 * j][2], v[2 * j][3]); w.z = cvt_pk_bf16(v[2 * j + 1][0], v[2 * j + 1][1]); w.w = cvt_pk_bf16(v[2 * j + 1][2], v[2 * j + 1][3]);
        *(u32x4*)(p + 8 * lane + 512 * j) = w; }
}
__device__ __forceinline__ float sumsq16(const f32x4 (&v)[4]) { float s = 0.f;
#pragma unroll
    for (int i = 0; i < 4; ++i) s += (v[i][0] * v[i][0] + v[i][1] * v[i][1]) + (v[i][2] * v[i][2] + v[i][3] * v[i][3]);
    return s; }
__device__ __forceinline__ void load_mod(const float* mod, const float* gain, int l, int r, int cs, int lane, f32x4 (&gm)[4], f32x4 (&sh)[4]) {
    const float* mr = mod + (size_t)(l * 9 + r) * 6144 + cs * 1024; f32x4 g[4], s[4];
    load_vec16(gain + l * 1024, lane, g); load_vec16(mr + 1024, lane, s); load_vec16(mr, lane, sh);
#pragma unroll
    for (int i = 0; i < 4; ++i) gm[i] = g[i] * (1.0f + s[i]);
}
__device__ __forceinline__ void p1_ln_rows(const Args& a, int lane, int gw, int NGW) {
    const float* mod = (const float*)(a.ws + WS_MOD); bf16_t* AB = (bf16_t*)(a.ws + WS_ABUF);
    const int rpw = (MA + NGW - 1) / NGW, m0 = gw * rpw, m1 = (m0 + rpw < MA) ? m0 + rpw : MA;
    int curb = -1; f32x4 gm[4], sh[4];
    for (int mm = m0; mm < m1; mm += 4) {
        f32x4 vv[4][4]; int mr[4];
#pragma unroll
        for (int r = 0; r < 4; ++r) { mr[r] = (mm + r < m1) ? mm + r : mm;
            load_vec16_nt((mr[r] < MT) ? a.in[I_X] + (size_t)mr[r] * 1024 : a.in[I_CTX] + (size_t)(mr[r] - MT) * 1024, lane, vv[r]); }
#pragma unroll
        for (int r = 0; r < 4; ++r) { const int m = mr[r]; if (r && m == mm) break;
            const int b = (m < MT) ? (m >> 12) : 8;
            if (b != curb) { load_mod(mod, a.in[I_N1G], 0, b, 0, lane, gm, sh); curb = b; }
            const float rstd = __builtin_amdgcn_rsqf(wave_sum(sumsq16(vv[r])) * (1.0f / 1024.0f) + EPS);
#pragma unroll
            for (int i = 0; i < 4; ++i) vv[r][i] = vv[r][i] * rstd * gm[i] + sh[i];
            store_row_bf16(AB + (size_t)m * 1024, lane, vv[r]); }
    }
}
template <class T> __device__ __forceinline__ void copy_rows(const T* src, float* dst, int lane, int gw, int NGW) {
    for (int m = gw; m < MT; m += NGW) { f32x4 v[4]; if constexpr (sizeof(T) == 4) load_vec16((const float*)src + (size_t)m * 1024, lane, v); else load_row_bf16((const bf16_t*)src + (size_t)m * 1024, lane, v);
#pragma unroll
        for (int j = 0; j < 2; ++j)
#pragma unroll
            for (int q = 0; q < 2; ++q) *(f32x4*)(dst + (size_t)m * 1024 + 8 * lane + 512 * j + 4 * q) = v[2 * j + q]; }
}

__device__ __forceinline__ void pool_task(int rb, int g, const bf16_t* P, const bf16_t* Wp, const float* pscale, bf16_t* A2, int lane) {
    const int r = lane & 31, hh = lane >> 5;
    const int m0 = rb * 32, b = m0 >> 12, t = (m0 & 4095) + r;
    const int half = 1 << g;
    const int lo = (t - half > 0) ? t - half : 0, hi = (t + half < SEQ) ? t + half : SEQ;
    const float invc = 1.0f / (float)(hi - lo);
    const bf16_t* Pb = P + (size_t)b * SEQ * 512 + g * 128 + 8 * hh;
    float sum[8][8];
#pragma unroll
    for (int s = 0; s < 8; ++s)
#pragma unroll
        for (int j = 0; j < 8; ++j) sum[s][j] = 0.f;
#pragma unroll 2
    for (int d2 = -half; d2 < half; d2 += 2)
#pragma unroll
    for (int dd = 0; dd < 2; ++dd) { const int d = d2 + dd;
        const int tt = t + d; const bool ok = (tt >= 0) && (tt < SEQ); const int tc = ok ? tt : t;
        const float msk = ok ? 1.0f : 0.0f;
#pragma unroll
        for (int s = 0; s < 8; ++s) { const u32x4 w = *(const u32x4*)(Pb + (size_t)tc * 512 + 16 * s);
            sum[s][0] += msk * bf_lo(w.x); sum[s][1] += msk * bf_hi(w.x); sum[s][2] += msk * bf_lo(w.y); sum[s][3] += msk * bf_hi(w.y);
            sum[s][4] += msk * bf_lo(w.z); sum[s][5] += msk * bf_hi(w.z); sum[s][6] += msk * bf_lo(w.w); sum[s][7] += msk * bf_hi(w.w); }
    }
    bf16x8 afrag[8];
#pragma unroll
    for (int s = 0; s < 8; ++s) { const u32x4 w = *(const u32x4*)(Pb + (size_t)t * 512 + 16 * s);
        u32x4 o; o.x = cvt_pk_bf16(sum[s][0] * invc - bf_lo(w.x), sum[s][1] * invc - bf_hi(w.x)); o.y = cvt_pk_bf16(sum[s][2] * invc - bf_lo(w.y), sum[s][3] * invc - bf_hi(w.y));
        o.z = cvt_pk_bf16(sum[s][4] * invc - bf_lo(w.z), sum[s][5] * invc - bf_hi(w.z)); o.w = cvt_pk_bf16(sum[s][6] * invc - bf_lo(w.w), sum[s][7] * invc - bf_hi(w.w));
        afrag[s] = __builtin_bit_cast(bf16x8, o); }
    bf16_t* orow = A2 + (size_t)(m0 + r) * 1024 + 512 + g * 128;
#pragma unroll
    for (int nb = 0; nb < 4; ++nb) {
        f32x16 acc = f32x16{};
#pragma unroll
        for (int s = 0; s < 8; ++s) { const bf16x8 bfr = *(const bf16x8*)(Wp + (size_t)(g * 128 + 32 * nb + r) * 128 + 16 * s + 8 * hh);
            acc = __builtin_amdgcn_mfma_f32_32x32x16_bf16(bfr, afrag[s], acc, 0, 0, 0); }
#pragma unroll
        for (int rg = 0; rg < 4; ++rg) { const int n = 32 * nb + 8 * rg + 4 * hh; const f32x4 ps = *(const f32x4*)(pscale + g * 128 + n);
            u32x2 w; w.x = cvt_pk_bf16(acc[4 * rg] * ps[0], acc[4 * rg + 1] * ps[1]); w.y = cvt_pk_bf16(acc[4 * rg + 2] * ps[2], acc[4 * rg + 3] * ps[3]);
            *(u32x2*)(orow + n) = w; }
    }
}

template <int N, int SZ> __device__ __forceinline__ void halve(float (&v)[SZ], int mask, bool upper) {
#pragma unroll
    for (int i = 0; i < N / 2; ++i) { const float send = upper ? v[i] : v[i + N / 2]; const float keep = upper ? v[i + N / 2] : v[i]; v[i] = keep + __shfl_xor(send, mask); }
}
__device__ __forceinline__ void reduce16(float (&v)[16], int lane, float (&out)[16]) {
    halve<16, 16>(v, 32, (lane & 32) != 0); halve<8, 16>(v, 16, (lane & 16) != 0); halve<4, 16>(v, 8, (lane & 8) != 0); halve<2, 16>(v, 4, (lane & 4) != 0);
    float x = v[0]; x += __shfl_xor(x, 2); x += __shfl_xor(x, 1);
#pragma unroll
    for (int i = 0; i < 16; ++i) out[i] = __builtin_bit_cast(float, __builtin_amdgcn_readlane(__builtin_bit_cast(int, x), 4 * i));
}
__device__ __forceinline__ void router_phase(const Args& a, int l, LAS unsigned char* lds, int tid, int lane_unused, int wave, int G) {
    unsigned char* ws = a.ws;
    const bf16_t* H = (const bf16_t*)(ws + WS_H); bf16_t* T = (bf16_t*)(ws + WS_ABUF); const float* mod = (const float*)(ws + WS_MOD);
    LAS float* WG1 = (LAS float*)lds;
    LAS float* WE = (LAS float*)(lds + 16384);
    LAS int* REC_E = (LAS int*)(lds + 92160); LAS int* REC_P = REC_E + 256; LAS float* REC_W = (LAS float*)(REC_P + 256);
    LAS int* CNT = (LAS int*)(lds + 95232); LAS int* GBASE = CNT + 32;
    const float* rgw = a.in[I_RGW] + (size_t)l * 1024 * 4; const float* rew = a.in[I_REW] + (size_t)l * 1024 * 16;
    {   f32x4 wg[2], we[2][4];
#pragma unroll
        for (int i = 0; i < 2; ++i) { const int col = tid + 512 * i; wg[i] = *(const f32x4*)(rgw + col * 4);
#pragma unroll
            for (int g = 0; g < 4; ++g) we[i][g] = *(const f32x4*)(rew + col * 16 + 4 * g); }
#pragma unroll
        for (int i = 0; i < 2; ++i) { const int col = tid + 512 * i, jp = col >> 9, ln = (col & 511) >> 3, cc = col & 7; const int pos = ((jp * 8 + cc) * 64 + ln) * 4;
            *(LAS f32x4*)(WG1 + pos) = wg[i];
#pragma unroll
            for (int g = 0; g < 4; ++g) *(LAS f32x4*)(WE + g * 4096 + pos) = we[i][g]; } }
    if (tid < NCLS) CNT[tid] = 0;
    __syncthreads();
    unsigned* counts = (unsigned*)(ws + WS_CTL) + CW_CNT + 64 * l;
    int* list = (int*)(ws + RT_LIST); f32x2* wsl = (f32x2*)(ws + RT_WSLOT);
    const float* rgb = a.in[I_RGB] + l * 4; const float* reb = a.in[I_REB] + l * 16;
    for (int blk = blockIdx.x; blk < MT / 128; blk += G) {
        const int tok0 = blk * 128 + wave * 16, b = (blk * 128) >> 12;
        f32x4 gm[4], sh[4]; load_mod(mod, a.in[I_N2G], l, b, 3, opaque_tid() & 63, gm, sh);
        u32x4 nx[4][2];
        { const int lane = opaque_tid() & 63;
#pragma unroll
          for (int tk = 0; tk < 4; ++tk)
#pragma unroll
            for (int j = 0; j < 2; ++j) nx[tk][j] = *(const u32x4*)(H + (size_t)(tok0 + tk) * 1024 + 8 * lane + 512 * j); }
#pragma unroll 1
        for (int grp = 0; grp < 4; ++grp) {
            const int lane = opaque_tid() & 63;
            f32x4 hv[4][4];
#pragma unroll
            for (int tk = 0; tk < 4; ++tk)
#pragma unroll
                for (int j = 0; j < 2; ++j) { const u32x4 w = nx[tk][j]; hv[tk][2 * j] = (f32x4){bf_lo(w.x), bf_hi(w.x), bf_lo(w.y), bf_hi(w.y)}; hv[tk][2 * j + 1] = (f32x4){bf_lo(w.z), bf_hi(w.z), bf_lo(w.w), bf_hi(w.w)}; }
            if (grp < 3) {
#pragma unroll
                for (int tk = 0; tk < 4; ++tk)
#pragma unroll
                    for (int j = 0; j < 2; ++j) nx[tk][j] = *(const u32x4*)(H + (size_t)(tok0 + (grp + 1) * 4 + tk) * 1024 + 8 * lane + 512 * j); }
            {
#pragma unroll
                for (int tk = 0; tk < 4; ++tk) { const float rstd = __builtin_amdgcn_rsqf(wave_sum(sumsq16(hv[tk])) * (1.0f / 1024.0f) + EPS);
#pragma unroll
                    for (int i = 0; i < 4; ++i) hv[tk][i] = hv[tk][i] * rstd * gm[i] + sh[i];
                    store_row_bf16(T + (size_t)(tok0 + grp * 4 + tk) * 1024, lane, hv[tk]); } }
            float acc[16], tot[16];
#pragma unroll
            for (int i = 0; i < 16; ++i) acc[i] = 0.f;
#pragma unroll
            for (int jp = 0; jp < 2; ++jp)
#pragma unroll
                for (int cc = 0; cc < 8; ++cc) { const f32x4 w4 = *(const LAS f32x4*)(WG1 + ((jp * 8 + cc) * 64 + lane) * 4);
#pragma unroll
                    for (int tk = 0; tk < 4; ++tk) { const float tv = hv[tk][2 * jp + (cc >> 2)][cc & 3];
#pragma unroll
                        for (int q = 0; q < 4; ++q) acc[tk * 4 + q] += tv * w4[q]; } }
            reduce16(acc, lane, tot);
            int gi[4]; float gp[4];
#pragma unroll
            for (int tk = 0; tk < 4; ++tk) { float gl[4];
#pragma unroll
                for (int q = 0; q < 4; ++q) gl[q] = tot[tk * 4 + q] + rgb[q];
                int g = 0; float gmx = gl[0];
#pragma unroll
                for (int q = 1; q < 4; ++q) if (gl[q] > gmx) { gmx = gl[q]; g = q; }
                float gs = 0.f;
#pragma unroll
                for (int q = 0; q < 4; ++q) gs += __expf(gl[q] - gmx);
                gi[tk] = __builtin_amdgcn_readfirstlane(g); gp[tk] = 1.0f / gs; }
#pragma unroll
            for (int i = 0; i < 16; ++i) acc[i] = 0.f;
#pragma unroll
            for (int tk = 0; tk < 4; ++tk) { const LAS float* we = WE + gi[tk] * 4096 + lane * 4;
#pragma unroll
                for (int jp = 0; jp < 2; ++jp)
#pragma unroll
                    for (int cc = 0; cc < 8; ++cc) { const f32x4 w4 = *(const LAS f32x4*)(we + (jp * 8 + cc) * 256); const float tv = hv[tk][2 * jp + (cc >> 2)][cc & 3];
#pragma unroll
                        for (int q = 0; q < 4; ++q) acc[tk * 4 + q] += tv * w4[q]; } }
            reduce16(acc, lane, tot);
            if (lane == 0) {
#pragma unroll
                for (int tk = 0; tk < 4; ++tk) { float el[4];
#pragma unroll
                    for (int q = 0; q < 4; ++q) el[q] = tot[tk * 4 + q] + reb[gi[tk] * 4 + q];
                    int i1 = 0; float m1 = el[0];
#pragma unroll
                    for (int q = 1; q < 4; ++q) if (el[q] > m1) { m1 = el[q]; i1 = q; }
                    int i2 = -1; float m2 = -3.0e38f;
#pragma unroll
                    for (int q = 0; q < 4; ++q) if (q != i1 && el[q] > m2) { m2 = el[q]; i2 = q; }
                    const float ex = __expf(m2 - m1), den = 1.0f / (1.0f + ex);
                    const float w1 = gp[tk] * den, w2 = gp[tk] * ex * den;
                    const int lo = (i1 < i2) ? i1 : i2, hi = (i1 < i2) ? i2 : i1; const int cls = gi[tk] * 6 + ((lo == 0) ? 0 : (lo == 1) ? 3 : 5) + (hi - lo - 1);
                    const int tl = wave * 16 + grp * 4 + tk;
                    REC_E[tl] = cls; REC_W[tl * 2] = (i1 < i2) ? w1 : w2; REC_W[tl * 2 + 1] = (i1 < i2) ? w2 : w1;
                    REC_P[tl] = __hip_atomic_fetch_add(CNT + cls, 1, __ATOMIC_RELAXED, __HIP_MEMORY_SCOPE_WORKGROUP); } }
        }
        const int tid = opaque_tid();
        __syncthreads();
        if (tid < NCLS) { GBASE[tid] = (int)__hip_atomic_fetch_add(counts + tid, (unsigned)CNT[tid], __ATOMIC_RELAXED, __HIP_MEMORY_SCOPE_AGENT); }
        __syncthreads();
        if (tid < 128) { const int cls = REC_E[tid], pos = GBASE[cls] + REC_P[tid]; const int token = blk * 128 + tid;
            list[cls * LISTCAP + pos] = token; wsl[(size_t)cls * LISTCAP + pos] = (f32x2){REC_W[tid * 2], REC_W[tid * 2 + 1]}; }
        if (tid < NCLS) CNT[tid] = 0;
        __syncthreads();
    }
}
__device__ __forceinline__ void build_tp(const Args& a, int l, LAS unsigned char* lds, int tid) {
    volatile LAS int* tp = (volatile LAS int*)(lds + TP_OFF);
    if (tid == 0) { const unsigned* counts = (const unsigned*)(a.ws + WS_CTL) + CW_CNT + 64 * l; int acc = 0;
        for (int e = 0; e < NCLS; ++e) { const int c = (int)__hip_atomic_load(counts + e, __ATOMIC_RELAXED, __HIP_MEMORY_SCOPE_AGENT); tp[e] = acc; tp[NCLS + 1 + e] = c; acc += (c + 255) >> 8; }
        tp[NCLS] = acc; }
    __syncthreads();
}
__device__ __forceinline__ void ln1_phase(const Args& a, int lane, int gw, int NGW) {
    unsigned char* ws = a.ws; const float* mod = (const float*)(ws + WS_MOD); const bf16_t* H = (const bf16_t*)(ws + WS_H); bf16_t* AB = (bf16_t*)(ws + WS_ABUF);
    const int rpw = (((MT + NGW - 1) / NGW) + 1) & ~1, m0 = gw * rpw, m1 = (m0 + rpw < MT) ? m0 + rpw : MT;
    int curb = -1; f32x4 gm[4], sh[4];
    for (int m = m0; m < m1; m += 2) {
        f32x4 hv[2][4];
#pragma unroll
        for (int r = 0; r < 2; ++r) load_row_bf16(H + (size_t)(m + r) * 1024, lane, hv[r]);
        const int b = m >> 12;
        if (b != curb) { load_mod(mod, a.in[I_N1G], 1, b, 0, lane, gm, sh); curb = b; }
#pragma unroll
        for (int r = 0; r < 2; ++r) { const float rstd = __builtin_amdgcn_rsqf(wave_sum(sumsq16(hv[r])) * (1.0f / 1024.0f) + EPS);
#pragma unroll
            for (int i = 0; i < 4; ++i) hv[r][i] = hv[r][i] * rstd * gm[i] + sh[i];
            store_row_bf16(AB + (size_t)(m + r) * 1024, lane, hv[r]); }
    }
}
__device__ __forceinline__ void sgconv_phase(const Args& a, LAS unsigned char* lds, int tid_unused, int lane_unused, int wave, int G) {
    unsigned char* ws = a.ws; const bf16_t* UV = (const bf16_t*)(ws + WS_RGN); bf16_t* MIX = (bf16_t*)(ws + WS_ABUF); const bf16_t* WSG = (const bf16_t*)(ws + WS_WSG);
    for (int blk = blockIdx.x; blk < MT / 128; blk += G) {
        const int tok0 = blk * 128;
        {
            const int lane = opaque_tid() & 63;
            const int g = wave >> 1, ch = lane & 15; float gn[8];
            u32x4 wv[16];
#pragma unroll
            for (int it = 0; it < 16; ++it) wv[it] = *(const u32x4*)(UV + (size_t)(tok0 + 64 * (wave & 1) + 4 * it + (lane >> 4)) * 2560 + 512 + g * 128 + 8 * ch);
#pragma unroll
            for (int j = 0; j < 8; ++j) gn[j] = a.in[I_SGG][g * 128 + 8 * ch + j];
#pragma unroll
            for (int it = 0; it < 16; ++it) { const int q = 64 * (wave & 1) + 4 * it + (lane >> 4); const u32x4 w = wv[it];
                float v[8] = {bf_lo(w.x), bf_hi(w.x), bf_lo(w.y), bf_hi(w.y), bf_lo(w.z), bf_hi(w.z), bf_lo(w.w), bf_hi(w.w)};
                float ss = 0.f;
#pragma unroll
                for (int j = 0; j < 8; ++j) ss += v[j] * v[j];
                ss += __shfl_xor(ss, 1); ss += __shfl_xor(ss, 2); ss += __shfl_xor(ss, 4); ss += __shfl_xor(ss, 8);
                const float rstd = __builtin_amdgcn_rsqf(ss * (1.0f / 128.0f) + EPS);
                u32x4 o; o.x = cvt_pk_bf16(v[0] * rstd * gn[0], v[1] * rstd * gn[1]); o.y = cvt_pk_bf16(v[2] * rstd * gn[2], v[3] * rstd * gn[3]);
                o.z = cvt_pk_bf16(v[4] * rstd * gn[4], v[5] * rstd * gn[5]); o.w = cvt_pk_bf16(v[6] * rstd * gn[6], v[7] * rstd * gn[7]);
                *(LAS u32x4*)(lds + g * 32768 + (ch >> 2) * 8192 + q * 64 + (ch & 3) * 16) = o; }
        }
        {
            const int lane = opaque_tid() & 63;
            float cw[3][8];
#pragma unroll
            for (int k = 0; k < 3; ++k)
#pragma unroll
                for (int j = 0; j < 8; ++j) cw[k][j] = a.in[I_CONVW][k * 512 + 8 * lane + j];
#pragma unroll 1
            for (int hf = 0; hf < 4; ++hf) { const int t0 = tok0 + wave * 16 + hf * 4;
                u32x4 hx[6], cg[6], bg[4];
#pragma unroll
                for (int i = 0; i < 6; ++i) { const bool ok = !((i == 0 && ((t0 & 4095) == 0)) || (i == 5 && (((t0 + 3) & 4095) == 4095))); const int tok = ok ? t0 - 1 + i : t0;
                    hx[i] = *(const u32x4*)(UV + (size_t)tok * 2560 + 1024 + 8 * lane); cg[i] = *(const u32x4*)(UV + (size_t)tok * 2560 + 2048 + 8 * lane);
                    if (!ok) hx[i] = (u32x4){0u, 0u, 0u, 0u}; }
#pragma unroll
                for (int i = 0; i < 4; ++i) bg[i] = *(const u32x4*)(UV + (size_t)(t0 + i) * 2560 + 1536 + 8 * lane);
                float z[6][8];
#pragma unroll
                for (int i = 0; i < 6; ++i) { z[i][0] = bf_lo(hx[i].x) * bf_lo(cg[i].x); z[i][1] = bf_hi(hx[i].x) * bf_hi(cg[i].x); z[i][2] = bf_lo(hx[i].y) * bf_lo(cg[i].y); z[i][3] = bf_hi(hx[i].y) * bf_hi(cg[i].y);
                    z[i][4] = bf_lo(hx[i].z) * bf_lo(cg[i].z); z[i][5] = bf_hi(hx[i].z) * bf_hi(cg[i].z); z[i][6] = bf_lo(hx[i].w) * bf_lo(cg[i].w); z[i][7] = bf_hi(hx[i].w) * bf_hi(cg[i].w); }
#pragma unroll
                for (int i = 0; i < 4; ++i) { const u32x4 b4 = bg[i];
                    const float bgv[8] = {bf_lo(b4.x), bf_hi(b4.x), bf_lo(b4.y), bf_hi(b4.y), bf_lo(b4.z), bf_hi(b4.z), bf_lo(b4.w), bf_hi(b4.w)};
                    float y[8];
#pragma unroll
                    for (int j = 0; j < 8; ++j) y[j] = bgv[j] * (cw[0][j] * z[i][j] + cw[1][j] * z[i + 1][j] + cw[2][j] * z[i + 2][j]);
                    u32x4 o; o.x = cvt_pk_bf16(y[0], y[1]); o.y = cvt_pk_bf16(y[2], y[3]); o.z = cvt_pk_bf16(y[4], y[5]); o.w = cvt_pk_bf16(y[6], y[7]);
                    *(u32x4*)(MIX + (size_t)(t0 + i) * 1024 + 512 + 8 * lane) = o; } }
        }
        __syncthreads();
        {
            const int lane = opaque_tid() & 63, r32 = lane & 31, hi = lane >> 5;
            const int g = wave >> 1, ph = wave & 1;
            f32x16 acc[2][4];
#pragma unroll
            for (int pb = 0; pb < 2; ++pb)
#pragma unroll
                for (int cb = 0; cb < 4; ++cb) acc[pb][cb] = f32x16{};
            const LAS unsigned char* vbase = lds + g * 32768 + ((lane >> 4) & 1) * 32 + (lane & 3) * 8 + (4 * hi + ((lane & 15) >> 2)) * 64;
#pragma unroll 4
            for (int s = 0; s < 8; ++s) {
                bf16x8 wf[2];
#pragma unroll
                for (int pb = 0; pb < 2; ++pb) wf[pb] = *(const bf16x8*)(WSG + (size_t)(g * 128 + 64 * ph + 32 * pb + r32) * 128 + 16 * s + 8 * hi);
#pragma unroll
                for (int cb = 0; cb < 4; ++cb) {
                    const s16x4 lo = attn_body::vtr((attn_body::lds_cptr)(vbase + cb * 8192 + s * 1024)), hh = attn_body::vtr((attn_body::lds_cptr)(vbase + cb * 8192 + s * 1024 + 512));
                    const bf16x8 vf = (bf16x8){lo[0], lo[1], lo[2], lo[3], hh[0], hh[1], hh[2], hh[3]};
#pragma unroll
                    for (int pb = 0; pb < 2; ++pb) acc[pb][cb] = __builtin_amdgcn_mfma_f32_32x32x16_bf16(vf, wf[pb], acc[pb][cb], 0, 0, 0);
                }
            }
#pragma unroll
            for (int pb = 0; pb < 2; ++pb) { const int p = 64 * ph + 32 * pb + r32; const float bias = a.in[I_SGB][g * 128 + p];
                const bf16_t* urow = UV + (size_t)(tok0 + p) * 2560 + g * 128; bf16_t* orow = MIX + (size_t)(tok0 + p) * 1024 + g * 128;
                u32x2 uu[4][4];
#pragma unroll
                for (int cb = 0; cb < 4; ++cb)
#pragma unroll
                    for (int rg = 0; rg < 4; ++rg) uu[cb][rg] = *(const u32x2*)(urow + 32 * cb + 8 * rg + 4 * hi);
#pragma unroll
                for (int cb = 0; cb < 4; ++cb)
#pragma unroll
                    for (int rg = 0; rg < 4; ++rg) { const int c0 = 32 * cb + 8 * rg + 4 * hi; const u32x2 u2 = uu[cb][rg];
                        u32x2 w; w.x = cvt_pk_bf16(bf_lo(u2.x) * (acc[pb][cb][4 * rg] + bias), bf_hi(u2.x) * (acc[pb][cb][4 * rg + 1] + bias));
                        w.y = cvt_pk_bf16(bf_lo(u2.y) * (acc[pb][cb][4 * rg + 2] + bias), bf_hi(u2.y) * (acc[pb][cb][4 * rg + 3] + bias));
                        *(u32x2*)(orow + c0) = w; } }
        }
        __syncthreads();
    }
}

__global__ void __launch_bounds__(NWAVES * 64, 2) mk_fwd(Args a) {
    extern __shared__ __attribute__((aligned(16))) unsigned char lds_raw[];
    LAS unsigned char* lds = (LAS unsigned char*)lds_raw;
    const int tid0 = threadIdx.x, wave = __builtin_amdgcn_readfirstlane(tid0 >> 6);
#define tid opaque_tid()
#define lane (opaque_tid() & 63)
    const int G = gridDim.x; const int bx = blockIdx.x; const int vcu = (G % 8 == 0) ? (bx % 8) * (G / 8) + bx / 8 : bx;
    const int gw = vcu * NWAVES + wave, NGW = G * NWAVES;
    unsigned char* ws = a.ws;
    for (int u = tid0; u < (LDS_BYTES - LDSCTL_OFF) / 4; u += NWAVES * 64) ((LAS unsigned*)(lds + LDSCTL_OFF))[u] = 0u;
    __syncthreads();
    volatile LAS unsigned* MISC = (volatile LAS unsigned*)(lds + MISC_OFF);
    XcdBarrier bar = xcd_barrier_post((unsigned*)(ws + WS_CTL) + CW_BAR, MISC + 8);
    unsigned long long t_ph = 0; if constexpr (MK_PROBE != 0u) t_ph = __builtin_amdgcn_s_memrealtime();
#define PROBE_IDLE(n) do { if constexpr (MK_PROBE != 0u) { if constexpr (((MK_PROBE) >> (n)) & 1u) { const unsigned long long t1_ = __builtin_amdgcn_s_memrealtime(), d_ = t1_ - t_ph; \
        while (__builtin_amdgcn_s_memrealtime() - t1_ < d_) __builtin_amdgcn_s_sleep(8); } t_ph = __builtin_amdgcn_s_memrealtime(); } } while (0)
#define GRID_BAR(n) do { xcd_barrier(bar); PROBE_IDLE(n); } while (0)
    const float* mod = (const float*)(ws + WS_MOD);
    bf16_t* H = (bf16_t*)(ws + WS_H);
    bf16_t* ABUF = (bf16_t*)(ws + WS_ABUF);

    PH(0) { p0_prologue(a, lds, tid, lane, wave, vcu, G); convert_weights(a, lds, 0, lane, wave, gw, NGW); }
    GRID_BAR(0);
#if MK_STAGE == 0
    copy_rows(a.in[I_X], a.out, lane, gw, NGW); return;
#endif
    PH(1) p1_ln_rows(a, lane, gw, NGW);
    GRID_BAR(1);
    PH(2) {   pg8::SchedInProj0 S{G, vcu};
        pg8::EpiQKV E{(bf16_t*)(ws + RG_Q), (bf16_t*)(ws + RG_K), (bf16_t*)(ws + RG_V), (bf16_t*)(ws + RG_P), a.in[I_QG], a.in[I_KG]};
        pg8::gemm_phase<pg8::EpiQKV, pg8::SchedInProj0, false>(lds, ABUF, (const bf16_t*)(ws + WS_WIN0), 1024, S, E); }
    PH(2) {   const int nfull = 648 % G;
        if (nfull != 0 && vcu >= nfull) convert_weights(a, lds, 1, lane, wave, (vcu - nfull) * NWAVES + wave, (G - nfull) * NWAVES);
        else if (nfull == 0) convert_weights(a, lds, 1, lane, wave, gw, NGW); }
    GRID_BAR(2);
    PH(3) {   const int nper = (NB * 8 * (SEQ / 256)) / G;
        for (int i = 0; i < nper; ++i) { const int uidx = vcu * nper + i; const int b = uidx >> 7, rem = uidx & 127, h = rem & 7, qb = rem >> 3;
            attn_body::attn_unit<8>(b, h, qb, (const bf16_t*)(ws + RG_Q), (const bf16_t*)(ws + RG_K), (const bf16_t*)(ws + RG_V), (bf16_t*)(ws + RG_A2), (char*)lds_raw); }
        for (int p = gw; p < (MT / 32) * 2; p += NGW)
#pragma unroll 1
            for (int k = 0; k < 2; ++k) pool_task(p >> 1, (p & 1) ? 1 + k : 3 * k, (const bf16_t*)(ws + RG_P), (const bf16_t*)(ws + WS_WPOOL), a.in[I_POOLS], (bf16_t*)(ws + RG_A2), lane); }
    GRID_BAR(3);
    PH(4) {   pg8::SchedGrid S{4, 128 * 4, G, vcu};
        pg8::EpiResid<true> E{a.in[I_X], H, mod + 2 * 1024};
        pg8::gemm_phase<pg8::EpiResid<true>, pg8::SchedGrid, false>(lds, (const bf16_t*)(ws + RG_A2), (const bf16_t*)(ws + WS_WOUT0), 1024, S, E); }
    GRID_BAR(4);
#if MK_STAGE == 1
    copy_rows(H, a.out, lane, gw, NGW); return;
#endif
#if MK_STAGE >= 2
    PH(5) router_phase(a, 0, lds, tid, lane, wave, G);
    GRID_BAR(5);
    build_tp(a, 0, lds, tid);
    PH(6) {   pg8::SchedMoE S{(const volatile LAS int*)(lds + TP_OFF), (const int*)(ws + RT_LIST), G, vcu, false, (const f32x2*)(ws + RT_WSLOT), lds + SIDE_OFF};
        pg8::EpiGateUp E{(bf16_t*)(ws + WS_RGN), lds + SIDE_OFF};
        pg8::gemm_phase<pg8::EpiGateUp, pg8::SchedMoE, true>(lds, ABUF, (const bf16_t*)(ws + WS_WGU), 1024, S, E); }
    PH(6) {   const int nun = ((const volatile LAS int*)(lds + TP_OFF))[NCLS] * 4, nfull = nun % G;
        if (nfull != 0 && vcu >= nfull) convert_weights(a, lds, 2, lane, wave, (vcu - nfull) * NWAVES + wave, (G - nfull) * NWAVES);
        else if (nfull == 0) convert_weights(a, lds, 2, lane, wave, gw, NGW); }
    GRID_BAR(6);
    PH(7) {   pg8::SchedMoE S{(const volatile LAS int*)(lds + TP_OFF), (const int*)(ws + RT_LIST), G, vcu, true, (const f32x2*)(ws + RT_WSLOT), lds + SIDE_OFF};
        pg8::EpiCombine<false> E{H, a.out, mod + 5 * 1024, lds + SIDE_OFF};
        pg8::gemm_phase<pg8::EpiCombine<false>, pg8::SchedMoE, false, true>(lds, (const bf16_t*)(ws + WS_RGN), (const bf16_t*)(ws + WS_WDN), 512, S, E); }
    GRID_BAR(7);
#endif
#if MK_STAGE >= 3
    PH(8) ln1_phase(a, lane, gw, NGW);
    GRID_BAR(8);
#endif
#if MK_STAGE == 2
    copy_rows(H, a.out, lane, gw, NGW); return;
#endif
#if MK_STAGE >= 3
    PH(9) {   pg8::SchedGrid S{10, 128 * 10, G, vcu};
        pg8::EpiBf16 E{(bf16_t*)(ws + WS_RGN), 2560, false};
        pg8::gemm_phase<pg8::EpiBf16, pg8::SchedGrid, false>(lds, ABUF, (const bf16_t*)(ws + WS_WIN1), 1024, S, E); }
    GRID_BAR(9);
    PH(10) sgconv_phase(a, lds, tid, lane, wave, G);
    GRID_BAR(10);
    PH(11) {   pg8::SchedGrid S{4, 128 * 4, G, vcu};
        pg8::EpiResid<false> E{H, H, mod + (size_t)9 * 6144 + 2 * 1024};
        pg8::gemm_phase<pg8::EpiResid<false>, pg8::SchedGrid, false>(lds, ABUF, (const bf16_t*)(ws + WS_WOUT1), 1024, S, E); }
    GRID_BAR(11);
#endif
#if MK_STAGE == 3
    copy_rows(H, a.out, lane, gw, NGW); return;
#endif
#if MK_STAGE >= 4
    router_phase(a, 1, lds, tid, lane, wave, G);
    GRID_BAR(12);
    build_tp(a, 1, lds, tid);
    {   pg8::SchedMoE S{(const volatile LAS int*)(lds + TP_OFF), (const int*)(ws + RT_LIST), G, vcu, false, (const f32x2*)(ws + RT_WSLOT), lds + SIDE_OFF};
        pg8::EpiGateUp E{(bf16_t*)(ws + WS_RGN), lds + SIDE_OFF};
        pg8::gemm_phase<pg8::EpiGateUp, pg8::SchedMoE, true>(lds, ABUF, (const bf16_t*)(ws + WS_WGU) + (size_t)8192 * 1024, 1024, S, E); }
    GRID_BAR(13);
    {   pg8::SchedMoE S{(const volatile LAS int*)(lds + TP_OFF), (const int*)(ws + RT_LIST), G, vcu, true, (const f32x2*)(ws + RT_WSLOT), lds + SIDE_OFF};
        pg8::EpiCombine<true> E{H, a.out, mod + (size_t)9 * 6144 + 5 * 1024, lds + SIDE_OFF};
        pg8::gemm_phase<pg8::EpiCombine<true>, pg8::SchedMoE, false, true>(lds, (const bf16_t*)(ws + WS_RGN), (const bf16_t*)(ws + WS_WDN) + (size_t)16384 * 256, 512, S, E); }
    PROBE_IDLE(15);
#endif
#undef tid
#undef lane
}

extern "C" void kernel_launch(void* const* d_in, const int* in_sizes, int n_in, void* d_out, int out_size, void* d_ws, size_t ws_size, hipStream_t stream) {
    static int grid = 0;
    if (grid == 0) {
        if (n_in != 27 || out_size != MT * DM || ws_size < WS_END) { fprintf(stderr, "kernel_launch: unexpected problem (n_in %d, out %d, ws %zu)\n", n_in, out_size, ws_size); grid = -1; return; }
        int dev = 0, cus = 0, per_cu = 0;
        if (hipGetDevice(&dev) != hipSuccess || hipDeviceGetAttribute(&cus, hipDeviceAttributeMultiprocessorCount, dev) != hipSuccess) { grid = -1; return; }
        if (hipFuncSetAttribute((const void*)mk_fwd, hipFuncAttributeMaxDynamicSharedMemorySize, LDS_BYTES) != hipSuccess) { fprintf(stderr, "kernel_launch: hipFuncSetAttribute failed\n"); grid = -1; return; }
        if (hipOccupancyMaxActiveBlocksPerMultiprocessor(&per_cu, (const void*)mk_fwd, NWAVES * 64, LDS_BYTES) != hipSuccess || per_cu < 1) { fprintf(stderr, "kernel_launch: occupancy query says %d blocks per CU\n", per_cu); }
        (void)hipGetLastError();
        grid = cus;
    }
    if (grid < 0) return;
    if (hipMemsetAsync((char*)d_ws + WS_CTL, 0, CTL_ZERO_BYTES, stream) != hipSuccess) return;
    Args a{};
    for (int i = 0; i < 27; ++i) a.in[i] = (const float*)d_in[i];
    a.out = (float*)d_out; a.ws = (unsigned char*)d_ws;
    hipLaunchKernelGGL(mk_fwd, dim3(grid), dim3(NWAVES * 64), LDS_BYTES, stream, a);
}
```

```cpp
#include <hip/hip_runtime.h>
#include <cstdio>
#include <cstdint>

#ifndef MK_PH
#define MK_PH 0xffffffffu
#endif
#define PH(n) if constexpr (((MK_PH) >> (n)) & 1u)
#ifndef MK_PROBE
#define MK_PROBE 0u
#endif
#ifndef MK_STAGE
#define MK_STAGE 4
#endif

#define LAS __attribute__((address_space(3)))
#define GAS __attribute__((address_space(1)))
typedef unsigned short bf16_t;
typedef short bf16x8 __attribute__((ext_vector_type(8)));
typedef short s16x4 __attribute__((ext_vector_type(4)));
typedef float f32x2 __attribute__((ext_vector_type(2)));
typedef float f32x4 __attribute__((ext_vector_type(4)));
typedef float f32x16 __attribute__((ext_vector_type(16)));
typedef unsigned u32x2 __attribute__((ext_vector_type(2)));
typedef unsigned u32x4 __attribute__((ext_vector_type(4)));

constexpr int NB = 8, SEQ = 4096, DM = 1024, MT = NB * SEQ, CTX = 256, MC = NB * CTX, MA = MT + MC, NKV = SEQ + CTX;
constexpr int NEXP = 16, DEXP = 256, NCLS = 24, LISTCAP = MT;
constexpr int SLOT_ROWS = MT + NCLS * 256;
constexpr float EPS = 1e-6f;
constexpr float C2 = 0.125f * 1.4426950408889634f;

constexpr size_t MiB = 1u << 20;
constexpr size_t WS_CTL = 0, CTL_ZERO_BYTES = 65536;
constexpr size_t WS_MOD = 512 * 1024;
constexpr size_t WS_WIN0 = 2 * MiB;
constexpr size_t WS_WOUT0 = 5 * MiB;
constexpr size_t WS_WIN1 = 7 * MiB;
constexpr size_t WS_WOUT1 = 12 * MiB;
constexpr size_t WS_WGU = 14 * MiB;
constexpr size_t WS_WDN = 46 * MiB;
constexpr size_t WS_WPOOL = 62 * MiB;
constexpr size_t WS_WSG = 62 * MiB + 512 * 1024;
constexpr size_t WS_ABUF = 64 * MiB;
constexpr size_t WS_H = 132 * MiB;
constexpr size_t WS_ACT = 260 * MiB;
constexpr size_t WS_RGN = 294 * MiB;
constexpr size_t RG_Q = WS_RGN, RG_K = RG_Q + 32 * MiB, RG_V = RG_K + 9 * MiB, RG_P = RG_V + 9 * MiB, RG_A2 = RG_P + 32 * MiB;
constexpr size_t WS_ROUTE = 462 * MiB;
constexpr size_t RT_LIST = WS_ROUTE;
constexpr size_t RT_WSLOT = WS_ACT;
constexpr size_t WS_END = 466 * MiB;
static_assert(RG_A2 + (size_t)MT * 1024 * 2 <= WS_ROUTE && WS_RGN + (size_t)SLOT_ROWS * 512 * 2 <= WS_ROUTE && WS_RGN + (size_t)MT * 2560 * 2 <= WS_ROUTE && RT_LIST + (size_t)NCLS * LISTCAP * 4 <= WS_END && RT_WSLOT + (size_t)NCLS * LISTCAP * 8 <= WS_RGN, "region map");
static_assert(WS_ABUF + (size_t)MA * 1024 * 2 <= WS_H && WS_H + (size_t)MT * 1024 * 4 <= WS_ACT, "ws map");
constexpr int CW_CNT = 64;
constexpr int CW_BAR = 4096;

constexpr int RING_BYTES = 131072;
constexpr int LDSCTL_OFF = RING_BYTES, MISC_OFF = LDSCTL_OFF + 320;
constexpr int SIDE_OFF = LDSCTL_OFF + 1024;
constexpr int LDS_BYTES = 147456;
constexpr int NWAVES = 8;

__device__ __forceinline__ unsigned cvt_pk_bf16(float lo, float hi) { unsigned r; asm volatile("v_cvt_pk_bf16_f32 %0, %1, %2" : "=v"(r) : "v"(lo), "v"(hi)); return r; }
__device__ __forceinline__ float bf_lo(unsigned w) { return __uint_as_float(w << 16); }
__device__ __forceinline__ float bf_hi(unsigned w) { return __uint_as_float(w & 0xffff0000u); }
__device__ __forceinline__ float wave_sum(float v) {
#pragma unroll
    for (int o = 1; o < 64; o <<= 1) v += __shfl_xor(v, o);
    return v;
}
__device__ __forceinline__ float fast_rcp(float x) { return __builtin_amdgcn_rcpf(x); }
__device__ __forceinline__ float silu_f(float v) { return v * fast_rcp(1.f + __builtin_amdgcn_exp2f(-1.4426950408889634f * v)); }

__device__ __forceinline__ int opaque_tid() { int t = threadIdx.x; asm volatile("" : "+v"(t)); return t; }

#define XB_TMO      128
#define XB_XCNT(j)  (256  + 64 * (j))
#define XB_XSUB(j)  (1280 + 64 * (j))
#define XB_XGEN(j)  (2304 + 64 * (j))
#define XB_TOP      3328
#define XB_TOPGEN   3392
#define XCD_BAR_WORDS 3456
#define XB_SPIN_CAP (1u << 18)
__device__ __forceinline__ unsigned xb_ld(unsigned* p)              { return __hip_atomic_load(p, __ATOMIC_RELAXED, __HIP_MEMORY_SCOPE_AGENT); }
__device__ __forceinline__ unsigned xb_add(unsigned* p, unsigned v) { return __hip_atomic_fetch_add(p, v, __ATOMIC_RELAXED, __HIP_MEMORY_SCOPE_AGENT); }
__device__ __forceinline__ unsigned xb_xcc_id() { return (unsigned)__builtin_amdgcn_s_getreg((3 << 11) | 20) & 0xFu; }
#define XB_SPIN(cond, bar) do { unsigned _sp = 0; while (cond) { __builtin_amdgcn_s_sleep(1); \
    if ((++_sp & 255u) == 0u) { if (xb_ld(&(bar)[XB_TMO])) break; if (_sp > XB_SPIN_CAP) { atomicAdd(&(bar)[XB_TMO], 1u); break; } } } } while (0)
struct XcdBarrier { unsigned* bar; unsigned x; volatile LAS unsigned* st; };
__device__ __forceinline__ XcdBarrier xcd_barrier_post(unsigned* bar, volatile LAS unsigned* st) {
    XcdBarrier b; b.bar = bar; b.x = xb_xcc_id(); b.st = st;
    if (threadIdx.x == 0) (void)xb_add(&bar[XB_XCNT(b.x)], 1u);
    return b;
}
__device__ __forceinline__ void xcd_barrier_complete(unsigned* bar, unsigned x, unsigned& nloc, unsigned& nx) {
    const unsigned G = gridDim.x * gridDim.y * gridDim.z;
    unsigned sum, cnt, mine, sp = 0u;
    for (;;) {
        sum = 0u; cnt = 0u; mine = 0u;
#pragma unroll
        for (unsigned j = 0; j < 16; ++j) { const unsigned c = xb_ld(&bar[XB_XCNT(j)]); sum += c; cnt += (c > 0u) ? 1u : 0u; mine = (j == x) ? c : mine; }
        if (sum == G) break;
        __builtin_amdgcn_s_sleep(1);
        if ((++sp & 255u) == 0u) { if (xb_ld(&bar[XB_TMO])) break; if (sp > XB_SPIN_CAP) { atomicAdd(&bar[XB_TMO], 1u); break; } }
    }
    nloc = mine > 0u ? mine : 1u; nx = cnt > 0u ? cnt : 1u;
}
__device__ __forceinline__ void xcd_barrier(const XcdBarrier& b) {
    asm volatile("s_waitcnt vmcnt(0)" ::: "memory");
    __syncthreads();
    if (threadIdx.x == 0) {
        unsigned* bar = b.bar;
        __builtin_amdgcn_s_waitcnt(0);
        unsigned nloc = b.st[0], nx = b.st[1];
        if (nloc == 0u) { xcd_barrier_complete(bar, b.x, nloc, nx); b.st[0] = nloc; b.st[1] = nx; }
        const unsigned old = xb_add(&bar[XB_XSUB(b.x)], 1u);
        const unsigned gen = old / nloc;
        if (old + 1u == (gen + 1u) * nloc) {
            __builtin_amdgcn_fence(__ATOMIC_RELEASE, "agent");
            asm volatile("s_waitcnt vmcnt(0)" ::: "memory");
            const unsigned og = xb_add(&bar[XB_TOP], 1u);
            const unsigned tg = og / nx;
            if (og + 1u == (tg + 1u) * nx) xb_add(&bar[XB_TOPGEN], 1u);
            else XB_SPIN(xb_ld(&bar[XB_TOPGEN]) == tg, bar);
            __builtin_amdgcn_fence(__ATOMIC_ACQUIRE, "agent");
            xb_add(&bar[XB_XGEN(b.x)], 1u);
            asm volatile("s_waitcnt vmcnt(0)" ::: "memory");
        } else {
            XB_SPIN(xb_ld(&bar[XB_XGEN(b.x)]) == gen, bar);
            __builtin_amdgcn_fence(__ATOMIC_ACQUIRE, "agent");
            asm volatile("s_waitcnt vmcnt(0)" ::: "memory");
        }
    }
    __syncthreads();
}

namespace pg8 {
constexpr int BM = 256, BK = 64, HALF = 128, HTB = HALF * BK * 2;
__device__ __forceinline__ int lds_byte(int r, int c) { const int st = (r >> 4) * 2 + (c >> 5), rr = r & 15, cc = c & 31, ob = rr * 64 + cc * 2; return st * 1024 + (ob ^ (((ob >> 9) & 1) << 5)); }
__device__ __forceinline__ void stage_rc(int b, int& R, int& C) { const int st = b / 1024, sb = b % 1024, swz = sb ^ (((sb >> 9) & 1) << 5); R = (st >> 1) * 16 + swz / 64; C = (st & 1) * 32 + (swz % 64) / 2; }
__device__ __forceinline__ int perm32(int rho) { const int n = rho >> 4, i = rho & 15; return 8 * (i >> 2) + 4 * n + (i & 3); }

struct Unit { int pm, pn, pn2, aux, e, r, slot, half; };

template <class Epi, class Sched, bool GATHER, bool SPLITB = false>
__device__ __forceinline__ void gemm_phase(LAS unsigned char* lds, const bf16_t* A, const bf16_t* Bt, const int K, const Sched& S, const Epi& E) {
    const int tid = opaque_tid(), wid = __builtin_amdgcn_readfirstlane(tid >> 6), lane = tid & 63, wr = wid >> 2, wc = wid & 3, fr = lane & 15, fq = lane >> 4;
    const int nt = K / BK, KB = SPLITB ? K / 2 : K, ntb = SPLITB ? nt / 2 : nt;
    unsigned voffB[2]; int RA[2], CA[2];
#pragma unroll
    for (int i = 0; i < 2; ++i) { int R, C; stage_rc(tid * 16 + i * 8192, R, C); const int Rb = Epi::PERM ? ((R & ~31) + perm32(R & 31)) : R;
        voffB[i] = (unsigned)(Rb * KB + C) * 2u; RA[i] = R; CA[i] = C; }
    const size_t kstep = (size_t)(BK * 2);
    const size_t hstep = (size_t)HALF * K * 2;
    const size_t tstep = 2 * hstep;
    const size_t hstepB = (size_t)HALF * KB * 2, tstepB = 2 * hstepB;
    const unsigned ldsw = (unsigned)wid * 1024u;
    const int aoff = lds_byte(wr * 64 + fr, fq * 8), boff = lds_byte(wc * 32 + fr, fq * 8);
#define PG8_SA(b, h) (((b) * 2 + (h)) * HTB)
#define PG8_SB(b, h) ((4 + (b) * 2 + (h)) * HTB)
#define PG8_STAGE(bufoff, gbase, voff) do { _Pragma("unroll") for (int _i = 0; _i < 2; ++_i) \
        __builtin_amdgcn_global_load_lds((const unsigned*)((const char*)(gbase) + (voff)[_i]), (LAS unsigned*)(lds + (bufoff) + ldsw + _i * 8192), 16, 0, 0); } while (0)
#define PG8_LDA(dst, b, h) do { _Pragma("unroll") for (int m = 0; m < 4; ++m) _Pragma("unroll") for (int k = 0; k < 2; ++k) dst[m][k] = *(const LAS bf16x8*)(lds + PG8_SA(b, h) + aoff + m * 2048 + k * 1024); } while (0)
#define PG8_LDB(dst, b, h) do { _Pragma("unroll") for (int n = 0; n < 2; ++n) _Pragma("unroll") for (int k = 0; k < 2; ++k) dst[n][k] = *(const LAS bf16x8*)(lds + PG8_SB(b, h) + boff + n * 2048 + k * 1024); } while (0)
#define PG8_MMA(ai, bj, At, Bt_) do { __builtin_amdgcn_s_setprio(1); _Pragma("unroll") for (int m = 0; m < 4; ++m) _Pragma("unroll") for (int n = 0; n < 2; ++n) _Pragma("unroll") for (int k = 0; k < 2; ++k) \
        acc[ai][bj][m][n] = __builtin_amdgcn_mfma_f32_16x16x32_bf16(Bt_[n][k], At[m][k], acc[ai][bj][m][n], 0, 0, 0); __builtin_amdgcn_s_setprio(0); } while (0)
#define PG8_WAIT_V(n) asm volatile("s_waitcnt vmcnt(" #n ")" ::: "memory")
#define PG8_WAIT_L(n) asm volatile("s_waitcnt lgkmcnt(" #n ")" ::: "memory")
#define PG8_BAR __builtin_amdgcn_s_barrier()
#define PG8_SCHED __builtin_amdgcn_sched_barrier(0)
    Unit cur, nxt; int ui = 0;
    if (!S.next(0, cur)) return;
    cur.slot = 0; S.prep(cur, tid);
    unsigned voA[2][2], voN[2][2];
    if constexpr (GATHER) S.rows(cur, RA, CA, K, voA);
    else {
#pragma unroll
        for (int h = 0; h < 2; ++h)
#pragma unroll
            for (int i = 0; i < 2; ++i) voA[h][i] = (unsigned)((h * HALF + RA[i]) * K + CA[i]) * 2u;
    }
    f32x4 acc[2][2][4][2];
#pragma unroll
    for (int a = 0; a < 2; ++a)
#pragma unroll
        for (int b = 0; b < 2; ++b)
#pragma unroll
            for (int m = 0; m < 4; ++m)
#pragma unroll
                for (int n = 0; n < 2; ++n) acc[a][b][m][n] = (f32x4){0.f, 0.f, 0.f, 0.f};
    bf16x8 At[4][2], B0[2][2], B1[2][2];
    const char* cA = GATHER ? (const char*)A : (const char*)A + (size_t)cur.pm * tstep;
    const char* cB = (const char*)Bt + (size_t)cur.pn * tstepB;
    const char* cB2 = SPLITB ? (const char*)Bt + (size_t)cur.pn2 * tstepB : cB;
    PG8_STAGE(PG8_SB(0, 0), cB, voffB); PG8_STAGE(PG8_SB(0, 1), cB + hstepB, voffB); PG8_STAGE(PG8_SA(0, 0), cA, voA[0]); PG8_STAGE(PG8_SA(0, 1), cA, voA[1]);
    if (wr == 1) PG8_BAR;
    PG8_WAIT_V(2); PG8_BAR;
    PG8_STAGE(PG8_SB(1, 0), cB + kstep, voffB); PG8_STAGE(PG8_SA(1, 0), cA + kstep, voA[0]); PG8_STAGE(PG8_SB(1, 1), cB + hstepB + kstep, voffB);
    PG8_WAIT_V(6); PG8_BAR;
    for (;;) {
        const bool has_next = S.next(ui + 1, nxt);
        if (has_next) { nxt.slot = (cur.slot == 2) ? 0 : cur.slot + 1; S.prep(nxt, tid); }
        const char* nA = cA; const char* nB = cB; const char* nB2 = cB2;
        if (has_next) { nA = GATHER ? (const char*)A : (const char*)A + (size_t)nxt.pm * tstep; nB = (const char*)Bt + (size_t)nxt.pn * tstepB; nB2 = SPLITB ? (const char*)Bt + (size_t)nxt.pn2 * tstepB : nB; }
        if constexpr (GATHER) {
            if (has_next) S.rows(nxt, RA, CA, K, voN);
            else {
#pragma unroll
                for (int h = 0; h < 2; ++h)
#pragma unroll
                    for (int i = 0; i < 2; ++i) voN[h][i] = voA[h][i];
            }
        }
#pragma unroll 1
        for (int t = 0; t < nt; t += 2) {
            const bool last = (t == nt - 2);
            const char* a1 = cA + (size_t)(t + 1) * kstep;
            const char* a2 = last ? nA : cA + (size_t)(t + 2) * kstep;
            const char* b2 = last ? nB : (SPLITB && t + 2 >= ntb) ? cB2 + (size_t)(t + 2 - ntb) * kstep : cB + (size_t)(t + 2) * kstep;
            const char* a3 = a2 + kstep; const char* b3 = b2 + kstep;
            unsigned sel[2][2];
#pragma unroll
            for (int h = 0; h < 2; ++h)
#pragma unroll
                for (int i = 0; i < 2; ++i) sel[h][i] = (GATHER && last) ? voN[h][i] : voA[h][i];
            PG8_LDB(B0, 0, 0); PG8_LDB(B1, 0, 1); PG8_SCHED; PG8_LDA(At, 0, 0); PG8_STAGE(PG8_SA(1, 1), a1, voA[1]);
            PG8_WAIT_V(8); PG8_WAIT_L(0); PG8_BAR; PG8_MMA(0, 0, At, B0); PG8_MMA(0, 1, At, B1); PG8_BAR; PG8_SCHED;
            PG8_LDA(At, 0, 1); PG8_STAGE(PG8_SB(0, 0), b2, voffB); PG8_STAGE(PG8_SB(0, 1), b2 + hstepB, voffB); PG8_STAGE(PG8_SA(0, 0), a2, sel[0]);
            PG8_WAIT_V(8); PG8_WAIT_L(0); PG8_BAR; if (!cur.half) { PG8_MMA(1, 0, At, B0); PG8_MMA(1, 1, At, B1); } PG8_BAR; PG8_SCHED;
            PG8_LDB(B0, 1, 0); PG8_LDB(B1, 1, 1); PG8_SCHED; PG8_LDA(At, 1, 0); PG8_STAGE(PG8_SA(0, 1), a2, sel[1]);
            PG8_WAIT_V(8); PG8_WAIT_L(0); PG8_BAR; PG8_MMA(0, 0, At, B0); PG8_MMA(0, 1, At, B1); PG8_BAR; PG8_SCHED;
            PG8_LDA(At, 1, 1); PG8_STAGE(PG8_SB(1, 0), b3, voffB); PG8_STAGE(PG8_SB(1, 1), b3 + hstepB, voffB); PG8_STAGE(PG8_SA(1, 0), a3, sel[0]);
            PG8_WAIT_V(8); PG8_WAIT_L(0); PG8_BAR; if (!cur.half) { PG8_MMA(1, 0, At, B0); PG8_MMA(1, 1, At, B1); } PG8_BAR; PG8_SCHED;
        }
        if constexpr (Epi::ALIGN) { if (wr == 0) PG8_BAR; }
        E(acc, cur, wr, wc, fr, fq);
        if (!has_next) break;
#pragma unroll
        for (int a = 0; a < 2; ++a)
#pragma unroll
            for (int b = 0; b < 2; ++b)
#pragma unroll
                for (int m = 0; m < 4; ++m)
#pragma unroll
                    for (int n = 0; n < 2; ++n) acc[a][b][m][n] = (f32x4){0.f, 0.f, 0.f, 0.f};
        cur = nxt; cA = nA; cB = nB; cB2 = nB2; ++ui;
        if constexpr (GATHER) {
#pragma unroll
            for (int h = 0; h < 2; ++h)
#pragma unroll
                for (int i = 0; i < 2; ++i) voA[h][i] = voN[h][i];
        }
        if constexpr (Epi::ALIGN) { if (wr == 1) PG8_BAR; }
    }
    PG8_WAIT_V(0);
    if constexpr (!Epi::ALIGN) { if (wr == 0) PG8_BAR; }
    PG8_BAR;
#undef PG8_SA
#undef PG8_SB
#undef PG8_STAGE
#undef PG8_LDA
#undef PG8_LDB
#undef PG8_MMA
#undef PG8_WAIT_V
#undef PG8_WAIT_L
#undef PG8_BAR
#undef PG8_SCHED
}

struct SchedGrid {
    int nN, total, G, c;
    __device__ __forceinline__ bool next(int i, Unit& u) const { const int L = i * G + c; if (L >= total) return false; u.pm = L / nN; u.pn = L % nN; u.pn2 = 0; u.aux = u.pn; u.e = 0; u.r = 0; u.half = 0; return true; }
    __device__ __forceinline__ void prep(const Unit&, int) const {}
};
struct SchedInProj0 {
    int G, c;
    __device__ __forceinline__ bool next(int i, Unit& u) const { const int L = i * G + c; if (L >= 648) return false;
        if (L < 640) { u.pm = L / 5; u.pn = L % 5; } else { u.pm = 128 + (L - 640); u.pn = 2; } u.pn2 = 0; u.aux = u.pn; u.e = 0; u.r = 0; u.half = 0; return true; }
    __device__ __forceinline__ void prep(const Unit&, int) const {}
};
struct SchedMoE {
    const volatile LAS int* tp; const int* list; int G, c; bool down; const f32x2* wslot; LAS unsigned char* side;
    __device__ __forceinline__ void prep(const Unit& u, int tid) const {
        if (tid < 256) { const int idx = u.r * 256 + tid; const bool ok = idx < tp[NCLS + 1 + u.e];
            ((LAS int*)(side + u.slot * 3072))[tid] = ok ? list[u.e * LISTCAP + idx] : -1;
            if (!down) ((LAS f32x2*)(side + u.slot * 3072 + 1024))[tid] = ok ? wslot[(size_t)u.e * LISTCAP + idx] : (f32x2){0.f, 0.f}; }
    }
    __device__ __forceinline__ bool next(int i, Unit& u) const {
        const volatile LAS int* hp = tp + 2 * NCLS + 1; const volatile LAS int* lp = hp + NCLS + 1;
        const int L = i * G + c; const int nh = hp[NCLS], total = tp[NCLS] * 4; if (L >= total) return false;
        const int ct = L & 3; int cl = 0, r, half;
        if (L < 4 * nh) { const int rt = L >> 2;
#pragma unroll
            for (int j = 1; j < NCLS; ++j) cl += (rt >= hp[j]) ? 1 : 0;
            cl = __builtin_amdgcn_readfirstlane(cl); r = rt - hp[cl]; half = 0; }
        else { const int li = (L >> 2) - nh;
#pragma unroll
            for (int j = 1; j < NCLS; ++j) cl += (li >= lp[j]) ? 1 : 0;
            cl = __builtin_amdgcn_readfirstlane(cl); r = tp[cl + 1] - tp[cl] - 1; half = 1; }
        const int g = cl / 6, p = cl % 6; const int lo = (p < 3) ? 0 : (p < 5) ? 1 : 2, hi = (p < 3) ? p + 1 : (p < 5) ? p - 1 : 3;
        const int elo = 4 * g + lo, ehi = 4 * g + hi;
        u.pm = tp[cl] + r; u.aux = ct; u.e = cl; u.r = r; u.half = half;
        if (down) { u.pn = elo * 4 + ct; u.pn2 = ehi * 4 + ct; }
        else { u.pn = ((ct < 2) ? elo : ehi) * 2 + (ct & 1); u.pn2 = 0; }
        return true;
    }
    __device__ __forceinline__ void rows(const Unit& u, const int (&RA)[2], const int (&CA)[2], int K, unsigned (&vo)[2][2]) const {
        const int cnt = tp[NCLS + 1 + u.e];
#pragma unroll
        for (int h = 0; h < 2; ++h)
#pragma unroll
            for (int i = 0; i < 2; ++i) { const int idx = u.r * 256 + h * HALF + RA[i]; const int tok = (idx < cnt) ? list[u.e * LISTCAP + idx] : 0;
                vo[h][i] = (unsigned)(tok * K + CA[i]) * 2u; }
    }
};

typedef f32x4 Acc[2][2][4][2];
struct EpiBf16 {
    static constexpr bool PERM = true, ALIGN = true;
    bf16_t* O; int ldc; bool use_aux;
    __device__ __forceinline__ void operator()(const Acc& acc, const Unit& u, int wr, int wc, int fr_, int fq_) const {
        int ln_ = fr_ | (fq_ << 4); asm volatile("" : "+v"(ln_)); const int fr = ln_ & 15, fq = ln_ >> 4;
        const int row0 = u.pm * BM + wr * 64 + fr; const int col0 = (use_aux ? u.aux : u.pn) * BM + wc * 32 + 8 * fq;
#pragma unroll
        for (int ai = 0; ai < 2; ++ai)
#pragma unroll
            for (int m = 0; m < 4; ++m) { bf16_t* rowp = O + (size_t)(row0 + ai * HALF + m * 16) * ldc + col0;
#pragma unroll
                for (int bj = 0; bj < 2; ++bj) { const f32x4 v0 = acc[ai][bj][m][0], v1 = acc[ai][bj][m][1];
                    u32x4 w; w.x = cvt_pk_bf16(v0[0], v0[1]); w.y = cvt_pk_bf16(v0[2], v0[3]); w.z = cvt_pk_bf16(v1[0], v1[1]); w.w = cvt_pk_bf16(v1[2], v1[3]);
                    *(u32x4*)(rowp + bj * HALF) = w; } }
    }
};
struct EpiGateUp {
    static constexpr bool PERM = true, ALIGN = true;
    bf16_t* O; LAS unsigned char* side;
    __device__ __forceinline__ void operator()(const Acc& acc, const Unit& u, int wr, int wc, int fr_, int fq_) const {
        int ln_ = fr_ | (fq_ << 4); asm volatile("" : "+v"(ln_)); const int fr = ln_ & 15, fq = ln_ >> 4;
        const int row0 = u.pm * BM + wr * 64 + fr; const int col0 = u.aux * HALF + wc * 32 + 8 * fq;
        const LAS float* wp = (const LAS float*)(side + u.slot * 3072 + 1024) + 2 * (wr * 64 + fr) + ((u.aux < 2) ? 0 : 1);
#pragma unroll
        for (int ai = 0; ai < 2; ++ai) { if (ai == 1 && u.half) break;
#pragma unroll
            for (int m = 0; m < 4; ++m) { const int rl = ai * HALF + m * 16; bf16_t* rowp = O + (size_t)(row0 + rl) * 512 + col0;
                const float w = wp[2 * rl];
                float o[8];
#pragma unroll
                for (int n = 0; n < 2; ++n)
#pragma unroll
                    for (int j = 0; j < 4; ++j) o[n * 4 + j] = w * silu_f(acc[ai][0][m][n][j]) * acc[ai][1][m][n][j];
                u32x4 wv; wv.x = cvt_pk_bf16(o[0], o[1]); wv.y = cvt_pk_bf16(o[2], o[3]); wv.z = cvt_pk_bf16(o[4], o[5]); wv.w = cvt_pk_bf16(o[6], o[7]);
                *(u32x4*)rowp = wv; } }
    }
};
template <bool FINAL> struct EpiCombine {
    static constexpr bool PERM = true, ALIGN = true;
    bf16_t* H; float* out; const float* gate; LAS unsigned char* side;
    __device__ __forceinline__ void operator()(const Acc& acc, const Unit& u, int wr, int wc, int fr_, int fq_) const {
        int ln_ = fr_ | (fq_ << 4); asm volatile("" : "+v"(ln_)); const int fr = ln_ & 15, fq = ln_ >> 4;
        const int col0 = u.aux * BM + wc * 32 + 8 * fq;
        const LAS int* tk = (const LAS int*)(side + u.slot * 3072) + wr * 64 + fr;
#pragma unroll
        for (int ai = 0; ai < 2; ++ai)
#pragma unroll
          for (int mp = 0; mp < 4; mp += 2) {
            int tok[2]; u32x4 hw[2][2]; f32x4 gg[2][2][2];
#pragma unroll
            for (int mm = 0; mm < 2; ++mm) { tok[mm] = tk[ai * HALF + (mp + mm) * 16]; const int tc = tok[mm] < 0 ? 0 : tok[mm];
                const float* gb = gate + (size_t)(tc >> 12) * 6144 + col0; const size_t off = (size_t)tc * DM + col0;
#pragma unroll
                for (int bj = 0; bj < 2; ++bj) { hw[mm][bj] = *(const u32x4*)(H + off + bj * HALF); gg[mm][bj][0] = *(const f32x4*)(gb + bj * HALF); gg[mm][bj][1] = *(const f32x4*)(gb + bj * HALF + 4); } }
#pragma unroll
            for (int mm = 0; mm < 2; ++mm) { const int m = mp + mm; const size_t off = (size_t)(tok[mm] < 0 ? 0 : tok[mm]) * DM + col0;
#pragma unroll
                for (int bj = 0; bj < 2; ++bj) { const u32x4 w = hw[mm][bj];
                    const f32x4 h0 = (f32x4){bf_lo(w.x), bf_hi(w.x), bf_lo(w.y), bf_hi(w.y)} + gg[mm][bj][0] * acc[ai][bj][m][0], h1 = (f32x4){bf_lo(w.z), bf_hi(w.z), bf_lo(w.w), bf_hi(w.w)} + gg[mm][bj][1] * acc[ai][bj][m][1];
                    if (tok[mm] >= 0) {
                        if constexpr (FINAL) { *(f32x4*)(out + off + bj * HALF) = h0; *(f32x4*)(out + off + bj * HALF + 4) = h1; }
                        else { u32x4 o; o.x = cvt_pk_bf16(h0[0], h0[1]); o.y = cvt_pk_bf16(h0[2], h0[3]); o.z = cvt_pk_bf16(h1[0], h1[1]); o.w = cvt_pk_bf16(h1[2], h1[3]); *(u32x4*)(H + off + bj * HALF) = o; } } } }
          }
    }
};
template <bool IN_F32> struct EpiResid {
    static constexpr bool PERM = true, ALIGN = true;
    const void* Hin; bf16_t* Hout; const float* gate;
    __device__ __forceinline__ void operator()(const Acc& acc, const Unit& u, int wr, int wc, int fr_, int fq_) const {
        int ln_ = fr_ | (fq_ << 4); asm volatile("" : "+v"(ln_)); const int fr = ln_ & 15, fq = ln_ >> 4;
        const int b = u.pm >> 4; const int col0 = u.pn * BM + wc * 32 + 8 * fq; const float* gb = gate + (size_t)b * 6144 + col0;
        f32x4 gv[2][2];
#pragma unroll
        for (int bj = 0; bj < 2; ++bj)
#pragma unroll
            for (int n = 0; n < 2; ++n) gv[bj][n] = *(const f32x4*)(gb + bj * HALF + 4 * n);
#pragma unroll
        for (int ai = 0; ai < 2; ++ai)
#pragma unroll
          for (int mp = 0; mp < 4; mp += 2) {
            f32x4 hh[2][2][2];
#pragma unroll
            for (int mm = 0; mm < 2; ++mm) { const size_t off = (size_t)(u.pm * BM + ai * HALF + wr * 64 + (mp + mm) * 16 + fr) * DM + col0;
#pragma unroll
                for (int bj = 0; bj < 2; ++bj) {
                    if constexpr (IN_F32) { hh[mm][bj][0] = *(const f32x4*)((const float*)Hin + off + bj * HALF); hh[mm][bj][1] = *(const f32x4*)((const float*)Hin + off + bj * HALF + 4); }
                    else { const u32x4 w = *(const u32x4*)((const bf16_t*)Hin + off + bj * HALF); hh[mm][bj][0] = (f32x4){bf_lo(w.x), bf_hi(w.x), bf_lo(w.y), bf_hi(w.y)}; hh[mm][bj][1] = (f32x4){bf_lo(w.z), bf_hi(w.z), bf_lo(w.w), bf_hi(w.w)}; } } }
#pragma unroll
            for (int mm = 0; mm < 2; ++mm) { const int m = mp + mm; const size_t off = (size_t)(u.pm * BM + ai * HALF + wr * 64 + m * 16 + fr) * DM + col0;
#pragma unroll
                for (int bj = 0; bj < 2; ++bj) { const f32x4 h0 = hh[mm][bj][0] + gv[bj][0] * acc[ai][bj][m][0], h1 = hh[mm][bj][1] + gv[bj][1] * acc[ai][bj][m][1];
                    u32x4 o; o.x = cvt_pk_bf16(h0[0], h0[1]); o.y = cvt_pk_bf16(h0[2], h0[3]); o.z = cvt_pk_bf16(h1[0], h1[1]); o.w = cvt_pk_bf16(h1[2], h1[3]);
                    *(u32x4*)(Hout + off + bj * HALF) = o; } }
          }
    }
};
struct EpiQKV {
    static constexpr bool PERM = true, ALIGN = true;
    bf16_t *Q, *Kb, *Vb, *P; const float *qg, *kg;
    __device__ __forceinline__ void operator()(const Acc& acc, const Unit& u, int wr, int wc, int fr_, int fq_) const {
        int ln_ = fr_ | (fq_ << 4); asm volatile("" : "+v"(ln_)); const int fr = ln_ & 15, fq = ln_ >> 4;
        const int pn = u.pn; const bool isctx = u.pm >= 128;
        const int rloc0 = wr * 64 + fr;
        if (pn >= 3) {
#pragma unroll
            for (int ai = 0; ai < 2; ++ai)
#pragma unroll
                for (int m = 0; m < 4; ++m) { bf16_t* rowp = P + (size_t)(u.pm * BM + rloc0 + ai * HALF + m * 16) * 512 + (pn - 3) * BM + wc * 32 + 8 * fq;
#pragma unroll
                    for (int bj = 0; bj < 2; ++bj) { const f32x4 v0 = acc[ai][bj][m][0], v1 = acc[ai][bj][m][1];
                        u32x4 w; w.x = cvt_pk_bf16(v0[0], v0[1]); w.y = cvt_pk_bf16(v0[2], v0[3]); w.z = cvt_pk_bf16(v1[0], v1[1]); w.w = cvt_pk_bf16(v1[2], v1[3]);
                        *(u32x4*)(rowp + bj * HALF) = w; } }
            return;
        }
        if (pn == 2 && wc >= 2) {
            const int vh = wc - 2;
#pragma unroll
            for (int ai = 0; ai < 2; ++ai)
#pragma unroll
                for (int m = 0; m < 4; ++m) { const int rl = rloc0 + ai * HALF + m * 16; int b, krow;
                    if (isctx) { const int cr = (u.pm - 128) * BM + rl; b = cr >> 8; krow = cr & 255; } else { const int mt = u.pm * BM + rl; b = mt >> 12; krow = CTX + (mt & 4095); }
                    bf16_t* rowp = Vb + ((size_t)(b * 2 + vh) * NKV + krow) * 64 + 8 * fq;
#pragma unroll
                    for (int bj = 0; bj < 2; ++bj) { const f32x4 v0 = acc[ai][bj][m][0], v1 = acc[ai][bj][m][1];
                        u32x4 w; w.x = cvt_pk_bf16(v0[0], v0[1]); w.y = cvt_pk_bf16(v0[2], v0[3]); w.z = cvt_pk_bf16(v1[0], v1[1]); w.w = cvt_pk_bf16(v1[2], v1[3]);
                        *(u32x4*)(rowp + bj * 32) = w; } }
            return;
        }
        const bool isq = pn < 2; const int head = isq ? pn * 4 + wc : wc;
        const float* gsrc = (isq ? qg : kg) + 32 * (fq >> 1) + 8 * (fq & 1);
        float g1[8], g2[8], inv[8];
#pragma unroll
        for (int j = 0; j < 8; ++j) { g1[j] = gsrc[j]; g2[j] = gsrc[16 + j];
            inv[j] = __builtin_amdgcn_exp2f(-(float)(8 * (fq & 1) + j) * (13.287712379549449f / 16.0f)) * 0.15915494309189535f; }
        const float osc = isq ? C2 : 1.0f;
#pragma unroll
        for (int ai = 0; ai < 2; ++ai)
#pragma unroll
            for (int m = 0; m < 4; ++m) {
                const int rl = rloc0 + ai * HALF + m * 16;
                float x1[8], x2[8];
#pragma unroll
                for (int n = 0; n < 2; ++n)
#pragma unroll
                    for (int j = 0; j < 4; ++j) { x1[n * 4 + j] = acc[ai][0][m][n][j]; x2[n * 4 + j] = acc[ai][1][m][n][j]; }
                float ss = 0.f;
#pragma unroll
                for (int j = 0; j < 8; ++j) ss += x1[j] * x1[j] + x2[j] * x2[j];
                ss += __shfl_xor(ss, 16); ss += __shfl_xor(ss, 32);
                const float rstd = __builtin_amdgcn_rsqf(ss * (1.0f / 64.0f) + EPS) * osc;
                int b, krow, mt = 0; float pos = 0.f;
                if (isctx) { const int cr = (u.pm - 128) * BM + rl; b = cr >> 8; krow = cr & 255; }
                else { mt = u.pm * BM + rl; b = mt >> 12; const int t = mt & 4095; krow = CTX + t; pos = (float)((fq >> 1) ? (t & 63) : (t >> 6)); }
                float o1[8], o2[8];
#pragma unroll
                for (int j = 0; j < 8; ++j) { const float y1 = x1[j] * rstd * g1[j], y2 = x2[j] * rstd * g2[j];
                    if (isctx) { o1[j] = y1; o2[j] = y2; }
                    else { const float rev = pos * inv[j]; const float cs = __builtin_amdgcn_cosf(rev), sn = __builtin_amdgcn_sinf(rev);
                        o1[j] = y1 * cs - y2 * sn; o2[j] = y2 * cs + y1 * sn; } }
                bf16_t* rowp = isq ? (Q + (size_t)mt * 512 + head * 64 + 8 * fq) : (Kb + ((size_t)(b * 2 + head) * NKV + krow) * 64 + 8 * fq);
                u32x4 w; w.x = cvt_pk_bf16(o1[0], o1[1]); w.y = cvt_pk_bf16(o1[2], o1[3]); w.z = cvt_pk_bf16(o1[4], o1[5]); w.w = cvt_pk_bf16(o1[6], o1[7]);
                *(u32x4*)rowp = w;
                w.x = cvt_pk_bf16(o2[0], o2[1]); w.y = cvt_pk_bf16(o2[2], o2[3]); w.z = cvt_pk_bf16(o2[4], o2[5]); w.w = cvt_pk_bf16(o2[6], o2[7]);
                *(u32x4*)(rowp + 32) = w;
            }
    }
};
}

namespace attn_body {
constexpr int NW = 8, QBLK = 32, QB = QBLK * NW, KVBLK = 64, NT = NKV / KVBLK;
constexpr int QP = 512, KP = 64, OP = 1024;
static_assert(NT % 2 == 0 && NT >= 8, "tile count");
__device__ __forceinline__ int crow(int r, int hi) { return (r & 3) + 8 * (r >> 2) + 4 * hi; }
#define SBAR() __builtin_amdgcn_sched_barrier(0)
constexpr int NSLOT = 3, SLOTB = 8192;
constexpr int LDS_K = 0, LDS_V = NSLOT * SLOTB, LDS_WS = 2 * NSLOT * SLOTB, LDS_OST = LDS_WS + NW * 64 * 4, ATT_LDS_BYTES = LDS_OST + NW * 4096;
__device__ __forceinline__ void glds16(const void* gsrc, unsigned lds_dst) { unsigned keep;
    asm volatile("s_mov_b32 %0, m0\n\ts_mov_b32 m0, %2\n\ts_nop 0\n\tglobal_load_lds_dwordx4 %1, off\n\ts_mov_b32 m0, %0" : "=&s"(keep) : "v"(gsrc), "s"(lds_dst) : "memory"); }
__device__ __forceinline__ float max3f(float a, float b, float c) { float r; asm("v_max3_f32 %0, %1, %2, %3" : "=v"(r) : "v"(a), "v"(b), "v"(c)); return r; }
__device__ __forceinline__ float max2f(float a, float b) { float r; asm("v_max_f32_e32 %0, %1, %2" : "=v"(r) : "v"(a), "v"(b)); return r; }
__device__ __forceinline__ float fadd_s(float a, float b) { float r; asm("v_add_f32_e32 %0, %1, %2" : "=v"(r) : "v"(a), "v"(b)); return r; }
__device__ __forceinline__ float fsub_s(float a, float b) { float r; asm("v_sub_f32_e32 %0, %1, %2" : "=v"(r) : "v"(a), "v"(b)); return r; }
typedef __bf16 bf16x2_t __attribute__((ext_vector_type(2)));
__device__ __forceinline__ unsigned cvtpk_s(float lo, float hi) { f32x2 v = {lo, hi}; bf16x2_t b = __builtin_convertvector(v, bf16x2_t); return __builtin_bit_cast(unsigned, b); }
#define WAIT_BAR(N) asm volatile("s_waitcnt vmcnt(" #N ") lgkmcnt(0)\n\ts_barrier" ::: "memory")
__device__ __forceinline__ void qkt(f32x16& p0, f32x16& p1, const char* Kslot, const bf16x8* qr, const f32x16& negm, int r32, int hi) {
    const char* kb = Kslot + hi * 1024 + r32 * 16;
#pragma unroll
    for (int d0 = 0; d0 < 4; ++d0) {
        const bf16x8 b0 = *reinterpret_cast<const bf16x8*>(kb + d0 * 2048);
        const bf16x8 b1 = *reinterpret_cast<const bf16x8*>(kb + d0 * 2048 + 512);
        if (d0 == 0) { p0 = __builtin_amdgcn_mfma_f32_32x32x16_bf16(b0, qr[0], negm, 0, 0, 0); p1 = __builtin_amdgcn_mfma_f32_32x32x16_bf16(b1, qr[0], negm, 0, 0, 0); }
        else { p0 = __builtin_amdgcn_mfma_f32_32x32x16_bf16(b0, qr[d0], p0, 0, 0, 0); p1 = __builtin_amdgcn_mfma_f32_32x32x16_bf16(b1, qr[d0], p1, 0, 0, 0); } }
}
typedef __attribute__((address_space(3))) const char* lds_cptr;
typedef short v4i16_t __attribute__((ext_vector_type(4)));
__device__ __forceinline__ void kload8(bf16x8* kf, lds_cptr kp) {
    kf[0] = *(const LAS bf16x8*)(kp);        kf[1] = *(const LAS bf16x8*)(kp + 512);
    kf[2] = *(const LAS bf16x8*)(kp + 2048); kf[3] = *(const LAS bf16x8*)(kp + 2560);
    kf[4] = *(const LAS bf16x8*)(kp + 4096); kf[5] = *(const LAS bf16x8*)(kp + 4608);
    kf[6] = *(const LAS bf16x8*)(kp + 6144); kf[7] = *(const LAS bf16x8*)(kp + 6656);
}
__device__ __forceinline__ void kload2(bf16x8* kf, lds_cptr kp, int j) { kf[2 * j] = *(const LAS bf16x8*)(kp + j * 2048); kf[2 * j + 1] = *(const LAS bf16x8*)(kp + j * 2048 + 512); }
__device__ __forceinline__ s16x4 vtr(lds_cptr p) { return __builtin_bit_cast(s16x4, __builtin_amdgcn_ds_read_tr16_b64_v4i16((LAS v4i16_t*)p)); }
__device__ __forceinline__ float rowmax(const f32x16& p0, const f32x16& p1) {
    float a = max3f(p0[0], p0[1], p1[0]), b = max3f(p0[2], p0[3], p1[1]); a = max3f(a, p1[2], p1[3]);
#pragma unroll
    for (int r = 4; r < 16; r += 4) { a = max3f(a, p0[r], p0[r + 1]); b = max3f(b, p0[r + 2], p0[r + 3]); a = max3f(a, p1[r], p1[r + 1]); b = max3f(b, p1[r + 2], p1[r + 3]); }
    const float m = max2f(a, b);
    auto rr = __builtin_amdgcn_permlane32_swap(__float_as_uint(m), __float_as_uint(m), false, false);
    return max2f(__uint_as_float(rr[0]), __uint_as_float(rr[1]));
}
__device__ __forceinline__ void pv(f32x16* o, int vb, bf16x8 pa0, bf16x8 pa1, bf16x8 pa2, bf16x8 pa3) {
#pragma unroll
    for (int d0 = 0; d0 < 2; ++d0) { s16x4 lo[4], hi[4];
#pragma unroll
        for (int ks = 0; ks < 4; ++ks) {
            asm volatile("ds_read_b64_tr_b16 %0,%1 offset:%c2" : "=&v"(lo[ks]) : "v"(vb), "i"(d0 * 4096 + ks * 1024) : "memory");
            asm volatile("ds_read_b64_tr_b16 %0,%1 offset:%c2" : "=&v"(hi[ks]) : "v"(vb), "i"(d0 * 4096 + ks * 1024 + 512) : "memory"); }
        asm volatile("s_waitcnt lgkmcnt(0)" ::: "memory"); SBAR();
#define PK(k) (bf16x8){lo[k][0], lo[k][1], lo[k][2], lo[k][3], hi[k][0], hi[k][1], hi[k][2], hi[k][3]}
        o[d0] = __builtin_amdgcn_mfma_f32_32x32x16_bf16(pa0, PK(0), o[d0], 0, 0, 0);
        o[d0] = __builtin_amdgcn_mfma_f32_32x32x16_bf16(pa1, PK(1), o[d0], 0, 0, 0);
        o[d0] = __builtin_amdgcn_mfma_f32_32x32x16_bf16(pa2, PK(2), o[d0], 0, 0, 0);
        o[d0] = __builtin_amdgcn_mfma_f32_32x32x16_bf16(pa3, PK(3), o[d0], 0, 0, 0);
#undef PK
    }
}
template <int THRL> __device__ __forceinline__ void attn_unit(int b, int h, int qb, const bf16_t* Q, const bf16_t* __restrict__ K, const bf16_t* __restrict__ V, bf16_t* O, char* shm, float ref) {
    const int tid = opaque_tid(), lane = tid & 63, r32 = lane & 31, hi = lane >> 5; const int wid = __builtin_amdgcn_readfirstlane(tid >> 6);
    const long rowq = (long)b * SEQ + qb * QB + wid * QBLK;
    const bf16_t* Qw = Q + rowq * QP + h * 64;
    const bf16_t* Kh = K + (long)(b * 2 + (h >> 2)) * NKV * KP, *Vh = V + (long)(b * 2 + (h >> 2)) * NKV * KP;
    const unsigned lds0 = (unsigned)(uintptr_t)shm;
    float* wsf = (float*)(shm + LDS_WS) + wid * 64;
    const bf16_t* ksrc = Kh + (long)lane * KP + wid * 8;
    const bf16_t* vsrc = Vh + (long)(16 * (wid & 3) + (lane >> 2)) * KP + (wid >> 2) * 32 + (lane & 3) * 8;
    const unsigned kdst = lds0 + LDS_K + wid * 1024, vdst = lds0 + LDS_V + wid * 1024;
#define DMA_K(t, slot) glds16(ksrc + (long)(t) * KVBLK * KP, (unsigned)__builtin_amdgcn_readfirstlane(kdst + (slot)))
#define DMA_V(t, slot) glds16(vsrc + (long)(t) * KVBLK * KP, (unsigned)__builtin_amdgcn_readfirstlane(vdst + (slot)))
    const int vb0 = (int)(lds0 + LDS_V) + ((lane >> 4) & 1) * 32 + (lane & 3) * 8 + (4 * hi + ((lane & 15) >> 2)) * 64;
    const char* Kbase = shm + LDS_K; bf16x8 kf[8];
    const lds_cptr shm3 = (lds_cptr)shm; const lds_cptr kp0 = shm3 + LDS_K + hi * 1024 + r32 * 16; const lds_cptr vp0 = shm3 + LDS_V + ((lane >> 4) & 1) * 32 + (lane & 3) * 8 + (4 * hi + ((lane & 15) >> 2)) * 64;
    DMA_K(0, 0); DMA_V(0, 0); DMA_K(1, SLOTB);
    bf16x8 qr[4];
#pragma unroll
    for (int d0 = 0; d0 < 4; ++d0) qr[d0] = *reinterpret_cast<const bf16x8*>(&Qw[(long)r32 * QP + d0 * 16 + hi * 8]);
    float l_reg = 0.f; f32x16 o[2]; o[0] = f32x16{}; o[1] = f32x16{}; f32x16 negm;
#pragma unroll
    for (int r = 0; r < 16; ++r) negm[r] = -ref;
    asm volatile("" : "+v"(negm));
#define START(P0, P1) do { _Pragma("unroll") for (int r = 0; r < 16; ++r) P0[r] = __builtin_amdgcn_exp2f(P0[r]); } while (0)
#define RESC() do { } while (0)
    f32x16 pA0, pA1, pB0, pB1;
    int sl_prev = 0, sl_cur = 0, sl_next = SLOTB;
#define ROT() do { sl_prev = sl_cur; sl_cur = sl_next; sl_next = (sl_next == (NSLOT - 1) * SLOTB) ? 0 : sl_next + SLOTB; } while (0)
    DMA_K(2, 2 * SLOTB);
    WAIT_BAR(3);
    qkt(pA0, pA1, Kbase, qr, negm, r32, hi); asm volatile("s_nop 15\n\ts_nop 7" : "+v"(pA0), "+v"(pA1));
    START(pA0, pA1);
    _Pragma("unroll") for (int r = 0; r < 16; ++r) pA1[r] = __builtin_amdgcn_exp2f(pA1[r]);
    WAIT_BAR(0);
    DMA_K(3, 0); DMA_V(1, SLOTB);
    ROT();
    kload8(kf, kp0 + sl_cur);
    WAIT_BAR(2);
    s16x4 vlo[8], vhi[8]; u32x4 pw0, pw1, pw2, pw3;
#define PKW(P, B) cvtpk_s(P[B], P[B + 1])
#define PAF(k) __builtin_bit_cast(bf16x8, pw##k)
#define VFR(i) (bf16x8){vlo[i][0], vlo[i][1], vlo[i][2], vlo[i][3], vhi[i][0], vhi[i][1], vhi[i][2], vhi[i][3]}
#define PIN(x) asm volatile("" : "+v"(x))
#define MX3(a, b, c) __builtin_fmaxf(__builtin_fmaxf((a), (b)), (c))
#define GAPA(MF, A0, A1, A2, A3, W0, W1, PW) do { MF; sacc += A0; sacc += A1; sacc += A2; sacc += A3; PIN(sacc); W0; W1; PIN(PW); SBAR(); } while (0)
#define EX(v) __builtin_amdgcn_exp2f(v)
#define GAPB(MF, X, B) do { MF; X[B] = EX(X[B]); X[B + 1] = EX(X[B + 1]); X[B + 2] = EX(X[B + 2]); X[B + 3] = EX(X[B + 3]); PIN(X); SBAR(); } while (0)
#define VRD(i) do { vlo[i] = vtr(vp_ + (((i) >> 2) * 4096 + ((i) & 3) * 1024)); vhi[i] = vtr(vp_ + (((i) >> 2) * 4096 + ((i) & 3) * 1024 + 512)); } while (0)
#define KRD(G, j) do { if (G) { kload2(kf, kp0 + sl_next, j); SBAR(); } } while (0)
#define STEP(C0, C1, P0, P1, t, GK, GV, GL) do { SBAR(); \
    const lds_cptr vp_ = vp0 + sl_prev; \
    VRD(0); SBAR(); float sacc = (P0[0] + P0[1]); \
    GAPA(C0 = __builtin_amdgcn_mfma_f32_32x32x16_bf16(kf[0], qr[0], negm, 0, 0, 0), P0[2], P0[3], P0[4], P0[5],     pw0[0] = PKW(P0, 0), pw0[1] = PKW(P0, 2), pw0); \
    VRD(4); SBAR(); GAPA(C1 = __builtin_amdgcn_mfma_f32_32x32x16_bf16(kf[1], qr[0], negm, 0, 0, 0), P0[6], P0[7], P0[8], P0[9],     pw0[2] = PKW(P0, 4), pw0[3] = PKW(P0, 6), pw0); \
    VRD(1); SBAR(); GAPA(C0 = __builtin_amdgcn_mfma_f32_32x32x16_bf16(kf[2], qr[1], C0, 0, 0, 0),   P0[10], P0[11], P0[12], P0[13], pw1[0] = PKW(P0, 8), pw1[1] = PKW(P0, 10), pw1); \
    VRD(5); SBAR(); GAPA(C1 = __builtin_amdgcn_mfma_f32_32x32x16_bf16(kf[3], qr[1], C1, 0, 0, 0),   P0[14], P0[15], P1[0], P1[1],   pw1[2] = PKW(P0, 12), pw1[3] = PKW(P0, 14), pw1); \
    VRD(2); SBAR(); GAPA(C0 = __builtin_amdgcn_mfma_f32_32x32x16_bf16(kf[4], qr[2], C0, 0, 0, 0),   P1[2], P1[3], P1[4], P1[5],     pw2[0] = PKW(P1, 0), pw2[1] = PKW(P1, 2), pw2); \
    VRD(6); SBAR(); GAPA(C1 = __builtin_amdgcn_mfma_f32_32x32x16_bf16(kf[5], qr[2], C1, 0, 0, 0),   P1[6], P1[7], P1[8], P1[9],     pw2[2] = PKW(P1, 4), pw2[3] = PKW(P1, 6), pw2); \
    VRD(3); SBAR(); GAPA(C0 = __builtin_amdgcn_mfma_f32_32x32x16_bf16(kf[6], qr[3], C0, 0, 0, 0),   P1[10], P1[11], P1[12], P1[13], pw3[0] = PKW(P1, 8), pw3[1] = PKW(P1, 10), pw3); \
    VRD(7); SBAR(); GAPA(C1 = __builtin_amdgcn_mfma_f32_32x32x16_bf16(kf[7], qr[3], C1, 0, 0, 0),   P1[14], P1[15], 0.f, 0.f,       pw3[2] = PKW(P1, 12), pw3[3] = PKW(P1, 14), pw3); \
    l_reg += sacc; \
    if (GK) { DMA_K((t) + 3, sl_cur); } if (GV) { DMA_V((t) + 1, sl_next); } \
    SBAR(); \
    GAPB(o[0] = __builtin_amdgcn_mfma_f32_32x32x16_bf16(PAF(0), VFR(0), o[0], 0, 0, 0), C0, 0); \
    GAPB(o[1] = __builtin_amdgcn_mfma_f32_32x32x16_bf16(PAF(0), VFR(4), o[1], 0, 0, 0), C0, 4); \
    KRD(GL, 0); GAPB(o[0] = __builtin_amdgcn_mfma_f32_32x32x16_bf16(PAF(1), VFR(1), o[0], 0, 0, 0), C0, 8); \
    KRD(GL, 1); GAPB(o[1] = __builtin_amdgcn_mfma_f32_32x32x16_bf16(PAF(1), VFR(5), o[1], 0, 0, 0), C0, 12); \
    KRD(GL, 2); GAPB(o[0] = __builtin_amdgcn_mfma_f32_32x32x16_bf16(PAF(2), VFR(2), o[0], 0, 0, 0), C1, 0); \
    KRD(GL, 3); GAPB(o[1] = __builtin_amdgcn_mfma_f32_32x32x16_bf16(PAF(2), VFR(6), o[1], 0, 0, 0), C1, 4); \
    GAPB(o[0] = __builtin_amdgcn_mfma_f32_32x32x16_bf16(PAF(3), VFR(3), o[0], 0, 0, 0), C1, 8); \
    GAPB(o[1] = __builtin_amdgcn_mfma_f32_32x32x16_bf16(PAF(3), VFR(7), o[1], 0, 0, 0), C1, 12); \
    } while (0)
    int t = 1;
    for (; t + 5 < NT; t += 2) {
        STEP(pB0, pB1, pA0, pA1, t, true, true, true);     WAIT_BAR(2); RESC(); ROT();
        STEP(pA0, pA1, pB0, pB1, t + 1, true, true, true); WAIT_BAR(2); RESC(); ROT();
    }
#define ENDW(tt) do { if ((tt) + 3 < NT) { WAIT_BAR(2); } else if ((tt) + 2 < NT) { WAIT_BAR(1); } else { WAIT_BAR(0); } } while (0)
    for (; t + 1 < NT; t += 2) {
        STEP(pB0, pB1, pA0, pA1, t, (t + 3 < NT), (t + 1 < NT), (t + 1 < NT));         ENDW(t);     RESC(); ROT();
        STEP(pA0, pA1, pB0, pB1, t + 1, (t + 4 < NT), (t + 2 < NT), (t + 2 < NT));     ENDW(t + 1); RESC(); ROT();
    }
    STEP(pB0, pB1, pA0, pA1, NT - 1, false, false, false); RESC();
    { float sacc = pB0[0] + pB0[1]; _Pragma("unroll") for (int r = 2; r < 16; ++r) sacc += pB0[r]; _Pragma("unroll") for (int r = 0; r < 16; ++r) sacc += pB1[r]; l_reg += sacc;
      pw0 = (u32x4){PKW(pB0, 0), PKW(pB0, 2), PKW(pB0, 4), PKW(pB0, 6)}; pw1 = (u32x4){PKW(pB0, 8), PKW(pB0, 10), PKW(pB0, 12), PKW(pB0, 14)}; pw2 = (u32x4){PKW(pB1, 0), PKW(pB1, 2), PKW(pB1, 4), PKW(pB1, 6)}; pw3 = (u32x4){PKW(pB1, 8), PKW(pB1, 10), PKW(pB1, 12), PKW(pB1, 14)};
      SBAR(); pv(o, vb0 + sl_cur, PAF(0), PAF(1), PAF(2), PAF(3)); }
#undef PKW
#undef PAF
#undef VFR
#undef PIN
#undef MX3
#undef GAPA
#undef GAPB
#undef EX
#undef VRD
#undef KRD
#undef STEP
#undef ENDW
    { auto rr = __builtin_amdgcn_permlane32_swap(__float_as_uint(l_reg), __float_as_uint(l_reg), false, false); l_reg = __uint_as_float(rr[0]) + __uint_as_float(rr[1]); }
    if (hi == 0) wsf[32 + r32] = l_reg; asm volatile("s_waitcnt lgkmcnt(0)" ::: "memory");
    float rli[16];
#pragma unroll
    for (int r = 0; r < 16; ++r) rli[r] = __builtin_amdgcn_rcpf(wsf[32 + crow(r, hi)]);
    bf16_t* Ow = O + rowq * OP + h * 64;
    { bf16_t* stg = (bf16_t*)(shm + LDS_OST) + wid * 2048;
#pragma unroll
      for (int r = 0; r < 16; ++r) { const int orow = crow(r, hi);
#pragma unroll
        for (int d0 = 0; d0 < 2; ++d0) stg[orow * 64 + d0 * 32 + r32] = (bf16_t)(cvtpk_s(o[d0][r] * rli[r], 0.f) & 0xffffu); }
      asm volatile("s_waitcnt lgkmcnt(0)" ::: "memory");
#pragma unroll
      for (int i = 0; i < 4; ++i) { const int row = i * 8 + (lane >> 3), ch = lane & 7; const u32x4 v = *(const u32x4*)(stg + row * 64 + ch * 8); *(u32x4*)(Ow + (long)row * OP + ch * 8) = v; } }
    asm volatile("s_waitcnt lgkmcnt(0)\n\ts_barrier" ::: "memory");
#undef DMA_K
#undef DMA_V
#undef START
#undef RESC
#undef ROT
}
#undef SBAR
#undef WAIT_BAR
}

#define LDS_WAIT() asm volatile("s_waitcnt lgkmcnt(0)" ::: "memory")
constexpr int TP_OFF = LDSCTL_OFF + 512;
struct Args { const float* in[27]; float* out; unsigned char* ws; };
enum { I_X = 0, I_C, I_CTX, I_CCTX, I_MODW, I_MODB, I_N1G, I_N2G, I_EWIN, I_QG, I_KG, I_POOLW, I_POOLS, I_EWOUT, I_OWIN, I_SGG, I_SGW, I_SGB, I_CONVW, I_OWOUT,
       I_RGW, I_RGB, I_REW, I_REB, I_WG, I_WU, I_WD };

__device__ __forceinline__ int map_in0(int n) {
    if (n < 640) { const int hd = n >> 6, e = n & 63; const int s = e >> 5, r = e & 31, bj = r >> 4, i = r & 15, j = 16 * s + i;
        const int pn = (hd < 8) ? (hd >> 2) : 2, wc = (hd < 8) ? (hd & 3) : (hd - 8); return 256 * pn + 128 * bj + 32 * wc + j; }
    if (n < 768) { const int vh = (n - 640) >> 6, e = n & 63, bj = e >> 5, j = e & 31; return 512 + 128 * bj + 32 * (2 + vh) + j; }
    return n;
}
struct TrItem { const float* W; int K, N; bf16_t* WT; int kind, off, item; };
__device__ __forceinline__ void tr_load(const TrItem& t, int lane, float (&tv)[32]) {
    const int nblk = t.N / 32, kb = t.item / nblk, nb = t.item % nblk, k0 = 64 * kb, n0 = 32 * nb;
#pragma unroll
    for (int i = 0; i < 32; ++i) tv[i] = t.W[(size_t)(k0 + 2 * i + (lane >> 5)) * t.N + n0 + (lane & 31)];
}
__device__ __forceinline__ void tr_store(const TrItem& t, int lane, const float (&tv)[32], LAS float* scr) {
    const int nblk = t.N / 32, kb = t.item / nblk, nb = t.item % nblk, k0 = 64 * kb, n0 = 32 * nb;
#pragma unroll
    for (int i = 0; i < 32; ++i) scr[(2 * i + (lane >> 5)) * 33 + (lane & 31)] = tv[i];
    LDS_WAIT(); asm volatile("" ::: "memory");
    const int c = lane & 7;
#pragma unroll
    for (int j = 0; j < 4; ++j) { const int n = (lane >> 3) + 8 * j; const LAS float* s = scr + (8 * c) * 33 + n; const int ng = n0 + n;
        const int dst = (t.kind == 1) ? map_in0(ng) : (t.kind == 2) ? t.off + 256 * (ng >> 7) + (ng & 127) : t.off + ng;
        u32x4 o; o.x = cvt_pk_bf16(s[0 * 33], s[1 * 33]); o.y = cvt_pk_bf16(s[2 * 33], s[3 * 33]); o.z = cvt_pk_bf16(s[4 * 33], s[5 * 33]); o.w = cvt_pk_bf16(s[6 * 33], s[7 * 33]);
        *(u32x4*)(t.WT + (size_t)dst * t.K + k0 + 8 * c) = o; }
    LDS_WAIT(); asm volatile("" ::: "memory");
}
__device__ __forceinline__ void p0_prologue(const Args& a, LAS unsigned char* lds, int tid, int lane, int wave, int vcu, int G) {
    unsigned char* ws = a.ws;
    {
        LAS float* sc = (LAS float*)lds;
        LAS float* red = (LAS float*)(lds + 36864);
        for (int idx = tid; idx < 9 * 1024; idx += 512) { const int r = idx >> 10, k = idx & 1023; const float v = (r < 8) ? a.in[I_C][r * 1024 + k] : a.in[I_CCTX][k]; sc[idx] = silu_f(v); }
        __syncthreads();
        float* MOD = (float*)(ws + WS_MOD);
        for (int unit = blockIdx.x; unit < 256; unit += G) {
            const int l = unit >> 7, n0 = (unit & 127) * 48;
            const int ks = lane / 12, c4 = lane % 12; const bool act = lane < 60;
            const float* Wm = a.in[I_MODW] + (size_t)l * 1024 * 6144 + n0 + 4 * c4;
            f32x4 acc4[9];
#pragma unroll
            for (int r = 0; r < 9; ++r) acc4[r] = (f32x4){0.f, 0.f, 0.f, 0.f};
#pragma unroll 1
            for (int it0 = 0; it0 < 26; it0 += 13) {
                f32x4 wv[13];
#pragma unroll
                for (int i = 0; i < 13; ++i) { const int kr = 5 * (it0 + i) + ks; const bool ok = act && kr < 128;
                    wv[i] = ok ? *(const f32x4*)(Wm + (size_t)(wave * 128 + kr) * 6144) : (f32x4){0.f, 0.f, 0.f, 0.f}; }
#pragma unroll
                for (int i = 0; i < 13; ++i) { const int kr = 5 * (it0 + i) + ks; const int kk = wave * 128 + (kr < 128 ? kr : 127);
#pragma unroll
                    for (int r = 0; r < 9; ++r) acc4[r] += sc[r * 1024 + kk] * wv[i]; }
            }
            if (act) {
#pragma unroll
                for (int r = 0; r < 9; ++r) *(LAS f32x4*)(red + ((wave * 5 + ks) * 9 + r) * 48 + 4 * c4) = acc4[r]; }
            __syncthreads();
            for (int idx = tid; idx < 9 * 48; idx += 512) { const int r = idx / 48, cl = idx % 48; float sum = a.in[I_MODB][l * 6144 + n0 + cl];
#pragma unroll 8
                for (int w = 0; w < 40; ++w) sum += red[(w * 9 + r) * 48 + cl];
                MOD[(size_t)(l * 9 + r) * 6144 + n0 + cl] = sum; }
            __syncthreads();
        }
    }
}
__device__ __forceinline__ void convert_weights(const Args& a, LAS unsigned char* lds, int set, int lane, int wave, int worker, int nworkers) {
    unsigned char* ws = a.ws;
    LAS float* scr = (LAS float*)(lds + wave * 16384);
    constexpr int I0 = 16 * 40, I1 = 16 * 32, I2 = 16 * 80, I3 = 16 * 32, IGU = 128, IDN = 128, IPL = 8, HL = 16 * 128;
    constexpr int E0 = I0, E1 = E0 + I1, E2 = E1 + I2, E3 = E2 + I3, E4 = E3 + 32 * IGU, E5 = E4 + 32 * IGU, E6 = E5 + 32 * IDN, E7 = E6 + 4 * IPL;
    constexpr int N1A = E3 - E0, N1 = N1A + 3 * HL + 4 * IPL, N2 = 3 * HL;
    const int nitems = (set == 0) ? E0 : (set == 1) ? N1 : N2;
    auto remap = [&](int v) -> int {
        if (set == 0) return v;
        if (set == 1) { if (v < N1A) return E0 + v; v -= N1A; if (v < HL) return E3 + v; v -= HL; if (v < HL) return E4 + v; v -= HL; if (v < HL) return E5 + v; v -= HL; return E6 + v; }
        if (v < HL) return E3 + HL + v; v -= HL; if (v < HL) return E4 + HL + v; v -= HL; return E5 + HL + v; };
    auto mk = [&](int v) -> TrItem { const int it = remap(v); TrItem t;
        if (it < E0) t = TrItem{a.in[I_EWIN], 1024, 1280, (bf16_t*)(ws + WS_WIN0), 1, 0, it};
        else if (it < E1) t = TrItem{a.in[I_EWOUT], 1024, 1024, (bf16_t*)(ws + WS_WOUT0), 0, 0, it - E0};
        else if (it < E2) t = TrItem{a.in[I_OWIN], 1024, 2560, (bf16_t*)(ws + WS_WIN1), 0, 0, it - E1};
        else if (it < E3) t = TrItem{a.in[I_OWOUT], 1024, 1024, (bf16_t*)(ws + WS_WOUT1), 0, 0, it - E2};
        else if (it < E4) { const int r = it - E3, le = r / IGU;
            t = TrItem{a.in[I_WG] + (size_t)le * 1024 * 256, 1024, 256, (bf16_t*)(ws + WS_WGU) + (size_t)(le >> 4) * 8192 * 1024, 2, (le & 15) * 512, r % IGU}; }
        else if (it < E5) { const int r = it - E4, le = r / IGU;
            t = TrItem{a.in[I_WU] + (size_t)le * 1024 * 256, 1024, 256, (bf16_t*)(ws + WS_WGU) + (size_t)(le >> 4) * 8192 * 1024, 2, (le & 15) * 512 + 128, r % IGU}; }
        else if (it < E6) { const int r = it - E5, le = r / IDN;
            t = TrItem{a.in[I_WD] + (size_t)le * 256 * 1024, 256, 1024, (bf16_t*)(ws + WS_WDN) + (size_t)(le >> 4) * 16384 * 256, 0, (le & 15) * 1024, r % IDN}; }
        else { const int r = it - E6, g = r / IPL;
            t = TrItem{a.in[I_POOLW] + (size_t)g * 128 * 128, 128, 128, (bf16_t*)(ws + WS_WPOOL), 0, g * 128, r % IPL}; }
        return t; };
    {   float tvA[32], tvB[32];
        int it = worker; TrItem cur{}; if (it < nitems) { cur = mk(it); tr_load(cur, lane, tvA); }
        for (; it < nitems; it += 2 * nworkers) {
            const int itB = it + nworkers, itC = it + 2 * nworkers; TrItem tb{}, tc{};
            if (itB < nitems) { tb = mk(itB); tr_load(tb, lane, tvB); }
            tr_store(cur, lane, tvA, scr);
            if (itC < nitems) { tc = mk(itC); tr_load(tc, lane, tvA); }
            if (itB < nitems) tr_store(tb, lane, tvB, scr);
            cur = tc;
        }
    }
    if (set == 1) {
        for (int idx = worker * 64 + lane; idx < 4 * 128 * 128; idx += nworkers * 64) { const int x = idx & 15; const int q = (x & 3) + 8 * ((x >> 2) & 1) + 4 * (x >> 3);
            const float v = a.in[I_SGW][(idx & ~15) + q]; ((bf16_t*)(ws + WS_WSG))[idx] = (bf16_t)(cvt_pk_bf16(v, 0.f) & 0xffffu); } }
}

__device__ __forceinline__ void load_vec16(const float* p, int lane, f32x4 (&v)[4]) {
#pragma unroll
    for (int j = 0; j < 2; ++j)
#pragma unroll
        for (int q = 0; q < 2; ++q) v[2 * j + q] = *(const f32x4*)(p + 8 * lane + 512 * j + 4 * q);
}
__device__ __forceinline__ void load_vec16_nt(const float* p, int lane, f32x4 (&v)[4]) {
#pragma unroll
    for (int j = 0; j < 2; ++j)
#pragma unroll
        for (int q = 0; q < 2; ++q) v[2 * j + q] = __builtin_nontemporal_load((const f32x4*)(p + 8 * lane + 512 * j + 4 * q));
}
__device__ __forceinline__ void load_row_bf16(const bf16_t* p, int lane, f32x4 (&v)[4]) {
#pragma unroll
    for (int j = 0; j < 2; ++j) { const u32x4 w = *(const u32x4*)(p + 8 * lane + 512 * j);
        v[2 * j] = (f32x4){bf_lo(w.x), bf_hi(w.x), bf_lo(w.y), bf_hi(w.y)}; v[2 * j + 1] = (f32x4){bf_lo(w.z), bf_hi(w.z), bf_lo(w.w), bf_hi(w.w)}; }
}
__device__ __forceinline__ void store_row_bf16(bf16_t* p, int lane, const f32x4 (&v)[4]) {
#pragma unroll
    for (int j = 0; j < 2; ++j) { u32x4 w; w.x = cvt_pk_bf16(v[2 * j][0], v[2 * j][1]); w.y = cvt_pk_bf16(v[2 * j][2], v[2 * j][3]); w.z = cvt_pk_bf16(v[2 * j + 1][0], v[2 * j + 1][1]); w.w = cvt_pk_bf16(v[2 * j + 1][2], v[2 * j + 1][3]);
        *(u32x4*)(p + 8 * lane + 512 * j) = w; }
}
__device__ __forceinline__ float sumsq16(const f32x4 (&v)[4]) { float s = 0.f;
#pragma unroll
    for (int i = 0; i < 4; ++i) s += (v[i][0] * v[i][0] + v[i][1] * v[i][1]) + (v[i][2] * v[i][2] + v[i][3] * v[i][3]);
    return s; }
__device__ __forceinline__ void load_mod(const float* mod, const float* gain, int l, int r, int cs, int lane, f32x4 (&gm)[4], f32x4 (&sh)[4]) {
    const float* mr = mod + (size_t)(l * 9 + r) * 6144 + cs * 1024; f32x4 g[4], s[4];
    load_vec16(gain + l * 1024, lane, g); load_vec16(mr + 1024, lane, s); load_vec16(mr, lane, sh);
#pragma unroll
    for (int i = 0; i < 4; ++i) gm[i] = g[i] * (1.0f + s[i]);
}
__device__ __forceinline__ void p1_ln_rows(const Args& a, int lane, int gw, int NGW) {
    const float* mod = (const float*)(a.ws + WS_MOD); bf16_t* AB = (bf16_t*)(a.ws + WS_ABUF);
    const int rpw = (MA + NGW - 1) / NGW, m0 = gw * rpw, m1 = (m0 + rpw < MA) ? m0 + rpw : MA;
    int curb = -1; f32x4 gm[4], sh[4];
    for (int mm = m0; mm < m1; mm += 4) {
        f32x4 vv[4][4]; int mr[4];
#pragma unroll
        for (int r = 0; r < 4; ++r) { mr[r] = (mm + r < m1) ? mm + r : mm;
            load_vec16_nt((mr[r] < MT) ? a.in[I_X] + (size_t)mr[r] * 1024 : a.in[I_CTX] + (size_t)(mr[r] - MT) * 1024, lane, vv[r]); }
#pragma unroll
        for (int r = 0; r < 4; ++r) { const int m = mr[r]; if (r && m == mm) break;
            const int b = (m < MT) ? (m >> 12) : 8;
            if (b != curb) { load_mod(mod, a.in[I_N1G], 0, b, 0, lane, gm, sh); curb = b; }
            const float rstd = __builtin_amdgcn_rsqf(wave_sum(sumsq16(vv[r])) * (1.0f / 1024.0f) + EPS);
#pragma unroll
            for (int i = 0; i < 4; ++i) vv[r][i] = vv[r][i] * rstd * gm[i] + sh[i];
            store_row_bf16(AB + (size_t)m * 1024, lane, vv[r]); }
    }
}
template <class T> __device__ __forceinline__ void copy_rows(const T* src, float* dst, int lane, int gw, int NGW) {
    for (int m = gw; m < MT; m += NGW) { f32x4 v[4]; if constexpr (sizeof(T) == 4) load_vec16((const float*)src + (size_t)m * 1024, lane, v); else load_row_bf16((const bf16_t*)src + (size_t)m * 1024, lane, v);
#pragma unroll
        for (int j = 0; j < 2; ++j)
#pragma unroll
            for (int q = 0; q < 2; ++q) *(f32x4*)(dst + (size_t)m * 1024 + 8 * lane + 512 * j + 4 * q) = v[2 * j + q]; }
}

__device__ __forceinline__ void pool_task(int rb, int g, const bf16_t* P, const bf16_t* Wp, const float* pscale, bf16_t* A2, int lane) {
    const int r = lane & 31, hh = lane >> 5;
    const int m0 = rb * 32, b = m0 >> 12, t = (m0 & 4095) + r;
    const int half = 1 << g;
    const int lo = (t - half > 0) ? t - half : 0, hi = (t + half < SEQ) ? t + half : SEQ;
    const float invc = 1.0f / (float)(hi - lo);
    const bf16_t* Pb = P + (size_t)b * SEQ * 512 + g * 128 + 8 * hh;
    float sum[8][8];
#pragma unroll
    for (int s = 0; s < 8; ++s)
#pragma unroll
        for (int j = 0; j < 8; ++j) sum[s][j] = 0.f;
#pragma unroll 2
    for (int d2 = -half; d2 < half; d2 += 2)
#pragma unroll
    for (int dd = 0; dd < 2; ++dd) { const int d = d2 + dd;
        const int tt = t + d; const bool ok = (tt >= 0) && (tt < SEQ); const int tc = ok ? tt : t;
        const float msk = ok ? 1.0f : 0.0f;
#pragma unroll
        for (int s = 0; s < 8; ++s) { const u32x4 w = *(const u32x4*)(Pb + (size_t)tc * 512 + 16 * s);
            sum[s][0] += msk * bf_lo(w.x); sum[s][1] += msk * bf_hi(w.x); sum[s][2] += msk * bf_lo(w.y); sum[s][3] += msk * bf_hi(w.y);
            sum[s][4] += msk * bf_lo(w.z); sum[s][5] += msk * bf_hi(w.z); sum[s][6] += msk * bf_lo(w.w); sum[s][7] += msk * bf_hi(w.w); }
    }
    bf16x8 afrag[8];
#pragma unroll
    for (int s = 0; s < 8; ++s) { const u32x4 w = *(const u32x4*)(Pb + (size_t)t * 512 + 16 * s);
        u32x4 o; o.x = cvt_pk_bf16(sum[s][0] * invc - bf_lo(w.x), sum[s][1] * invc - bf_hi(w.x)); o.y = cvt_pk_bf16(sum[s][2] * invc - bf_lo(w.y), sum[s][3] * invc - bf_hi(w.y));
        o.z = cvt_pk_bf16(sum[s][4] * invc - bf_lo(w.z), sum[s][5] * invc - bf_hi(w.z)); o.w = cvt_pk_bf16(sum[s][6] * invc - bf_lo(w.w), sum[s][7] * invc - bf_hi(w.w));
        afrag[s] = __builtin_bit_cast(bf16x8, o); }
    bf16_t* orow = A2 + (size_t)(m0 + r) * 1024 + 512 + g * 128;
#pragma unroll
    for (int nb = 0; nb < 4; ++nb) {
        f32x16 acc = f32x16{};
#pragma unroll
        for (int s = 0; s < 8; ++s) { const bf16x8 bfr = *(const bf16x8*)(Wp + (size_t)(g * 128 + 32 * nb + r) * 128 + 16 * s + 8 * hh);
            acc = __builtin_amdgcn_mfma_f32_32x32x16_bf16(bfr, afrag[s], acc, 0, 0, 0); }
#pragma unroll
        for (int rg = 0; rg < 4; ++rg) { const int n = 32 * nb + 8 * rg + 4 * hh; const f32x4 ps = *(const f32x4*)(pscale + g * 128 + n);
            u32x2 w; w.x = cvt_pk_bf16(acc[4 * rg] * ps[0], acc[4 * rg + 1] * ps[1]); w.y = cvt_pk_bf16(acc[4 * rg + 2] * ps[2], acc[4 * rg + 3] * ps[3]);
            *(u32x2*)(orow + n) = w; }
    }
}

template <int N, int SZ> __device__ __forceinline__ void halve(float (&v)[SZ], int mask, bool upper) {
#pragma unroll
    for (int i = 0; i < N / 2; ++i) { const float send = upper ? v[i] : v[i + N / 2]; const float keep = upper ? v[i + N / 2] : v[i]; v[i] = keep + __shfl_xor(send, mask); }
}
__device__ __forceinline__ void reduce16(float (&v)[16], int lane, float (&out)[16]) {
    halve<16, 16>(v, 32, (lane & 32) != 0); halve<8, 16>(v, 16, (lane & 16) != 0); halve<4, 16>(v, 8, (lane & 8) != 0); halve<2, 16>(v, 4, (lane & 4) != 0);
    float x = v[0]; x += __shfl_xor(x, 2); x += __shfl_xor(x, 1);
#pragma unroll
    for (int i = 0; i < 16; ++i) out[i] = __builtin_bit_cast(float, __builtin_amdgcn_readlane(__builtin_bit_cast(int, x), 4 * i));
}
__device__ __forceinline__ void router_phase(const Args& a, int l, LAS unsigned char* lds, int tid, int lane_unused, int wave, int G) {
    unsigned char* ws = a.ws;
    const bf16_t* H = (const bf16_t*)(ws + WS_H); bf16_t* T = (bf16_t*)(ws + WS_ABUF); const float* mod = (const float*)(ws + WS_MOD);
    LAS float* WG1 = (LAS float*)lds;
    LAS float* WE = (LAS float*)(lds + 16384);
    LAS int* REC_E = (LAS int*)(lds + 92160); LAS int* REC_P = REC_E + 256; LAS float* REC_W = (LAS float*)(REC_P + 256);
    LAS int* CNT = (LAS int*)(lds + 95232); LAS int* GBASE = CNT + 32;
    const float* rgw = a.in[I_RGW] + (size_t)l * 1024 * 4; const float* rew = a.in[I_REW] + (size_t)l * 1024 * 16;
    {   f32x4 wg[2], we[2][4];
#pragma unroll
        for (int i = 0; i < 2; ++i) { const int col = tid + 512 * i; wg[i] = *(const f32x4*)(rgw + col * 4);
#pragma unroll
            for (int g = 0; g < 4; ++g) we[i][g] = *(const f32x4*)(rew + col * 16 + 4 * g); }
#pragma unroll
        for (int i = 0; i < 2; ++i) { const int col = tid + 512 * i, jp = col >> 9, ln = (col & 511) >> 3, cc = col & 7; const int pos = ((jp * 8 + cc) * 64 + ln) * 4;
            *(LAS f32x4*)(WG1 + pos) = wg[i];
#pragma unroll
            for (int g = 0; g < 4; ++g) *(LAS f32x4*)(WE + g * 4096 + pos) = we[i][g]; } }
    if (tid < NCLS) CNT[tid] = 0;
    __syncthreads();
    unsigned* counts = (unsigned*)(ws + WS_CTL) + CW_CNT + 64 * l;
    int* list = (int*)(ws + RT_LIST); f32x2* wsl = (f32x2*)(ws + RT_WSLOT);
    const float* rgb = a.in[I_RGB] + l * 4; const float* reb = a.in[I_REB] + l * 16;
    for (int blk = blockIdx.x; blk < MT / 128; blk += G) {
        const int tok0 = blk * 128 + wave * 16, b = (blk * 128) >> 12;
        f32x4 gm[4], sh[4]; load_mod(mod, a.in[I_N2G], l, b, 3, opaque_tid() & 63, gm, sh);
        u32x4 nx[4][2];
        { const int lane = opaque_tid() & 63;
#pragma unroll
          for (int tk = 0; tk < 4; ++tk)
#pragma unroll
            for (int j = 0; j < 2; ++j) nx[tk][j] = *(const u32x4*)(H + (size_t)(tok0 + tk) * 1024 + 8 * lane + 512 * j); }
#pragma unroll 1
        for (int grp = 0; grp < 4; ++grp) {
            const int lane = opaque_tid() & 63;
            f32x4 hv[4][4];
#pragma unroll
            for (int tk = 0; tk < 4; ++tk)
#pragma unroll
                for (int j = 0; j < 2; ++j) { const u32x4 w = nx[tk][j]; hv[tk][2 * j] = (f32x4){bf_lo(w.x), bf_hi(w.x), bf_lo(w.y), bf_hi(w.y)}; hv[tk][2 * j + 1] = (f32x4){bf_lo(w.z), bf_hi(w.z), bf_lo(w.w), bf_hi(w.w)}; }
            if (grp < 3) {
#pragma unroll
                for (int tk = 0; tk < 4; ++tk)
#pragma unroll
                    for (int j = 0; j < 2; ++j) nx[tk][j] = *(const u32x4*)(H + (size_t)(tok0 + (grp + 1) * 4 + tk) * 1024 + 8 * lane + 512 * j); }
            {
#pragma unroll
                for (int tk = 0; tk < 4; ++tk) { const float rstd = __builtin_amdgcn_rsqf(wave_sum(sumsq16(hv[tk])) * (1.0f / 1024.0f) + EPS);
#pragma unroll
                    for (int i = 0; i < 4; ++i) hv[tk][i] = hv[tk][i] * rstd * gm[i] + sh[i];
                    store_row_bf16(T + (size_t)(tok0 + grp * 4 + tk) * 1024, lane, hv[tk]); } }
            float acc[16], tot[16];
#pragma unroll
            for (int i = 0; i < 16; ++i) acc[i] = 0.f;
#pragma unroll
            for (int jp = 0; jp < 2; ++jp)
#pragma unroll
                for (int cc = 0; cc < 8; ++cc) { const f32x4 w4 = *(const LAS f32x4*)(WG1 + ((jp * 8 + cc) * 64 + lane) * 4);
#pragma unroll
                    for (int tk = 0; tk < 4; ++tk) { const float tv = hv[tk][2 * jp + (cc >> 2)][cc & 3];
#pragma unroll
                        for (int q = 0; q < 4; ++q) acc[tk * 4 + q] += tv * w4[q]; } }
            reduce16(acc, lane, tot);
            int gi[4]; float gp[4];
#pragma unroll
            for (int tk = 0; tk < 4; ++tk) { float gl[4];
#pragma unroll
                for (int q = 0; q < 4; ++q) gl[q] = tot[tk * 4 + q] + rgb[q];
                int g = 0; float gmx = gl[0];
#pragma unroll
                for (int q = 1; q < 4; ++q) if (gl[q] > gmx) { gmx = gl[q]; g = q; }
                float gs = 0.f;
#pragma unroll
                for (int q = 0; q < 4; ++q) gs += __expf(gl[q] - gmx);
                gi[tk] = __builtin_amdgcn_readfirstlane(g); gp[tk] = 1.0f / gs; }
#pragma unroll
            for (int i = 0; i < 16; ++i) acc[i] = 0.f;
#pragma unroll
            for (int tk = 0; tk < 4; ++tk) { const LAS float* we = WE + gi[tk] * 4096 + lane * 4;
#pragma unroll
                for (int jp = 0; jp < 2; ++jp)
#pragma unroll
                    for (int cc = 0; cc < 8; ++cc) { const f32x4 w4 = *(const LAS f32x4*)(we + (jp * 8 + cc) * 256); const float tv = hv[tk][2 * jp + (cc >> 2)][cc & 3];
#pragma unroll
                        for (int q = 0; q < 4; ++q) acc[tk * 4 + q] += tv * w4[q]; } }
            reduce16(acc, lane, tot);
            if (lane == 0) {
#pragma unroll
                for (int tk = 0; tk < 4; ++tk) { float el[4];
#pragma unroll
                    for (int q = 0; q < 4; ++q) el[q] = tot[tk * 4 + q] + reb[gi[tk] * 4 + q];
                    int i1 = 0; float m1 = el[0];
#pragma unroll
                    for (int q = 1; q < 4; ++q) if (el[q] > m1) { m1 = el[q]; i1 = q; }
                    int i2 = -1; float m2 = -3.0e38f;
#pragma unroll
                    for (int q = 0; q < 4; ++q) if (q != i1 && el[q] > m2) { m2 = el[q]; i2 = q; }
                    const float ex = __expf(m2 - m1), den = 1.0f / (1.0f + ex);
                    const float w1 = gp[tk] * den, w2 = gp[tk] * ex * den;
                    const int lo = (i1 < i2) ? i1 : i2, hi = (i1 < i2) ? i2 : i1; const int cls = gi[tk] * 6 + ((lo == 0) ? 0 : (lo == 1) ? 3 : 5) + (hi - lo - 1);
                    const int tl = wave * 16 + grp * 4 + tk;
                    REC_E[tl] = cls; REC_W[tl * 2] = (i1 < i2) ? w1 : w2; REC_W[tl * 2 + 1] = (i1 < i2) ? w2 : w1;
                    REC_P[tl] = __hip_atomic_fetch_add(CNT + cls, 1, __ATOMIC_RELAXED, __HIP_MEMORY_SCOPE_WORKGROUP); } }
        }
        const int tid = opaque_tid();
        __syncthreads();
        if (tid < NCLS) { GBASE[tid] = (int)__hip_atomic_fetch_add(counts + tid, (unsigned)CNT[tid], __ATOMIC_RELAXED, __HIP_MEMORY_SCOPE_AGENT); }
        __syncthreads();
        if (tid < 128) { const int cls = REC_E[tid], pos = GBASE[cls] + REC_P[tid]; const int token = blk * 128 + tid;
            list[cls * LISTCAP + pos] = token; wsl[(size_t)cls * LISTCAP + pos] = (f32x2){REC_W[tid * 2], REC_W[tid * 2 + 1]}; }
        if (tid < NCLS) CNT[tid] = 0;
        __syncthreads();
    }
}
__device__ __forceinline__ void build_tp(const Args& a, int l, LAS unsigned char* lds, int tid) {
    volatile LAS int* tp = (volatile LAS int*)(lds + TP_OFF);
    if (tid == 0) { const unsigned* counts = (const unsigned*)(a.ws + WS_CTL) + CW_CNT + 64 * l; int acc = 0;
        volatile LAS int* hp = tp + 2 * NCLS + 1; volatile LAS int* lp = hp + NCLS + 1; int ah = 0, al = 0;
        for (int e = 0; e < NCLS; ++e) { const int c = (int)__hip_atomic_load(counts + e, __ATOMIC_RELAXED, __HIP_MEMORY_SCOPE_AGENT); const int nt_ = (c + 255) >> 8;
            const int light = (nt_ > 0 && c - 256 * (nt_ - 1) <= 128) ? 1 : 0;
            tp[e] = acc; tp[NCLS + 1 + e] = c; hp[e] = ah; lp[e] = al; acc += nt_; ah += nt_ - light; al += light; }
        tp[NCLS] = acc; hp[NCLS] = ah; lp[NCLS] = al; }
    __syncthreads();
}
__device__ __forceinline__ void ln1_phase(const Args& a, int lane, int gw, int NGW) {
    unsigned char* ws = a.ws; const float* mod = (const float*)(ws + WS_MOD); const bf16_t* H = (const bf16_t*)(ws + WS_H); bf16_t* AB = (bf16_t*)(ws + WS_ABUF);
    const int rpw = (((MT + NGW - 1) / NGW) + 1) & ~1, m0 = gw * rpw, m1 = (m0 + rpw < MT) ? m0 + rpw : MT;
    int curb = -1; f32x4 gm[4], sh[4];
    for (int m = m0; m < m1; m += 2) {
        f32x4 hv[2][4];
#pragma unroll
        for (int r = 0; r < 2; ++r) load_row_bf16(H + (size_t)(m + r) * 1024, lane, hv[r]);
        const int b = m >> 12;
        if (b != curb) { load_mod(mod, a.in[I_N1G], 1, b, 0, lane, gm, sh); curb = b; }
#pragma unroll
        for (int r = 0; r < 2; ++r) { const float rstd = __builtin_amdgcn_rsqf(wave_sum(sumsq16(hv[r])) * (1.0f / 1024.0f) + EPS);
#pragma unroll
            for (int i = 0; i < 4; ++i) hv[r][i] = hv[r][i] * rstd * gm[i] + sh[i];
            store_row_bf16(AB + (size_t)(m + r) * 1024, lane, hv[r]); }
    }
}
__device__ __forceinline__ void sgconv_phase(const Args& a, LAS unsigned char* lds, int tid_unused, int lane_unused, int wave, int G) {
    unsigned char* ws = a.ws; const bf16_t* UV = (const bf16_t*)(ws + WS_RGN); bf16_t* MIX = (bf16_t*)(ws + WS_ABUF); const bf16_t* WSG = (const bf16_t*)(ws + WS_WSG);
    for (int blk = blockIdx.x; blk < MT / 128; blk += G) {
        const int tok0 = blk * 128;
        {
            const int lane = opaque_tid() & 63;
            const int g = wave >> 1, ch = lane & 15; float gn[8];
            u32x4 wv[16];
#pragma unroll
            for (int it = 0; it < 16; ++it) wv[it] = *(const u32x4*)(UV + (size_t)(tok0 + 64 * (wave & 1) + 4 * it + (lane >> 4)) * 2560 + 512 + g * 128 + 8 * ch);
#pragma unroll
            for (int j = 0; j < 8; ++j) gn[j] = a.in[I_SGG][g * 128 + 8 * ch + j];
#pragma unroll
            for (int it = 0; it < 16; ++it) { const int q = 64 * (wave & 1) + 4 * it + (lane >> 4); const u32x4 w = wv[it];
                float v[8] = {bf_lo(w.x), bf_hi(w.x), bf_lo(w.y), bf_hi(w.y), bf_lo(w.z), bf_hi(w.z), bf_lo(w.w), bf_hi(w.w)};
                float ss = 0.f;
#pragma unroll
                for (int j = 0; j < 8; ++j) ss += v[j] * v[j];
                ss += __shfl_xor(ss, 1); ss += __shfl_xor(ss, 2); ss += __shfl_xor(ss, 4); ss += __shfl_xor(ss, 8);
                const float rstd = __builtin_amdgcn_rsqf(ss * (1.0f / 128.0f) + EPS);
                u32x4 o; o.x = cvt_pk_bf16(v[0] * rstd * gn[0], v[1] * rstd * gn[1]); o.y = cvt_pk_bf16(v[2] * rstd * gn[2], v[3] * rstd * gn[3]);
                o.z = cvt_pk_bf16(v[4] * rstd * gn[4], v[5] * rstd * gn[5]); o.w = cvt_pk_bf16(v[6] * rstd * gn[6], v[7] * rstd * gn[7]);
                *(LAS u32x4*)(lds + g * 32768 + (ch >> 2) * 8192 + q * 64 + (ch & 3) * 16) = o; }
        }
        {
            const int lane = opaque_tid() & 63;
            float cw[3][8];
#pragma unroll
            for (int k = 0; k < 3; ++k)
#pragma unroll
                for (int j = 0; j < 8; ++j) cw[k][j] = a.in[I_CONVW][k * 512 + 8 * lane + j];
#pragma unroll 1
            for (int hf = 0; hf < 4; ++hf) { const int t0 = tok0 + wave * 16 + hf * 4;
                u32x4 hx[6], cg[6], bg[4];
#pragma unroll
                for (int i = 0; i < 6; ++i) { const bool ok = !((i == 0 && ((t0 & 4095) == 0)) || (i == 5 && (((t0 + 3) & 4095) == 4095))); const int tok = ok ? t0 - 1 + i : t0;
                    hx[i] = *(const u32x4*)(UV + (size_t)tok * 2560 + 1024 + 8 * lane); cg[i] = *(const u32x4*)(UV + (size_t)tok * 2560 + 2048 + 8 * lane);
                    if (!ok) hx[i] = (u32x4){0u, 0u, 0u, 0u}; }
#pragma unroll
                for (int i = 0; i < 4; ++i) bg[i] = *(const u32x4*)(UV + (size_t)(t0 + i) * 2560 + 1536 + 8 * lane);
                float z[6][8];
#pragma unroll
                for (int i = 0; i < 6; ++i) { z[i][0] = bf_lo(hx[i].x) * bf_lo(cg[i].x); z[i][1] = bf_hi(hx[i].x) * bf_hi(cg[i].x); z[i][2] = bf_lo(hx[i].y) * bf_lo(cg[i].y); z[i][3] = bf_hi(hx[i].y) * bf_hi(cg[i].y);
                    z[i][4] = bf_lo(hx[i].z) * bf_lo(cg[i].z); z[i][5] = bf_hi(hx[i].z) * bf_hi(cg[i].z); z[i][6] = bf_lo(hx[i].w) * bf_lo(cg[i].w); z[i][7] = bf_hi(hx[i].w) * bf_hi(cg[i].w); }
#pragma unroll
                for (int i = 0; i < 4; ++i) { const u32x4 b4 = bg[i];
                    const float bgv[8] = {bf_lo(b4.x), bf_hi(b4.x), bf_lo(b4.y), bf_hi(b4.y), bf_lo(b4.z), bf_hi(b4.z), bf_lo(b4.w), bf_hi(b4.w)};
                    float y[8];
#pragma unroll
                    for (int j = 0; j < 8; ++j) y[j] = bgv[j] * (cw[0][j] * z[i][j] + cw[1][j] * z[i + 1][j] + cw[2][j] * z[i + 2][j]);
                    u32x4 o; o.x = cvt_pk_bf16(y[0], y[1]); o.y = cvt_pk_bf16(y[2], y[3]); o.z = cvt_pk_bf16(y[4], y[5]); o.w = cvt_pk_bf16(y[6], y[7]);
                    *(u32x4*)(MIX + (size_t)(t0 + i) * 1024 + 512 + 8 * lane) = o; } }
        }
        __syncthreads();
        {
            const int lane = opaque_tid() & 63, r32 = lane & 31, hi = lane >> 5;
            const int g = wave >> 1, ph = wave & 1;
            f32x16 acc[2][4];
#pragma unroll
            for (int pb = 0; pb < 2; ++pb)
#pragma unroll
                for (int cb = 0; cb < 4; ++cb) acc[pb][cb] = f32x16{};
            const LAS unsigned char* vbase = lds + g * 32768 + ((lane >> 4) & 1) * 32 + (lane & 3) * 8 + (4 * hi + ((lane & 15) >> 2)) * 64;
#pragma unroll 4
            for (int s = 0; s < 8; ++s) {
                bf16x8 wf[2];
#pragma unroll
                for (int pb = 0; pb < 2; ++pb) wf[pb] = *(const bf16x8*)(WSG + (size_t)(g * 128 + 64 * ph + 32 * pb + r32) * 128 + 16 * s + 8 * hi);
#pragma unroll
                for (int cb = 0; cb < 4; ++cb) {
                    const s16x4 lo = attn_body::vtr((attn_body::lds_cptr)(vbase + cb * 8192 + s * 1024)), hh = attn_body::vtr((attn_body::lds_cptr)(vbase + cb * 8192 + s * 1024 + 512));
                    const bf16x8 vf = (bf16x8){lo[0], lo[1], lo[2], lo[3], hh[0], hh[1], hh[2], hh[3]};
#pragma unroll
                    for (int pb = 0; pb < 2; ++pb) acc[pb][cb] = __builtin_amdgcn_mfma_f32_32x32x16_bf16(vf, wf[pb], acc[pb][cb], 0, 0, 0);
                }
            }
#pragma unroll
            for (int pb = 0; pb < 2; ++pb) { const int p = 64 * ph + 32 * pb + r32; const float bias = a.in[I_SGB][g * 128 + p];
                const bf16_t* urow = UV + (size_t)(tok0 + p) * 2560 + g * 128; bf16_t* orow = MIX + (size_t)(tok0 + p) * 1024 + g * 128;
                u32x2 uu[4][4];
#pragma unroll
                for (int cb = 0; cb < 4; ++cb)
#pragma unroll
                    for (int rg = 0; rg < 4; ++rg) uu[cb][rg] = *(const u32x2*)(urow + 32 * cb + 8 * rg + 4 * hi);
#pragma unroll
                for (int cb = 0; cb < 4; ++cb)
#pragma unroll
                    for (int rg = 0; rg < 4; ++rg) { const int c0 = 32 * cb + 8 * rg + 4 * hi; const u32x2 u2 = uu[cb][rg];
                        u32x2 w; w.x = cvt_pk_bf16(bf_lo(u2.x) * (acc[pb][cb][4 * rg] + bias), bf_hi(u2.x) * (acc[pb][cb][4 * rg + 1] + bias));
                        w.y = cvt_pk_bf16(bf_lo(u2.y) * (acc[pb][cb][4 * rg + 2] + bias), bf_hi(u2.y) * (acc[pb][cb][4 * rg + 3] + bias));
                        *(u32x2*)(orow + c0) = w; } }
        }
        __syncthreads();
    }
}

__global__ void __launch_bounds__(NWAVES * 64, 2) mk_fwd(Args a) {
    extern __shared__ __attribute__((aligned(16))) unsigned char lds_raw[];
    LAS unsigned char* lds = (LAS unsigned char*)lds_raw;
    const int tid0 = threadIdx.x, wave = __builtin_amdgcn_readfirstlane(tid0 >> 6);
#define tid opaque_tid()
#define lane (opaque_tid() & 63)
    const int G = gridDim.x; const int bx = blockIdx.x; const int vcu = (G % 8 == 0) ? (bx % 8) * (G / 8) + bx / 8 : bx;
    const int gw = vcu * NWAVES + wave, NGW = G * NWAVES;
    unsigned char* ws = a.ws;
    for (int u = tid0; u < (LDS_BYTES - LDSCTL_OFF) / 4; u += NWAVES * 64) ((LAS unsigned*)(lds + LDSCTL_OFF))[u] = 0u;
    __syncthreads();
    volatile LAS unsigned* MISC = (volatile LAS unsigned*)(lds + MISC_OFF);
    XcdBarrier bar = xcd_barrier_post((unsigned*)(ws + WS_CTL) + CW_BAR, MISC + 8);
    unsigned long long t_ph = 0; if constexpr (MK_PROBE != 0u) t_ph = __builtin_amdgcn_s_memrealtime();
#define PROBE_IDLE(n) do { if constexpr (MK_PROBE != 0u) { if constexpr (((MK_PROBE) >> (n)) & 1u) { const unsigned long long t1_ = __builtin_amdgcn_s_memrealtime(), d_ = t1_ - t_ph; \
        while (__builtin_amdgcn_s_memrealtime() - t1_ < d_) __builtin_amdgcn_s_sleep(8); } t_ph = __builtin_amdgcn_s_memrealtime(); } } while (0)
#define GRID_BAR(n) do { xcd_barrier(bar); PROBE_IDLE(n); } while (0)
    const float* mod = (const float*)(ws + WS_MOD);
    bf16_t* H = (bf16_t*)(ws + WS_H);
    bf16_t* ABUF = (bf16_t*)(ws + WS_ABUF);

    PH(0) { p0_prologue(a, lds, tid, lane, wave, vcu, G); convert_weights(a, lds, 0, lane, wave, gw, NGW); }
    GRID_BAR(0);
#if MK_STAGE == 0
    copy_rows(a.in[I_X], a.out, lane, gw, NGW); return;
#endif
    PH(1) p1_ln_rows(a, lane, gw, NGW);
    GRID_BAR(1);
    PH(2) {   pg8::SchedInProj0 S{G, vcu};
        pg8::EpiQKV E{(bf16_t*)(ws + RG_Q), (bf16_t*)(ws + RG_K), (bf16_t*)(ws + RG_V), (bf16_t*)(ws + RG_P), a.in[I_QG], a.in[I_KG]};
        pg8::gemm_phase<pg8::EpiQKV, pg8::SchedInProj0, false>(lds, ABUF, (const bf16_t*)(ws + WS_WIN0), 1024, S, E); }
    PH(2) {   const int nfull = 648 % G;
        if (nfull != 0 && vcu >= nfull) convert_weights(a, lds, 1, lane, wave, (vcu - nfull) * NWAVES + wave, (G - nfull) * NWAVES);
        else if (nfull == 0) convert_weights(a, lds, 1, lane, wave, gw, NGW); }
    GRID_BAR(2);
    PH(3) {   float aref; { float mq = fabsf(a.in[I_QG][lane]), mk = fabsf(a.in[I_KG][lane]);
#pragma unroll
            for (int o_ = 1; o_ < 64; o_ <<= 1) { mq = fmaxf(mq, __shfl_xor(mq, o_)); mk = fmaxf(mk, __shfl_xor(mk, o_)); }
            aref = 64.0f * C2 * mq * mk; }
        const int nper = (NB * 8 * (SEQ / 256)) / G;
        for (int i = 0; i < nper; ++i) { const int uidx = vcu * nper + i; const int b = uidx >> 7, rem = uidx & 127, h = rem & 7, qb = rem >> 3;
            attn_body::attn_unit<8>(b, h, qb, (const bf16_t*)(ws + RG_Q), (const bf16_t*)(ws + RG_K), (const bf16_t*)(ws + RG_V), (bf16_t*)(ws + RG_A2), (char*)lds_raw, aref); }
        for (int p = gw; p < (MT / 32) * 2; p += NGW)
#pragma unroll 1
            for (int k = 0; k < 2; ++k) pool_task(p >> 1, (p & 1) ? 1 + k : 3 * k, (const bf16_t*)(ws + RG_P), (const bf16_t*)(ws + WS_WPOOL), a.in[I_POOLS], (bf16_t*)(ws + RG_A2), lane); }
    GRID_BAR(3);
    PH(4) {   pg8::SchedGrid S{4, 128 * 4, G, vcu};
        pg8::EpiResid<true> E{a.in[I_X], H, mod + 2 * 1024};
        pg8::gemm_phase<pg8::EpiResid<true>, pg8::SchedGrid, false>(lds, (const bf16_t*)(ws + RG_A2), (const bf16_t*)(ws + WS_WOUT0), 1024, S, E); }
    GRID_BAR(4);
#if MK_STAGE == 1
    copy_rows(H, a.out, lane, gw, NGW); return;
#endif
#if MK_STAGE >= 2
    PH(5) router_phase(a, 0, lds, tid, lane, wave, G);
    GRID_BAR(5);
    build_tp(a, 0, lds, tid);
    PH(6) {   pg8::SchedMoE S{(const volatile LAS int*)(lds + TP_OFF), (const int*)(ws + RT_LIST), G, vcu, false, (const f32x2*)(ws + RT_WSLOT), lds + SIDE_OFF};
        pg8::EpiGateUp E{(bf16_t*)(ws + WS_RGN), lds + SIDE_OFF};
        pg8::gemm_phase<pg8::EpiGateUp, pg8::SchedMoE, true>(lds, ABUF, (const bf16_t*)(ws + WS_WGU), 1024, S, E); }
    PH(6) {   const int nun = ((const volatile LAS int*)(lds + TP_OFF))[NCLS] * 4, nfull = nun % G;
        if (nfull != 0 && vcu >= nfull) convert_weights(a, lds, 2, lane, wave, (vcu - nfull) * NWAVES + wave, (G - nfull) * NWAVES);
        else if (nfull == 0) convert_weights(a, lds, 2, lane, wave, gw, NGW); }
    GRID_BAR(6);
    PH(7) {   pg8::SchedMoE S{(const volatile LAS int*)(lds + TP_OFF), (const int*)(ws + RT_LIST), G, vcu, true, (const f32x2*)(ws + RT_WSLOT), lds + SIDE_OFF};
        pg8::EpiCombine<false> E{H, a.out, mod + 5 * 1024, lds + SIDE_OFF};
        pg8::gemm_phase<pg8::EpiCombine<false>, pg8::SchedMoE, false, true>(lds, (const bf16_t*)(ws + WS_RGN), (const bf16_t*)(ws + WS_WDN), 512, S, E); }
    GRID_BAR(7);
#endif
#if MK_STAGE >= 3
    PH(8) ln1_phase(a, lane, gw, NGW);
    GRID_BAR(8);
#endif
#if MK_STAGE == 2
    copy_rows(H, a.out, lane, gw, NGW); return;
#endif
#if MK_STAGE >= 3
    PH(9) {   pg8::SchedGrid S{10, 128 * 10, G, vcu};
        pg8::EpiBf16 E{(bf16_t*)(ws + WS_RGN), 2560, false};
        pg8::gemm_phase<pg8::EpiBf16, pg8::SchedGrid, false>(lds, ABUF, (const bf16_t*)(ws + WS_WIN1), 1024, S, E); }
    GRID_BAR(9);
    PH(10) sgconv_phase(a, lds, tid, lane, wave, G);
    GRID_BAR(10);
    PH(11) {   pg8::SchedGrid S{4, 128 * 4, G, vcu};
        pg8::EpiResid<false> E{H, H, mod + (size_t)9 * 6144 + 2 * 1024};
        pg8::gemm_phase<pg8::EpiResid<false>, pg8::SchedGrid, false>(lds, ABUF, (const bf16_t*)(ws + WS_WOUT1), 1024, S, E); }
    GRID_BAR(11);
#endif
#if MK_STAGE == 3
    copy_rows(H, a.out, lane, gw, NGW); return;
#endif
#if MK_STAGE >= 4
    router_phase(a, 1, lds, tid, lane, wave, G);
    GRID_BAR(12);
    build_tp(a, 1, lds, tid);
    {   pg8::SchedMoE S{(const volatile LAS int*)(lds + TP_OFF), (const int*)(ws + RT_LIST), G, vcu, false, (const f32x2*)(ws + RT_WSLOT), lds + SIDE_OFF};
        pg8::EpiGateUp E{(bf16_t*)(ws + WS_RGN), lds + SIDE_OFF};
        pg8::gemm_phase<pg8::EpiGateUp, pg8::SchedMoE, true>(lds, ABUF, (const bf16_t*)(ws + WS_WGU) + (size_t)8192 * 1024, 1024, S, E); }
    GRID_BAR(13);
    {   pg8::SchedMoE S{(const volatile LAS int*)(lds + TP_OFF), (const int*)(ws + RT_LIST), G, vcu, true, (const f32x2*)(ws + RT_WSLOT), lds + SIDE_OFF};
        pg8::EpiCombine<true> E{H, a.out, mod + (size_t)9 * 6144 + 5 * 1024, lds + SIDE_OFF};
        pg8::gemm_phase<pg8::EpiCombine<true>, pg8::SchedMoE, false, true>(lds, (const bf16_t*)(ws + WS_RGN), (const bf16_t*)(ws + WS_WDN) + (size_t)16384 * 256, 512, S, E); }
    PROBE_IDLE(15);
#endif
#undef tid
#undef lane
}

extern "C" void kernel_launch(void* const* d_in, const int* in_sizes, int n_in, void* d_out, int out_size, void* d_ws, size_t ws_size, hipStream_t stream) {
    static int grid = 0;
    if (grid == 0) {
        if (n_in != 27 || out_size != MT * DM || ws_size < WS_END) { fprintf(stderr, "kernel_launch: unexpected problem (n_in %d, out %d, ws %zu)\n", n_in, out_size, ws_size); grid = -1; return; }
        int dev = 0, cus = 0, per_cu = 0;
        if (hipGetDevice(&dev) != hipSuccess || hipDeviceGetAttribute(&cus, hipDeviceAttributeMultiprocessorCount, dev) != hipSuccess) { grid = -1; return; }
        if (hipFuncSetAttribute((const void*)mk_fwd, hipFuncAttributeMaxDynamicSharedMemorySize, LDS_BYTES) != hipSuccess) { fprintf(stderr, "kernel_launch: hipFuncSetAttribute failed\n"); grid = -1; return; }
        if (hipOccupancyMaxActiveBlocksPerMultiprocessor(&per_cu, (const void*)mk_fwd, NWAVES * 64, LDS_BYTES) != hipSuccess || per_cu < 1) { fprintf(stderr, "kernel_launch: occupancy query says %d blocks per CU\n", per_cu); }
        (void)hipGetLastError();
        grid = cus;
    }
    if (grid < 0) return;
    if (hipMemsetAsync((char*)d_ws + WS_CTL, 0, CTL_ZERO_BYTES, stream) != hipSuccess) return;
    Args a{};
    for (int i = 0; i < 27; ++i) a.in[i] = (const float*)d_in[i];
    a.out = (float*)d_out; a.ws = (unsigned char*)d_ws;
    hipLaunchKernelGGL(mk_fwd, dim3(grid), dim3(NWAVES * 64), LDS_BYTES, stream, a);
}
```

```cpp
#include <hip/hip_runtime.h>
#include <cstdio>
#include <cstdint>

#ifndef MK_PH
#define MK_PH 0xffffffffu
#endif
#define PH(n) if constexpr (((MK_PH) >> (n)) & 1u)
#ifndef MK_PROBE
#define MK_PROBE 0u
#endif
#ifndef MK_STAGE
#define MK_STAGE 4
#endif

#define LAS __attribute__((address_space(3)))
#define GAS __attribute__((address_space(1)))
typedef unsigned short bf16_t;
typedef short bf16x8 __attribute__((ext_vector_type(8)));
typedef short s16x4 __attribute__((ext_vector_type(4)));
typedef float f32x2 __attribute__((ext_vector_type(2)));
typedef float f32x4 __attribute__((ext_vector_type(4)));
typedef float f32x16 __attribute__((ext_vector_type(16)));
typedef unsigned u32x2 __attribute__((ext_vector_type(2)));
typedef unsigned u32x4 __attribute__((ext_vector_type(4)));
typedef GAS unsigned gu32_t;

constexpr int NB = 8, SEQ = 4096, DM = 1024, MT = NB * SEQ, CTX = 256, MC = NB * CTX, MA = MT + MC, NKV = SEQ + CTX;
constexpr int NEXP = 16, DEXP = 256, NCLS = 24, LISTCAP = MT;
constexpr int SLOT_ROWS = MT + NCLS * 256;
constexpr float EPS = 1e-6f;
constexpr float C2 = 0.125f * 1.4426950408889634f;

constexpr size_t MiB = 1u << 20;
constexpr size_t WS_CTL = 0, CTL_ZERO_BYTES = 65536;
constexpr size_t WS_MOD = 512 * 1024;
constexpr size_t WS_WIN0 = 2 * MiB;
constexpr size_t WS_WOUT0 = 5 * MiB;
constexpr size_t WS_WIN1 = 7 * MiB;
constexpr size_t WS_WOUT1 = 12 * MiB;
constexpr size_t WS_WGU = 14 * MiB;
constexpr size_t WS_WDN = 46 * MiB;
constexpr size_t WS_WPOOL = 62 * MiB;
constexpr size_t WS_WSG = 62 * MiB + 512 * 1024;
constexpr size_t WS_ABUF = 64 * MiB;
constexpr size_t WS_H = 132 * MiB;
constexpr size_t WS_ACT = 260 * MiB;
constexpr size_t WS_RGN = 294 * MiB;
constexpr size_t RG_Q = WS_RGN, RG_K = RG_Q + 32 * MiB, RG_V = RG_K + 9 * MiB, RG_P = RG_V + 9 * MiB, RG_A2 = RG_P + 32 * MiB;
constexpr size_t WS_ROUTE = 462 * MiB;
constexpr size_t RT_LIST = WS_ROUTE;
constexpr size_t RT_WSLOT = WS_ACT;
constexpr size_t WS_END = 466 * MiB;
static_assert(RG_A2 + (size_t)MT * 1024 * 2 <= WS_ROUTE && WS_RGN + (size_t)SLOT_ROWS * 512 * 2 <= WS_ROUTE && WS_RGN + (size_t)MT * 2560 * 2 <= WS_ROUTE && RT_LIST + (size_t)NCLS * LISTCAP * 4 <= WS_END && RT_WSLOT + (size_t)NCLS * LISTCAP * 8 <= WS_RGN, "region map");
static_assert(WS_ABUF + (size_t)MA * 1024 * 2 <= WS_H && WS_H + (size_t)MT * 1024 * 4 <= WS_ACT, "ws map");
constexpr int CW_CNT = 64;
constexpr int CW_WFLAG = 1024;
constexpr int CW_BAR = 4096;

constexpr int RING_BYTES = 131072;
constexpr int LDSCTL_OFF = RING_BYTES, MISC_OFF = LDSCTL_OFF + 320;
constexpr int SIDE_OFF = LDSCTL_OFF + 1024;
constexpr int LDS_BYTES = 147456;
constexpr int NWAVES = 8;

__device__ __forceinline__ unsigned cvt_pk_bf16(float lo, float hi) { unsigned r; asm volatile("v_cvt_pk_bf16_f32 %0, %1, %2" : "=v"(r) : "v"(lo), "v"(hi)); return r; }
__device__ __forceinline__ float bf_lo(unsigned w) { return __uint_as_float(w << 16); }
__device__ __forceinline__ float bf_hi(unsigned w) { return __uint_as_float(w & 0xffff0000u); }
__device__ __forceinline__ float wave_sum(float v) {
#pragma unroll
    for (int o = 1; o < 64; o <<= 1) v += __shfl_xor(v, o);
    return v;
}
__device__ __forceinline__ float fast_rcp(float x) { return __builtin_amdgcn_rcpf(x); }
__device__ __forceinline__ float silu_f(float v) { return v * fast_rcp(1.f + __builtin_amdgcn_exp2f(-1.4426950408889634f * v)); }

__device__ __forceinline__ int opaque_tid() { int t = threadIdx.x; asm volatile("" : "+v"(t)); return t; }

#define XB_TMO      128
#define XB_XCNT(j)  (256  + 64 * (j))
#define XB_XSUB(j)  (1280 + 64 * (j))
#define XB_XGEN(j)  (2304 + 64 * (j))
#define XB_TOP      3328
#define XB_TOPGEN   3392
#define XCD_BAR_WORDS 3456
#define XB_SPIN_CAP (1u << 18)
__device__ __forceinline__ unsigned xb_ld(unsigned* p)              { return __hip_atomic_load(p, __ATOMIC_RELAXED, __HIP_MEMORY_SCOPE_AGENT); }
__device__ __forceinline__ unsigned xb_add(unsigned* p, unsigned v) { return __hip_atomic_fetch_add(p, v, __ATOMIC_RELAXED, __HIP_MEMORY_SCOPE_AGENT); }
__device__ __forceinline__ unsigned xb_xcc_id() { return (unsigned)__builtin_amdgcn_s_getreg((3 << 11) | 20) & 0xFu; }
#define XB_SPIN(cond, bar) do { unsigned _sp = 0; while (cond) { __builtin_amdgcn_s_sleep(1); \
    if ((++_sp & 255u) == 0u) { if (xb_ld(&(bar)[XB_TMO])) break; if (_sp > XB_SPIN_CAP) { atomicAdd(&(bar)[XB_TMO], 1u); break; } } } } while (0)
struct XcdBarrier { unsigned* bar; unsigned x; volatile LAS unsigned* st; unsigned nwg; };
__device__ __forceinline__ XcdBarrier xcd_barrier_post(unsigned* bar, volatile LAS unsigned* st, unsigned nwg) {
    XcdBarrier b; b.bar = bar; b.x = xb_xcc_id(); b.st = st; b.nwg = nwg;
    if (threadIdx.x == 0) (void)xb_add(&bar[XB_XCNT(b.x)], 1u);
    return b;
}
__device__ __forceinline__ void xcd_barrier_complete(unsigned* bar, unsigned x, unsigned G, unsigned& nloc, unsigned& nx) {
    unsigned sum, cnt, mine, sp = 0u;
    for (;;) {
        sum = 0u; cnt = 0u; mine = 0u;
#pragma unroll
        for (unsigned j = 0; j < 16; ++j) { const unsigned c = xb_ld(&bar[XB_XCNT(j)]); sum += c; cnt += (c > 0u) ? 1u : 0u; mine = (j == x) ? c : mine; }
        if (sum == G) break;
        __builtin_amdgcn_s_sleep(1);
        if ((++sp & 255u) == 0u) { if (xb_ld(&bar[XB_TMO])) break; if (sp > XB_SPIN_CAP) { atomicAdd(&bar[XB_TMO], 1u); break; } }
    }
    nloc = mine > 0u ? mine : 1u; nx = cnt > 0u ? cnt : 1u;
}
__device__ __forceinline__ void xcd_barrier(const XcdBarrier& b) {
    asm volatile("s_waitcnt vmcnt(0)" ::: "memory");
    __syncthreads();
    if (threadIdx.x == 0) {
        unsigned* bar = b.bar;
        __builtin_amdgcn_s_waitcnt(0);
        unsigned nloc = b.st[0], nx = b.st[1];
        if (nloc == 0u) { xcd_barrier_complete(bar, b.x, b.nwg, nloc, nx); b.st[0] = nloc; b.st[1] = nx; }
        const unsigned old = xb_add(&bar[XB_XSUB(b.x)], 1u);
        const unsigned gen = old / nloc;
        if (old + 1u == (gen + 1u) * nloc) {
            __builtin_amdgcn_fence(__ATOMIC_RELEASE, "agent");
            asm volatile("s_waitcnt vmcnt(0)" ::: "memory");
            const unsigned og = xb_add(&bar[XB_TOP], 1u);
            const unsigned tg = og / nx;
            if (og + 1u == (tg + 1u) * nx) xb_add(&bar[XB_TOPGEN], 1u);
            else XB_SPIN(xb_ld(&bar[XB_TOPGEN]) == tg, bar);
            __builtin_amdgcn_fence(__ATOMIC_ACQUIRE, "agent");
            xb_add(&bar[XB_XGEN(b.x)], 1u);
            asm volatile("s_waitcnt vmcnt(0)" ::: "memory");
        } else {
            XB_SPIN(xb_ld(&bar[XB_XGEN(b.x)]) == gen, bar);
            __builtin_amdgcn_fence(__ATOMIC_ACQUIRE, "agent");
            asm volatile("s_waitcnt vmcnt(0)" ::: "memory");
        }
    }
    __syncthreads();
}

namespace pg8 {
constexpr int BM = 256, BK = 64, HALF = 128, HTB = HALF * BK * 2;
__device__ __forceinline__ int lds_byte(int r, int c) { const int st = (r >> 4) * 2 + (c >> 5), rr = r & 15, cc = c & 31, ob = rr * 64 + cc * 2; return st * 1024 + (ob ^ (((ob >> 9) & 1) << 5)); }
__device__ __forceinline__ void stage_rc(int b, int& R, int& C) { const int st = b / 1024, sb = b % 1024, swz = sb ^ (((sb >> 9) & 1) << 5); R = (st >> 1) * 16 + swz / 64; C = (st & 1) * 32 + (swz % 64) / 2; }
__device__ __forceinline__ int perm32(int rho) { const int n = rho >> 4, i = rho & 15; return 8 * (i >> 2) + 4 * n + (i & 3); }

struct Unit { int pm, pn, pn2, aux, e, r, slot, half; };

template <class Epi, class Sched, bool GATHER, bool SPLITB = false>
__device__ __forceinline__ void gemm_phase(LAS unsigned char* lds, const bf16_t* A, const bf16_t* Bt, const int K, const Sched& S, const Epi& E) {
    const int tid = opaque_tid(), wid = __builtin_amdgcn_readfirstlane(tid >> 6), lane = tid & 63, wr = wid >> 2, wc = wid & 3, fr = lane & 15, fq = lane >> 4;
    const int nt = K / BK, KB = SPLITB ? K / 2 : K, ntb = SPLITB ? nt / 2 : nt;
    unsigned voffB[2]; int RA[2], CA[2];
#pragma unroll
    for (int i = 0; i < 2; ++i) { int R, C; stage_rc(tid * 16 + i * 8192, R, C); const int Rb = Epi::PERM ? ((R & ~31) + perm32(R & 31)) : R;
        voffB[i] = (unsigned)(Rb * KB + C) * 2u; RA[i] = R; CA[i] = C; }
    const size_t kstep = (size_t)(BK * 2);
    const size_t hstep = (size_t)HALF * K * 2;
    const size_t tstep = 2 * hstep;
    const size_t hstepB = (size_t)HALF * KB * 2, tstepB = 2 * hstepB;
    const unsigned ldsw = (unsigned)wid * 1024u;
    const int aoff = lds_byte(wr * 64 + fr, fq * 8), boff = lds_byte(wc * 32 + fr, fq * 8);
#define PG8_SA(b, h) (((b) * 2 + (h)) * HTB)
#define PG8_SB(b, h) ((4 + (b) * 2 + (h)) * HTB)
#define PG8_STAGE(bufoff, gbase, voff) do { _Pragma("unroll") for (int _i = 0; _i < 2; ++_i) \
        __builtin_amdgcn_global_load_lds((const unsigned*)((const char*)(gbase) + (voff)[_i]), (LAS unsigned*)(lds + (bufoff) + ldsw + _i * 8192), 16, 0, 0); } while (0)
#define PG8_LDA(dst, b, h) do { _Pragma("unroll") for (int m = 0; m < 4; ++m) _Pragma("unroll") for (int k = 0; k < 2; ++k) dst[m][k] = *(const LAS bf16x8*)(lds + PG8_SA(b, h) + aoff + m * 2048 + k * 1024); } while (0)
#define PG8_LDB(dst, b, h) do { _Pragma("unroll") for (int n = 0; n < 2; ++n) _Pragma("unroll") for (int k = 0; k < 2; ++k) dst[n][k] = *(const LAS bf16x8*)(lds + PG8_SB(b, h) + boff + n * 2048 + k * 1024); } while (0)
#define PG8_MMA(ai, bj, At, Bt_) do { __builtin_amdgcn_s_setprio(1); _Pragma("unroll") for (int m = 0; m < 4; ++m) _Pragma("unroll") for (int n = 0; n < 2; ++n) _Pragma("unroll") for (int k = 0; k < 2; ++k) \
        acc[ai][bj][m][n] = __builtin_amdgcn_mfma_f32_16x16x32_bf16(Bt_[n][k], At[m][k], acc[ai][bj][m][n], 0, 0, 0); __builtin_amdgcn_s_setprio(0); } while (0)
#define PG8_WAIT_V(n) asm volatile("s_waitcnt vmcnt(" #n ")" ::: "memory")
#define PG8_WAIT_L(n) asm volatile("s_waitcnt lgkmcnt(" #n ")" ::: "memory")
#define PG8_BAR __builtin_amdgcn_s_barrier()
#define PG8_SCHED __builtin_amdgcn_sched_barrier(0)
    Unit cur, nxt; int ui = 0;
    if (!S.next(0, cur)) return;
    cur.slot = 0; S.prep(cur, tid);
    unsigned voA[2][2], voN[2][2];
    if constexpr (GATHER) S.rows(cur, RA, CA, K, voA);
    else {
#pragma unroll
        for (int h = 0; h < 2; ++h)
#pragma unroll
            for (int i = 0; i < 2; ++i) voA[h][i] = (unsigned)((h * HALF + RA[i]) * K + CA[i]) * 2u;
    }
    f32x4 acc[2][2][4][2];
#pragma unroll
    for (int a = 0; a < 2; ++a)
#pragma unroll
        for (int b = 0; b < 2; ++b)
#pragma unroll
            for (int m = 0; m < 4; ++m)
#pragma unroll
                for (int n = 0; n < 2; ++n) acc[a][b][m][n] = (f32x4){0.f, 0.f, 0.f, 0.f};
    bf16x8 At[4][2], B0[2][2], B1[2][2];
    const char* cA = GATHER ? (const char*)A : (const char*)A + (size_t)cur.pm * tstep;
    const char* cB = (const char*)Bt + (size_t)cur.pn * tstepB;
    const char* cB2 = SPLITB ? (const char*)Bt + (size_t)cur.pn2 * tstepB : cB;
    PG8_STAGE(PG8_SB(0, 0), cB, voffB); PG8_STAGE(PG8_SB(0, 1), cB + hstepB, voffB); PG8_STAGE(PG8_SA(0, 0), cA, voA[0]); PG8_STAGE(PG8_SA(0, 1), cA, voA[1]);
    if (wr == 1) PG8_BAR;
    PG8_WAIT_V(2); PG8_BAR;
    PG8_STAGE(PG8_SB(1, 0), cB + kstep, voffB); PG8_STAGE(PG8_SA(1, 0), cA + kstep, voA[0]); PG8_STAGE(PG8_SB(1, 1), cB + hstepB + kstep, voffB);
    PG8_WAIT_V(6); PG8_BAR;
    for (;;) {
        const bool has_next = S.next(ui + 1, nxt);
        if (has_next) { nxt.slot = (cur.slot == 2) ? 0 : cur.slot + 1; S.prep(nxt, tid); }
        const char* nA = cA; const char* nB = cB; const char* nB2 = cB2;
        if (has_next) { nA = GATHER ? (const char*)A : (const char*)A + (size_t)nxt.pm * tstep; nB = (const char*)Bt + (size_t)nxt.pn * tstepB; nB2 = SPLITB ? (const char*)Bt + (size_t)nxt.pn2 * tstepB : nB; }
        if constexpr (GATHER) {
            if (has_next) S.rows(nxt, RA, CA, K, voN);
            else {
#pragma unroll
                for (int h = 0; h < 2; ++h)
#pragma unroll
                    for (int i = 0; i < 2; ++i) voN[h][i] = voA[h][i];
            }
        }
#pragma unroll 1
        for (int t = 0; t < nt; t += 2) {
            const bool last = (t == nt - 2);
            const char* a1 = cA + (size_t)(t + 1) * kstep;
            const char* a2 = last ? nA : cA + (size_t)(t + 2) * kstep;
            const char* b2 = last ? nB : (SPLITB && t + 2 >= ntb) ? cB2 + (size_t)(t + 2 - ntb) * kstep : cB + (size_t)(t + 2) * kstep;
            const char* a3 = a2 + kstep; const char* b3 = b2 + kstep;
            unsigned sel[2][2];
#pragma unroll
            for (int h = 0; h < 2; ++h)
#pragma unroll
                for (int i = 0; i < 2; ++i) sel[h][i] = (GATHER && last) ? voN[h][i] : voA[h][i];
            PG8_LDB(B0, 0, 0); PG8_LDB(B1, 0, 1); PG8_SCHED; PG8_LDA(At, 0, 0); PG8_STAGE(PG8_SA(1, 1), a1, voA[1]);
            PG8_WAIT_V(8); PG8_WAIT_L(0); PG8_BAR; PG8_MMA(0, 0, At, B0); PG8_MMA(0, 1, At, B1); PG8_BAR; PG8_SCHED;
            PG8_LDA(At, 0, 1); PG8_STAGE(PG8_SB(0, 0), b2, voffB); PG8_STAGE(PG8_SB(0, 1), b2 + hstepB, voffB); PG8_STAGE(PG8_SA(0, 0), a2, sel[0]);
            PG8_WAIT_V(8); PG8_WAIT_L(0); PG8_BAR; if (!cur.half) { PG8_MMA(1, 0, At, B0); PG8_MMA(1, 1, At, B1); } PG8_BAR; PG8_SCHED;
            PG8_LDB(B0, 1, 0); PG8_LDB(B1, 1, 1); PG8_SCHED; PG8_LDA(At, 1, 0); PG8_STAGE(PG8_SA(0, 1), a2, sel[1]);
            PG8_WAIT_V(8); PG8_WAIT_L(0); PG8_BAR; PG8_MMA(0, 0, At, B0); PG8_MMA(0, 1, At, B1); PG8_BAR; PG8_SCHED;
            PG8_LDA(At, 1, 1); PG8_STAGE(PG8_SB(1, 0), b3, voffB); PG8_STAGE(PG8_SB(1, 1), b3 + hstepB, voffB); PG8_STAGE(PG8_SA(1, 0), a3, sel[0]);
            PG8_WAIT_V(8); PG8_WAIT_L(0); PG8_BAR; if (!cur.half) { PG8_MMA(1, 0, At, B0); PG8_MMA(1, 1, At, B1); } PG8_BAR; PG8_SCHED;
        }
        if constexpr (Epi::ALIGN) { if (wr == 0) PG8_BAR; }
        E(acc, cur, wr, wc, fr, fq);
        if (!has_next) break;
#pragma unroll
        for (int a = 0; a < 2; ++a)
#pragma unroll
            for (int b = 0; b < 2; ++b)
#pragma unroll
                for (int m = 0; m < 4; ++m)
#pragma unroll
                    for (int n = 0; n < 2; ++n) acc[a][b][m][n] = (f32x4){0.f, 0.f, 0.f, 0.f};
        cur = nxt; cA = nA; cB = nB; cB2 = nB2; ++ui;
        if constexpr (GATHER) {
#pragma unroll
            for (int h = 0; h < 2; ++h)
#pragma unroll
                for (int i = 0; i < 2; ++i) voA[h][i] = voN[h][i];
        }
        if constexpr (Epi::ALIGN) { if (wr == 1) PG8_BAR; }
    }
    PG8_WAIT_V(0);
    if constexpr (!Epi::ALIGN) { if (wr == 0) PG8_BAR; }
    PG8_BAR;
#undef PG8_SA
#undef PG8_SB
#undef PG8_STAGE
#undef PG8_LDA
#undef PG8_LDB
#undef PG8_MMA
#undef PG8_WAIT_V
#undef PG8_WAIT_L
#undef PG8_BAR
#undef PG8_SCHED
}

struct SchedGrid {
    int nN, total, G, c, pm0;
    __device__ __forceinline__ bool next(int i, Unit& u) const { const int L = i * G + c; if (L >= total) return false; u.pm = pm0 + L / nN; u.pn = L % nN; u.pn2 = 0; u.aux = u.pn; u.e = 0; u.r = 0; u.half = 0; return true; }
    __device__ __forceinline__ void prep(const Unit&, int) const {}
};
struct SchedInProj0 {
    int G, c, pm0, nlat, cm0, nctx;
    __device__ __forceinline__ bool next(int i, Unit& u) const { const int L = i * G + c; if (L >= nlat * 5 + nctx) return false;
        if (L < nlat * 5) { u.pm = pm0 + L / 5; u.pn = L % 5; } else { u.pm = 128 + cm0 + (L - nlat * 5); u.pn = 2; } u.pn2 = 0; u.aux = u.pn; u.e = 0; u.r = 0; u.half = 0; return true; }
    __device__ __forceinline__ void prep(const Unit&, int) const {}
};
struct SchedMoE {
    const volatile LAS int* tp; const int* list; int G, c; bool down; const f32x2* wslot; LAS unsigned char* side; int cap, pm0;
    __device__ __forceinline__ void prep(const Unit& u, int tid) const {
        if (tid < 256) { const int idx = u.r * 256 + tid; const bool ok = idx < tp[NCLS + 1 + u.e];
            ((LAS int*)(side + u.slot * 3072))[tid] = ok ? list[u.e * cap + idx] : -1;
            if (!down) ((LAS f32x2*)(side + u.slot * 3072 + 1024))[tid] = ok ? wslot[(size_t)u.e * cap + idx] : (f32x2){0.f, 0.f}; }
    }
    __device__ __forceinline__ bool next(int i, Unit& u) const {
        const volatile LAS int* hp = tp + 2 * NCLS + 1; const volatile LAS int* lp = hp + NCLS + 1;
        const int L = i * G + c; const int nh = hp[NCLS], total = tp[NCLS] * 4; if (L >= total) return false;
        const int ct = L & 3; int cl = 0, r, half;
        if (L < 4 * nh) { const int rt = L >> 2;
#pragma unroll
            for (int j = 1; j < NCLS; ++j) cl += (rt >= hp[j]) ? 1 : 0;
            cl = __builtin_amdgcn_readfirstlane(cl); r = rt - hp[cl]; half = 0; }
        else { const int li = (L >> 2) - nh;
#pragma unroll
            for (int j = 1; j < NCLS; ++j) cl += (li >= lp[j]) ? 1 : 0;
            cl = __builtin_amdgcn_readfirstlane(cl); r = tp[cl + 1] - tp[cl] - 1; half = 1; }
        const int g = cl / 6, p = cl % 6; const int lo = (p < 3) ? 0 : (p < 5) ? 1 : 2, hi = (p < 3) ? p + 1 : (p < 5) ? p - 1 : 3;
        const int elo = 4 * g + lo, ehi = 4 * g + hi;
        u.pm = pm0 + tp[cl] + r; u.aux = ct; u.e = cl; u.r = r; u.half = half;
        if (down) { u.pn = elo * 4 + ct; u.pn2 = ehi * 4 + ct; }
        else { u.pn = ((ct < 2) ? elo : ehi) * 2 + (ct & 1); u.pn2 = 0; }
        return true;
    }
    __device__ __forceinline__ void rows(const Unit& u, const int (&RA)[2], const int (&CA)[2], int K, unsigned (&vo)[2][2]) const {
        const int cnt = tp[NCLS + 1 + u.e];
#pragma unroll
        for (int h = 0; h < 2; ++h)
#pragma unroll
            for (int i = 0; i < 2; ++i) { const int idx = u.r * 256 + h * HALF + RA[i]; const int tok = (idx < cnt) ? list[u.e * cap + idx] : 0;
                vo[h][i] = (unsigned)(tok * K + CA[i]) * 2u; }
    }
};

typedef f32x4 Acc[2][2][4][2];
struct EpiBf16 {
    static constexpr bool PERM = true, ALIGN = true;
    bf16_t* O; int ldc; bool use_aux;
    __device__ __forceinline__ void operator()(const Acc& acc, const Unit& u, int wr, int wc, int fr_, int fq_) const {
        int ln_ = fr_ | (fq_ << 4); asm volatile("" : "+v"(ln_)); const int fr = ln_ & 15, fq = ln_ >> 4;
        const int row0 = u.pm * BM + wr * 64 + fr; const int col0 = (use_aux ? u.aux : u.pn) * BM + wc * 32 + 8 * fq;
#pragma unroll
        for (int ai = 0; ai < 2; ++ai)
#pragma unroll
            for (int m = 0; m < 4; ++m) { bf16_t* rowp = O + (size_t)(row0 + ai * HALF + m * 16) * ldc + col0;
#pragma unroll
                for (int bj = 0; bj < 2; ++bj) { const f32x4 v0 = acc[ai][bj][m][0], v1 = acc[ai][bj][m][1];
                    u32x4 w; w.x = cvt_pk_bf16(v0[0], v0[1]); w.y = cvt_pk_bf16(v0[2], v0[3]); w.z = cvt_pk_bf16(v1[0], v1[1]); w.w = cvt_pk_bf16(v1[2], v1[3]);
                    *(u32x4*)(rowp + bj * HALF) = w; } }
    }
};
struct EpiGateUp {
    static constexpr bool PERM = true, ALIGN = true;
    bf16_t* O; LAS unsigned char* side;
    __device__ __forceinline__ void operator()(const Acc& acc, const Unit& u, int wr, int wc, int fr_, int fq_) const {
        int ln_ = fr_ | (fq_ << 4); asm volatile("" : "+v"(ln_)); const int fr = ln_ & 15, fq = ln_ >> 4;
        const int row0 = u.pm * BM + wr * 64 + fr; const int col0 = u.aux * HALF + wc * 32 + 8 * fq;
        const LAS float* wp = (const LAS float*)(side + u.slot * 3072 + 1024) + 2 * (wr * 64 + fr) + ((u.aux < 2) ? 0 : 1);
#pragma unroll
        for (int ai = 0; ai < 2; ++ai) { if (ai == 1 && u.half) break;
#pragma unroll
            for (int m = 0; m < 4; ++m) { const int rl = ai * HALF + m * 16; bf16_t* rowp = O + (size_t)(row0 + rl) * 512 + col0;
                const float w = wp[2 * rl];
                float o[8];
#pragma unroll
                for (int n = 0; n < 2; ++n)
#pragma unroll
                    for (int j = 0; j < 4; ++j) o[n * 4 + j] = w * silu_f(acc[ai][0][m][n][j]) * acc[ai][1][m][n][j];
                u32x4 wv; wv.x = cvt_pk_bf16(o[0], o[1]); wv.y = cvt_pk_bf16(o[2], o[3]); wv.z = cvt_pk_bf16(o[4], o[5]); wv.w = cvt_pk_bf16(o[6], o[7]);
                *(u32x4*)rowp = wv; } }
    }
};
template <bool FINAL> struct EpiCombine {
    static constexpr bool PERM = true, ALIGN = true;
    bf16_t* H; float* out; const float* gate; LAS unsigned char* side;
    __device__ __forceinline__ void operator()(const Acc& acc, const Unit& u, int wr, int wc, int fr_, int fq_) const {
        int ln_ = fr_ | (fq_ << 4); asm volatile("" : "+v"(ln_)); const int fr = ln_ & 15, fq = ln_ >> 4;
        const int col0 = u.aux * BM + wc * 32 + 8 * fq;
        const LAS int* tk = (const LAS int*)(side + u.slot * 3072) + wr * 64 + fr;
#pragma unroll
        for (int ai = 0; ai < 2; ++ai)
#pragma unroll
          for (int mp = 0; mp < 4; mp += 2) {
            int tok[2]; u32x4 hw[2][2]; f32x4 gg[2][2][2];
#pragma unroll
            for (int mm = 0; mm < 2; ++mm) { tok[mm] = tk[ai * HALF + (mp + mm) * 16]; const int tc = tok[mm] < 0 ? 0 : tok[mm];
                const float* gb = gate + (size_t)(tc >> 12) * 6144 + col0; const size_t off = (size_t)tc * DM + col0;
#pragma unroll
                for (int bj = 0; bj < 2; ++bj) { hw[mm][bj] = *(const u32x4*)(H + off + bj * HALF); gg[mm][bj][0] = *(const f32x4*)(gb + bj * HALF); gg[mm][bj][1] = *(const f32x4*)(gb + bj * HALF + 4); } }
#pragma unroll
            for (int mm = 0; mm < 2; ++mm) { const int m = mp + mm; const size_t off = (size_t)(tok[mm] < 0 ? 0 : tok[mm]) * DM + col0;
#pragma unroll
                for (int bj = 0; bj < 2; ++bj) { const u32x4 w = hw[mm][bj];
                    const f32x4 h0 = (f32x4){bf_lo(w.x), bf_hi(w.x), bf_lo(w.y), bf_hi(w.y)} + gg[mm][bj][0] * acc[ai][bj][m][0], h1 = (f32x4){bf_lo(w.z), bf_hi(w.z), bf_lo(w.w), bf_hi(w.w)} + gg[mm][bj][1] * acc[ai][bj][m][1];
                    if (tok[mm] >= 0) {
                        if constexpr (FINAL) { *(f32x4*)(out + off + bj * HALF) = h0; *(f32x4*)(out + off + bj * HALF + 4) = h1; }
                        else { u32x4 o; o.x = cvt_pk_bf16(h0[0], h0[1]); o.y = cvt_pk_bf16(h0[2], h0[3]); o.z = cvt_pk_bf16(h1[0], h1[1]); o.w = cvt_pk_bf16(h1[2], h1[3]); *(u32x4*)(H + off + bj * HALF) = o; } } } }
          }
    }
};
template <bool IN_F32> struct EpiResid {
    static constexpr bool PERM = true, ALIGN = true;
    const void* Hin; bf16_t* Hout; const float* gate;
    __device__ __forceinline__ void operator()(const Acc& acc, const Unit& u, int wr, int wc, int fr_, int fq_) const {
        int ln_ = fr_ | (fq_ << 4); asm volatile("" : "+v"(ln_)); const int fr = ln_ & 15, fq = ln_ >> 4;
        const int b = u.pm >> 4; const int col0 = u.pn * BM + wc * 32 + 8 * fq; const float* gb = gate + (size_t)b * 6144 + col0;
        f32x4 gv[2][2];
#pragma unroll
        for (int bj = 0; bj < 2; ++bj)
#pragma unroll
            for (int n = 0; n < 2; ++n) gv[bj][n] = *(const f32x4*)(gb + bj * HALF + 4 * n);
#pragma unroll
        for (int ai = 0; ai < 2; ++ai)
#pragma unroll
          for (int mp = 0; mp < 4; mp += 2) {
            f32x4 hh[2][2][2];
#pragma unroll
            for (int mm = 0; mm < 2; ++mm) { const size_t off = (size_t)(u.pm * BM + ai * HALF + wr * 64 + (mp + mm) * 16 + fr) * DM + col0;
#pragma unroll
                for (int bj = 0; bj < 2; ++bj) {
                    if constexpr (IN_F32) { hh[mm][bj][0] = *(const f32x4*)((const float*)Hin + off + bj * HALF); hh[mm][bj][1] = *(const f32x4*)((const float*)Hin + off + bj * HALF + 4); }
                    else { const u32x4 w = *(const u32x4*)((const bf16_t*)Hin + off + bj * HALF); hh[mm][bj][0] = (f32x4){bf_lo(w.x), bf_hi(w.x), bf_lo(w.y), bf_hi(w.y)}; hh[mm][bj][1] = (f32x4){bf_lo(w.z), bf_hi(w.z), bf_lo(w.w), bf_hi(w.w)}; } } }
#pragma unroll
            for (int mm = 0; mm < 2; ++mm) { const int m = mp + mm; const size_t off = (size_t)(u.pm * BM + ai * HALF + wr * 64 + m * 16 + fr) * DM + col0;
#pragma unroll
                for (int bj = 0; bj < 2; ++bj) { const f32x4 h0 = hh[mm][bj][0] + gv[bj][0] * acc[ai][bj][m][0], h1 = hh[mm][bj][1] + gv[bj][1] * acc[ai][bj][m][1];
                    u32x4 o; o.x = cvt_pk_bf16(h0[0], h0[1]); o.y = cvt_pk_bf16(h0[2], h0[3]); o.z = cvt_pk_bf16(h1[0], h1[1]); o.w = cvt_pk_bf16(h1[2], h1[3]);
                    *(u32x4*)(Hout + off + bj * HALF) = o; } }
          }
    }
};
struct EpiQKV {
    static constexpr bool PERM = true, ALIGN = true;
    bf16_t *Q, *Kb, *Vb, *P; const float *qg, *kg;
    __device__ __forceinline__ void operator()(const Acc& acc, const Unit& u, int wr, int wc, int fr_, int fq_) const {
        int ln_ = fr_ | (fq_ << 4); asm volatile("" : "+v"(ln_)); const int fr = ln_ & 15, fq = ln_ >> 4;
        const int pn = u.pn; const bool isctx = u.pm >= 128;
        const int rloc0 = wr * 64 + fr;
        if (pn >= 3) {
#pragma unroll
            for (int ai = 0; ai < 2; ++ai)
#pragma unroll
                for (int m = 0; m < 4; ++m) { bf16_t* rowp = P + (size_t)(u.pm * BM + rloc0 + ai * HALF + m * 16) * 512 + (pn - 3) * BM + wc * 32 + 8 * fq;
#pragma unroll
                    for (int bj = 0; bj < 2; ++bj) { const f32x4 v0 = acc[ai][bj][m][0], v1 = acc[ai][bj][m][1];
                        u32x4 w; w.x = cvt_pk_bf16(v0[0], v0[1]); w.y = cvt_pk_bf16(v0[2], v0[3]); w.z = cvt_pk_bf16(v1[0], v1[1]); w.w = cvt_pk_bf16(v1[2], v1[3]);
                        *(u32x4*)(rowp + bj * HALF) = w; } }
            return;
        }
        if (pn == 2 && wc >= 2) {
            const int vh = wc - 2;
#pragma unroll
            for (int ai = 0; ai < 2; ++ai)
#pragma unroll
                for (int m = 0; m < 4; ++m) { const int rl = rloc0 + ai * HALF + m * 16; int b, krow;
                    if (isctx) { const int cr = (u.pm - 128) * BM + rl; b = cr >> 8; krow = cr & 255; } else { const int mt = u.pm * BM + rl; b = mt >> 12; krow = CTX + (mt & 4095); }
                    bf16_t* rowp = Vb + ((size_t)(b * 2 + vh) * NKV + krow) * 64 + 8 * fq;
#pragma unroll
                    for (int bj = 0; bj < 2; ++bj) { const f32x4 v0 = acc[ai][bj][m][0], v1 = acc[ai][bj][m][1];
                        u32x4 w; w.x = cvt_pk_bf16(v0[0], v0[1]); w.y = cvt_pk_bf16(v0[2], v0[3]); w.z = cvt_pk_bf16(v1[0], v1[1]); w.w = cvt_pk_bf16(v1[2], v1[3]);
                        *(u32x4*)(rowp + bj * 32) = w; } }
            return;
        }
        const bool isq = pn < 2; const int head = isq ? pn * 4 + wc : wc;
        const float* gsrc = (isq ? qg : kg) + 32 * (fq >> 1) + 8 * (fq & 1);
        float g1[8], g2[8], inv[8];
#pragma unroll
        for (int j = 0; j < 8; ++j) { g1[j] = gsrc[j]; g2[j] = gsrc[16 + j];
            inv[j] = __builtin_amdgcn_exp2f(-(float)(8 * (fq & 1) + j) * (13.287712379549449f / 16.0f)) * 0.15915494309189535f; }
        const float osc = isq ? C2 : 1.0f;
#pragma unroll
        for (int ai = 0; ai < 2; ++ai)
#pragma unroll
            for (int m = 0; m < 4; ++m) {
                const int rl = rloc0 + ai * HALF + m * 16;
                float x1[8], x2[8];
#pragma unroll
                for (int n = 0; n < 2; ++n)
#pragma unroll
                    for (int j = 0; j < 4; ++j) { x1[n * 4 + j] = acc[ai][0][m][n][j]; x2[n * 4 + j] = acc[ai][1][m][n][j]; }
                float ss = 0.f;
#pragma unroll
                for (int j = 0; j < 8; ++j) ss += x1[j] * x1[j] + x2[j] * x2[j];
                ss += __shfl_xor(ss, 16); ss += __shfl_xor(ss, 32);
                const float rstd = __builtin_amdgcn_rsqf(ss * (1.0f / 64.0f) + EPS) * osc;
                int b, krow, mt = 0; float pos = 0.f;
                if (isctx) { const int cr = (u.pm - 128) * BM + rl; b = cr >> 8; krow = cr & 255; }
                else { mt = u.pm * BM + rl; b = mt >> 12; const int t = mt & 4095; krow = CTX + t; pos = (float)((fq >> 1) ? (t & 63) : (t >> 6)); }
                float o1[8], o2[8];
#pragma unroll
                for (int j = 0; j < 8; ++j) { const float y1 = x1[j] * rstd * g1[j], y2 = x2[j] * rstd * g2[j];
                    if (isctx) { o1[j] = y1; o2[j] = y2; }
                    else { const float rev = pos * inv[j]; const float cs = __builtin_amdgcn_cosf(rev), sn = __builtin_amdgcn_sinf(rev);
                        o1[j] = y1 * cs - y2 * sn; o2[j] = y2 * cs + y1 * sn; } }
                bf16_t* rowp = isq ? (Q + (size_t)mt * 512 + head * 64 + 8 * fq) : (Kb + ((size_t)(b * 2 + head) * NKV + krow) * 64 + 8 * fq);
                u32x4 w; w.x = cvt_pk_bf16(o1[0], o1[1]); w.y = cvt_pk_bf16(o1[2], o1[3]); w.z = cvt_pk_bf16(o1[4], o1[5]); w.w = cvt_pk_bf16(o1[6], o1[7]);
                *(u32x4*)rowp = w;
                w.x = cvt_pk_bf16(o2[0], o2[1]); w.y = cvt_pk_bf16(o2[2], o2[3]); w.z = cvt_pk_bf16(o2[4], o2[5]); w.w = cvt_pk_bf16(o2[6], o2[7]);
                *(u32x4*)(rowp + 32) = w;
            }
    }
};
}

namespace attn_body {
constexpr int NW = 8, QBLK = 32, QB = QBLK * NW, KVBLK = 64, NT = NKV / KVBLK;
constexpr int QP = 512, KP = 64, OP = 1024;
static_assert(NT % 2 == 0 && NT >= 8, "tile count");
__device__ __forceinline__ int crow(int r, int hi) { return (r & 3) + 8 * (r >> 2) + 4 * hi; }
#define SBAR() __builtin_amdgcn_sched_barrier(0)
constexpr int NSLOT = 3, SLOTB = 8192;
constexpr int LDS_K = 0, LDS_V = NSLOT * SLOTB, LDS_WS = 2 * NSLOT * SLOTB, LDS_OST = LDS_WS + NW * 64 * 4, ATT_LDS_BYTES = LDS_OST + NW * 4096;
__device__ __forceinline__ void glds16(const void* gsrc, unsigned lds_dst) { unsigned keep;
    asm volatile("s_mov_b32 %0, m0\n\ts_mov_b32 m0, %2\n\ts_nop 0\n\tglobal_load_lds_dwordx4 %1, off\n\ts_mov_b32 m0, %0" : "=&s"(keep) : "v"(gsrc), "s"(lds_dst) : "memory"); }
__device__ __forceinline__ float max3f(float a, float b, float c) { float r; asm("v_max3_f32 %0, %1, %2, %3" : "=v"(r) : "v"(a), "v"(b), "v"(c)); return r; }
__device__ __forceinline__ float max2f(float a, float b) { float r; asm("v_max_f32_e32 %0, %1, %2" : "=v"(r) : "v"(a), "v"(b)); return r; }
__device__ __forceinline__ float fadd_s(float a, float b) { float r; asm("v_add_f32_e32 %0, %1, %2" : "=v"(r) : "v"(a), "v"(b)); return r; }
__device__ __forceinline__ float fsub_s(float a, float b) { float r; asm("v_sub_f32_e32 %0, %1, %2" : "=v"(r) : "v"(a), "v"(b)); return r; }
typedef __bf16 bf16x2_t __attribute__((ext_vector_type(2)));
__device__ __forceinline__ unsigned cvtpk_s(float lo, float hi) { f32x2 v = {lo, hi}; bf16x2_t b = __builtin_convertvector(v, bf16x2_t); return __builtin_bit_cast(unsigned, b); }
#define WAIT_BAR(N) asm volatile("s_waitcnt vmcnt(" #N ") lgkmcnt(0)\n\ts_barrier" ::: "memory")
__device__ __forceinline__ void qkt(f32x16& p0, f32x16& p1, const char* Kslot, const bf16x8* qr, const f32x16& negm, int r32, int hi) {
    const char* kb = Kslot + hi * 1024 + r32 * 16;
#pragma unroll
    for (int d0 = 0; d0 < 4; ++d0) {
        const bf16x8 b0 = *reinterpret_cast<const bf16x8*>(kb + d0 * 2048);
        const bf16x8 b1 = *reinterpret_cast<const bf16x8*>(kb + d0 * 2048 + 512);
        if (d0 == 0) { p0 = __builtin_amdgcn_mfma_f32_32x32x16_bf16(b0, qr[0], negm, 0, 0, 0); p1 = __builtin_amdgcn_mfma_f32_32x32x16_bf16(b1, qr[0], negm, 0, 0, 0); }
        else { p0 = __builtin_amdgcn_mfma_f32_32x32x16_bf16(b0, qr[d0], p0, 0, 0, 0); p1 = __builtin_amdgcn_mfma_f32_32x32x16_bf16(b1, qr[d0], p1, 0, 0, 0); } }
}
typedef __attribute__((address_space(3))) const char* lds_cptr;
typedef short v4i16_t __attribute__((ext_vector_type(4)));
__device__ __forceinline__ void kload8(bf16x8* kf, lds_cptr kp) {
    kf[0] = *(const LAS bf16x8*)(kp);        kf[1] = *(const LAS bf16x8*)(kp + 512);
    kf[2] = *(const LAS bf16x8*)(kp + 2048); kf[3] = *(const LAS bf16x8*)(kp + 2560);
    kf[4] = *(const LAS bf16x8*)(kp + 4096); kf[5] = *(const LAS bf16x8*)(kp + 4608);
    kf[6] = *(const LAS bf16x8*)(kp + 6144); kf[7] = *(const LAS bf16x8*)(kp + 6656);
}
__device__ __forceinline__ void kload2(bf16x8* kf, lds_cptr kp, int j) { kf[2 * j] = *(const LAS bf16x8*)(kp + j * 2048); kf[2 * j + 1] = *(const LAS bf16x8*)(kp + j * 2048 + 512); }
__device__ __forceinline__ s16x4 vtr(lds_cptr p) { return __builtin_bit_cast(s16x4, __builtin_amdgcn_ds_read_tr16_b64_v4i16((LAS v4i16_t*)p)); }
__device__ __forceinline__ float rowmax(const f32x16& p0, const f32x16& p1) {
    float a = max3f(p0[0], p0[1], p1[0]), b = max3f(p0[2], p0[3], p1[1]); a = max3f(a, p1[2], p1[3]);
#pragma unroll
    for (int r = 4; r < 16; r += 4) { a = max3f(a, p0[r], p0[r + 1]); b = max3f(b, p0[r + 2], p0[r + 3]); a = max3f(a, p1[r], p1[r + 1]); b = max3f(b, p1[r + 2], p1[r + 3]); }
    const float m = max2f(a, b);
    auto rr = __builtin_amdgcn_permlane32_swap(__float_as_uint(m), __float_as_uint(m), false, false);
    return max2f(__uint_as_float(rr[0]), __uint_as_float(rr[1]));
}
__device__ __forceinline__ void pv(f32x16* o, int vb, bf16x8 pa0, bf16x8 pa1, bf16x8 pa2, bf16x8 pa3) {
#pragma unroll
    for (int d0 = 0; d0 < 2; ++d0) { s16x4 lo[4], hi[4];
#pragma unroll
        for (int ks = 0; ks < 4; ++ks) {
            asm volatile("ds_read_b64_tr_b16 %0,%1 offset:%c2" : "=&v"(lo[ks]) : "v"(vb), "i"(d0 * 4096 + ks * 1024) : "memory");
            asm volatile("ds_read_b64_tr_b16 %0,%1 offset:%c2" : "=&v"(hi[ks]) : "v"(vb), "i"(d0 * 4096 + ks * 1024 + 512) : "memory"); }
        asm volatile("s_waitcnt lgkmcnt(0)" ::: "memory"); SBAR();
#define PK(k) (bf16x8){lo[k][0], lo[k][1], lo[k][2], lo[k][3], hi[k][0], hi[k][1], hi[k][2], hi[k][3]}
        o[d0] = __builtin_amdgcn_mfma_f32_32x32x16_bf16(pa0, PK(0), o[d0], 0, 0, 0);
        o[d0] = __builtin_amdgcn_mfma_f32_32x32x16_bf16(pa1, PK(1), o[d0], 0, 0, 0);
        o[d0] = __builtin_amdgcn_mfma_f32_32x32x16_bf16(pa2, PK(2), o[d0], 0, 0, 0);
        o[d0] = __builtin_amdgcn_mfma_f32_32x32x16_bf16(pa3, PK(3), o[d0], 0, 0, 0);
#undef PK
    }
}
template <int THRL> __device__ __forceinline__ void attn_unit(int b, int h, int qb, const bf16_t* Q, const bf16_t* __restrict__ K, const bf16_t* __restrict__ V, bf16_t* O, char* shm, float ref) {
    const int tid = opaque_tid(), lane = tid & 63, r32 = lane & 31, hi = lane >> 5; const int wid = __builtin_amdgcn_readfirstlane(tid >> 6);
    const long rowq = (long)b * SEQ + qb * QB + wid * QBLK;
    const bf16_t* Qw = Q + rowq * QP + h * 64;
    const bf16_t* Kh = K + (long)(b * 2 + (h >> 2)) * NKV * KP, *Vh = V + (long)(b * 2 + (h >> 2)) * NKV * KP;
    const unsigned lds0 = (unsigned)(uintptr_t)shm;
    float* wsf = (float*)(shm + LDS_WS) + wid * 64;
    const bf16_t* ksrc = Kh + (long)lane * KP + wid * 8;
    const bf16_t* vsrc = Vh + (long)(16 * (wid & 3) + (lane >> 2)) * KP + (wid >> 2) * 32 + (lane & 3) * 8;
    const unsigned kdst = lds0 + LDS_K + wid * 1024, vdst = lds0 + LDS_V + wid * 1024;
#define DMA_K(t, slot) glds16(ksrc + (long)(t) * KVBLK * KP, (unsigned)__builtin_amdgcn_readfirstlane(kdst + (slot)))
#define DMA_V(t, slot) glds16(vsrc + (long)(t) * KVBLK * KP, (unsigned)__builtin_amdgcn_readfirstlane(vdst + (slot)))
    const int vb0 = (int)(lds0 + LDS_V) + ((lane >> 4) & 1) * 32 + (lane & 3) * 8 + (4 * hi + ((lane & 15) >> 2)) * 64;
    const char* Kbase = shm + LDS_K; bf16x8 kf[8];
    const lds_cptr shm3 = (lds_cptr)shm; const lds_cptr kp0 = shm3 + LDS_K + hi * 1024 + r32 * 16; const lds_cptr vp0 = shm3 + LDS_V + ((lane >> 4) & 1) * 32 + (lane & 3) * 8 + (4 * hi + ((lane & 15) >> 2)) * 64;
    DMA_K(0, 0); DMA_V(0, 0); DMA_K(1, SLOTB);
    bf16x8 qr[4];
#pragma unroll
    for (int d0 = 0; d0 < 4; ++d0) qr[d0] = *reinterpret_cast<const bf16x8*>(&Qw[(long)r32 * QP + d0 * 16 + hi * 8]);
    float l_reg = 0.f; f32x16 o[2]; o[0] = f32x16{}; o[1] = f32x16{}; f32x16 negm;
#pragma unroll
    for (int r = 0; r < 16; ++r) negm[r] = -ref;
    asm volatile("" : "+v"(negm));
#define START(P0, P1) do { _Pragma("unroll") for (int r = 0; r < 16; ++r) P0[r] = __builtin_amdgcn_exp2f(P0[r]); } while (0)
#define RESC() do { } while (0)
    f32x16 pA0, pA1, pB0, pB1;
    int sl_prev = 0, sl_cur = 0, sl_next = SLOTB;
#define ROT() do { sl_prev = sl_cur; sl_cur = sl_next; sl_next = (sl_next == (NSLOT - 1) * SLOTB) ? 0 : sl_next + SLOTB; } while (0)
    DMA_K(2, 2 * SLOTB);
    WAIT_BAR(3);
    qkt(pA0, pA1, Kbase, qr, negm, r32, hi); asm volatile("s_nop 15\n\ts_nop 7" : "+v"(pA0), "+v"(pA1));
    START(pA0, pA1);
    _Pragma("unroll") for (int r = 0; r < 16; ++r) pA1[r] = __builtin_amdgcn_exp2f(pA1[r]);
    WAIT_BAR(0);
    DMA_K(3, 0); DMA_V(1, SLOTB);
    ROT();
    kload8(kf, kp0 + sl_cur);
    WAIT_BAR(2);
    s16x4 vlo[8], vhi[8]; u32x4 pw0, pw1, pw2, pw3;
#define PKW(P, B) cvtpk_s(P[B], P[B + 1])
#define PAF(k) __builtin_bit_cast(bf16x8, pw##k)
#define VFR(i) (bf16x8){vlo[i][0], vlo[i][1], vlo[i][2], vlo[i][3], vhi[i][0], vhi[i][1], vhi[i][2], vhi[i][3]}
#define PIN(x) asm volatile("" : "+v"(x))
#define MX3(a, b, c) __builtin_fmaxf(__builtin_fmaxf((a), (b)), (c))
#define GAPA(MF, A0, A1, A2, A3, W0, W1, PW) do { MF; sacc += A0; sacc += A1; sacc += A2; sacc += A3; PIN(sacc); W0; W1; PIN(PW); SBAR(); } while (0)
#define EX(v) __builtin_amdgcn_exp2f(v)
#define GAPB(MF, X, B) do { MF; X[B] = EX(X[B]); X[B + 1] = EX(X[B + 1]); X[B + 2] = EX(X[B + 2]); X[B + 3] = EX(X[B + 3]); PIN(X); SBAR(); } while (0)
#define VRD(i) do { vlo[i] = vtr(vp_ + (((i) >> 2) * 4096 + ((i) & 3) * 1024)); vhi[i] = vtr(vp_ + (((i) >> 2) * 4096 + ((i) & 3) * 1024 + 512)); } while (0)
#define KRD(G, j) do { if (G) { kload2(kf, kp0 + sl_next, j); SBAR(); } } while (0)
#define STEP(C0, C1, P0, P1, t, GK, GV, GL) do { SBAR(); \
    const lds_cptr vp_ = vp0 + sl_prev; \
    VRD(0); SBAR(); float sacc = (P0[0] + P0[1]); \
    GAPA(C0 = __builtin_amdgcn_mfma_f32_32x32x16_bf16(kf[0], qr[0], negm, 0, 0, 0), P0[2], P0[3], P0[4], P0[5],     pw0[0] = PKW(P0, 0), pw0[1] = PKW(P0, 2), pw0); \
    VRD(4); SBAR(); GAPA(C1 = __builtin_amdgcn_mfma_f32_32x32x16_bf16(kf[1], qr[0], negm, 0, 0, 0), P0[6], P0[7], P0[8], P0[9],     pw0[2] = PKW(P0, 4), pw0[3] = PKW(P0, 6), pw0); \
    VRD(1); SBAR(); GAPA(C0 = __builtin_amdgcn_mfma_f32_32x32x16_bf16(kf[2], qr[1], C0, 0, 0, 0),   P0[10], P0[11], P0[12], P0[13], pw1[0] = PKW(P0, 8), pw1[1] = PKW(P0, 10), pw1); \
    VRD(5); SBAR(); GAPA(C1 = __builtin_amdgcn_mfma_f32_32x32x16_bf16(kf[3], qr[1], C1, 0, 0, 0),   P0[14], P0[15], P1[0], P1[1],   pw1[2] = PKW(P0, 12), pw1[3] = PKW(P0, 14), pw1); \
    VRD(2); SBAR(); GAPA(C0 = __builtin_amdgcn_mfma_f32_32x32x16_bf16(kf[4], qr[2], C0, 0, 0, 0),   P1[2], P1[3], P1[4], P1[5],     pw2[0] = PKW(P1, 0), pw2[1] = PKW(P1, 2), pw2); \
    VRD(6); SBAR(); GAPA(C1 = __builtin_amdgcn_mfma_f32_32x32x16_bf16(kf[5], qr[2], C1, 0, 0, 0),   P1[6], P1[7], P1[8], P1[9],     pw2[2] = PKW(P1, 4), pw2[3] = PKW(P1, 6), pw2); \
    VRD(3); SBAR(); GAPA(C0 = __builtin_amdgcn_mfma_f32_32x32x16_bf16(kf[6], qr[3], C0, 0, 0, 0),   P1[10], P1[11], P1[12], P1[13], pw3[0] = PKW(P1, 8), pw3[1] = PKW(P1, 10), pw3); \
    VRD(7); SBAR(); GAPA(C1 = __builtin_amdgcn_mfma_f32_32x32x16_bf16(kf[7], qr[3], C1, 0, 0, 0),   P1[14], P1[15], 0.f, 0.f,       pw3[2] = PKW(P1, 12), pw3[3] = PKW(P1, 14), pw3); \
    l_reg += sacc; \
    if (GK) { DMA_K((t) + 3, sl_cur); } if (GV) { DMA_V((t) + 1, sl_next); } \
    SBAR(); \
    GAPB(o[0] = __builtin_amdgcn_mfma_f32_32x32x16_bf16(PAF(0), VFR(0), o[0], 0, 0, 0), C0, 0); \
    GAPB(o[1] = __builtin_amdgcn_mfma_f32_32x32x16_bf16(PAF(0), VFR(4), o[1], 0, 0, 0), C0, 4); \
    KRD(GL, 0); GAPB(o[0] = __builtin_amdgcn_mfma_f32_32x32x16_bf16(PAF(1), VFR(1), o[0], 0, 0, 0), C0, 8); \
    KRD(GL, 1); GAPB(o[1] = __builtin_amdgcn_mfma_f32_32x32x16_bf16(PAF(1), VFR(5), o[1], 0, 0, 0), C0, 12); \
    KRD(GL, 2); GAPB(o[0] = __builtin_amdgcn_mfma_f32_32x32x16_bf16(PAF(2), VFR(2), o[0], 0, 0, 0), C1, 0); \
    KRD(GL, 3); GAPB(o[1] = __builtin_amdgcn_mfma_f32_32x32x16_bf16(PAF(2), VFR(6), o[1], 0, 0, 0), C1, 4); \
    GAPB(o[0] = __builtin_amdgcn_mfma_f32_32x32x16_bf16(PAF(3), VFR(3), o[0], 0, 0, 0), C1, 8); \
    GAPB(o[1] = __builtin_amdgcn_mfma_f32_32x32x16_bf16(PAF(3), VFR(7), o[1], 0, 0, 0), C1, 12); \
    } while (0)
    int t = 1;
    for (; t + 5 < NT; t += 2) {
        STEP(pB0, pB1, pA0, pA1, t, true, true, true);     WAIT_BAR(2); RESC(); ROT();
        STEP(pA0, pA1, pB0, pB1, t + 1, true, true, true); WAIT_BAR(2); RESC(); ROT();
    }
#define ENDW(tt) do { if ((tt) + 3 < NT) { WAIT_BAR(2); } else if ((tt) + 2 < NT) { WAIT_BAR(1); } else { WAIT_BAR(0); } } while (0)
    for (; t + 1 < NT; t += 2) {
        STEP(pB0, pB1, pA0, pA1, t, (t + 3 < NT), (t + 1 < NT), (t + 1 < NT));         ENDW(t);     RESC(); ROT();
        STEP(pA0, pA1, pB0, pB1, t + 1, (t + 4 < NT), (t + 2 < NT), (t + 2 < NT));     ENDW(t + 1); RESC(); ROT();
    }
    STEP(pB0, pB1, pA0, pA1, NT - 1, false, false, false); RESC();
    { float sacc = pB0[0] + pB0[1]; _Pragma("unroll") for (int r = 2; r < 16; ++r) sacc += pB0[r]; _Pragma("unroll") for (int r = 0; r < 16; ++r) sacc += pB1[r]; l_reg += sacc;
      pw0 = (u32x4){PKW(pB0, 0), PKW(pB0, 2), PKW(pB0, 4), PKW(pB0, 6)}; pw1 = (u32x4){PKW(pB0, 8), PKW(pB0, 10), PKW(pB0, 12), PKW(pB0, 14)}; pw2 = (u32x4){PKW(pB1, 0), PKW(pB1, 2), PKW(pB1, 4), PKW(pB1, 6)}; pw3 = (u32x4){PKW(pB1, 8), PKW(pB1, 10), PKW(pB1, 12), PKW(pB1, 14)};
      SBAR(); pv(o, vb0 + sl_cur, PAF(0), PAF(1), PAF(2), PAF(3)); }
#undef PKW
#undef PAF
#undef VFR
#undef PIN
#undef MX3
#undef GAPA
#undef GAPB
#undef EX
#undef VRD
#undef KRD
#undef STEP
#undef ENDW
    { auto rr = __builtin_amdgcn_permlane32_swap(__float_as_uint(l_reg), __float_as_uint(l_reg), false, false); l_reg = __uint_as_float(rr[0]) + __uint_as_float(rr[1]); }
    if (hi == 0) wsf[32 + r32] = l_reg; asm volatile("s_waitcnt lgkmcnt(0)" ::: "memory");
    float rli[16];
#pragma unroll
    for (int r = 0; r < 16; ++r) rli[r] = __builtin_amdgcn_rcpf(wsf[32 + crow(r, hi)]);
    bf16_t* Ow = O + rowq * OP + h * 64;
    { bf16_t* stg = (bf16_t*)(shm + LDS_OST) + wid * 2048;
#pragma unroll
      for (int r = 0; r < 16; ++r) { const int orow = crow(r, hi);
#pragma unroll
        for (int d0 = 0; d0 < 2; ++d0) stg[orow * 64 + d0 * 32 + r32] = (bf16_t)(cvtpk_s(o[d0][r] * rli[r], 0.f) & 0xffffu); }
      asm volatile("s_waitcnt lgkmcnt(0)" ::: "memory");
#pragma unroll
      for (int i = 0; i < 4; ++i) { const int row = i * 8 + (lane >> 3), ch = lane & 7; const u32x4 v = *(const u32x4*)(stg + row * 64 + ch * 8); *(u32x4*)(Ow + (long)row * OP + ch * 8) = v; } }
    asm volatile("s_waitcnt lgkmcnt(0)\n\ts_barrier" ::: "memory");
#undef DMA_K
#undef DMA_V
#undef START
#undef RESC
#undef ROT
}
#undef SBAR
#undef WAIT_BAR
}

#define LDS_WAIT() asm volatile("s_waitcnt lgkmcnt(0)" ::: "memory")
constexpr int TP_OFF = LDSCTL_OFF + 512;
struct Args { const float* in[27]; float* out; unsigned char* ws; };
struct Grp { int id, NH, Gh, vh, tok0, ntok, b0, nb; };
enum { I_X = 0, I_C, I_CTX, I_CCTX, I_MODW, I_MODB, I_N1G, I_N2G, I_EWIN, I_QG, I_KG, I_POOLW, I_POOLS, I_EWOUT, I_OWIN, I_SGG, I_SGW, I_SGB, I_CONVW, I_OWOUT,
       I_RGW, I_RGB, I_REW, I_REB, I_WG, I_WU, I_WD };

__device__ __forceinline__ int map_in0(int n) {
    if (n < 640) { const int hd = n >> 6, e = n & 63; const int s = e >> 5, r = e & 31, bj = r >> 4, i = r & 15, j = 16 * s + i;
        const int pn = (hd < 8) ? (hd >> 2) : 2, wc = (hd < 8) ? (hd & 3) : (hd - 8); return 256 * pn + 128 * bj + 32 * wc + j; }
    if (n < 768) { const int vh = (n - 640) >> 6, e = n & 63, bj = e >> 5, j = e & 31; return 512 + 128 * bj + 32 * (2 + vh) + j; }
    return n;
}
struct TrItem { const float* W; int K, N; bf16_t* WT; int kind, off, item; };
__device__ __forceinline__ void tr_load(const TrItem& t, int lane, float (&tv)[32]) {
    const int nblk = t.N / 32, kb = t.item / nblk, nb = t.item % nblk, k0 = 64 * kb, n0 = 32 * nb;
#pragma unroll
    for (int i = 0; i < 32; ++i) tv[i] = t.W[(size_t)(k0 + 2 * i + (lane >> 5)) * t.N + n0 + (lane & 31)];
}
__device__ __forceinline__ void tr_store(const TrItem& t, int lane, const float (&tv)[32], LAS float* scr) {
    const int nblk = t.N / 32, kb = t.item / nblk, nb = t.item % nblk, k0 = 64 * kb, n0 = 32 * nb;
#pragma unroll
    for (int i = 0; i < 32; ++i) scr[(2 * i + (lane >> 5)) * 33 + (lane & 31)] = tv[i];
    LDS_WAIT(); asm volatile("" ::: "memory");
    const int c = lane & 7;
#pragma unroll
    for (int j = 0; j < 4; ++j) { const int n = (lane >> 3) + 8 * j; const LAS float* s = scr + (8 * c) * 33 + n; const int ng = n0 + n;
        const int dst = (t.kind == 1) ? map_in0(ng) : (t.kind == 2) ? t.off + 256 * (ng >> 7) + (ng & 127) : t.off + ng;
        u32x4 o; o.x = cvt_pk_bf16(s[0 * 33], s[1 * 33]); o.y = cvt_pk_bf16(s[2 * 33], s[3 * 33]); o.z = cvt_pk_bf16(s[4 * 33], s[5 * 33]); o.w = cvt_pk_bf16(s[6 * 33], s[7 * 33]);
        *(u32x4*)(t.WT + (size_t)dst * t.K + k0 + 8 * c) = o; }
    LDS_WAIT(); asm volatile("" ::: "memory");
}
__device__ __forceinline__ void p0_prologue(const Args& a, LAS unsigned char* lds, int tid, int lane, int wave, int vcu, int G) {
    unsigned char* ws = a.ws;
    {
        LAS float* sc = (LAS float*)lds;
        LAS float* red = (LAS float*)(lds + 36864);
        for (int idx = tid; idx < 9 * 1024; idx += 512) { const int r = idx >> 10, k = idx & 1023; const float v = (r < 8) ? a.in[I_C][r * 1024 + k] : a.in[I_CCTX][k]; sc[idx] = silu_f(v); }
        __syncthreads();
        float* MOD = (float*)(ws + WS_MOD);
        for (int unit = blockIdx.x; unit < 256; unit += G) {
            const int l = unit >> 7, n0 = (unit & 127) * 48;
            const int ks = lane / 12, c4 = lane % 12; const bool act = lane < 60;
            const float* Wm = a.in[I_MODW] + (size_t)l * 1024 * 6144 + n0 + 4 * c4;
            f32x4 acc4[9];
#pragma unroll
            for (int r = 0; r < 9; ++r) acc4[r] = (f32x4){0.f, 0.f, 0.f, 0.f};
#pragma unroll 1
            for (int it0 = 0; it0 < 26; it0 += 13) {
                f32x4 wv[13];
#pragma unroll
                for (int i = 0; i < 13; ++i) { const int kr = 5 * (it0 + i) + ks; const bool ok = act && kr < 128;
                    wv[i] = ok ? *(const f32x4*)(Wm + (size_t)(wave * 128 + kr) * 6144) : (f32x4){0.f, 0.f, 0.f, 0.f}; }
#pragma unroll
                for (int i = 0; i < 13; ++i) { const int kr = 5 * (it0 + i) + ks; const int kk = wave * 128 + (kr < 128 ? kr : 127);
#pragma unroll
                    for (int r = 0; r < 9; ++r) acc4[r] += sc[r * 1024 + kk] * wv[i]; }
            }
            if (act) {
#pragma unroll
                for (int r = 0; r < 9; ++r) *(LAS f32x4*)(red + ((wave * 5 + ks) * 9 + r) * 48 + 4 * c4) = acc4[r]; }
            __syncthreads();
            for (int idx = tid; idx < 9 * 48; idx += 512) { const int r = idx / 48, cl = idx % 48; float sum = a.in[I_MODB][l * 6144 + n0 + cl];
#pragma unroll 8
                for (int w = 0; w < 40; ++w) sum += red[(w * 9 + r) * 48 + cl];
                MOD[(size_t)(l * 9 + r) * 6144 + n0 + cl] = sum; }
            __syncthreads();
        }
    }
}
__device__ __forceinline__ void convert_weights(const Args& a, LAS unsigned char* lds, int set, int lane, int wave, int worker, int nworkers) {
    unsigned char* ws = a.ws;
    LAS float* scr = (LAS float*)(lds + wave * 16384);
    constexpr int I0 = 16 * 40, I1 = 16 * 32, I2 = 16 * 80, I3 = 16 * 32, IGU = 128, IDN = 128, IPL = 8, HL = 16 * 128;
    constexpr int E0 = I0, E1 = E0 + I1, E2 = E1 + I2, E3 = E2 + I3, E4 = E3 + 32 * IGU, E5 = E4 + 32 * IGU, E6 = E5 + 32 * IDN, E7 = E6 + 4 * IPL;
    constexpr int N1A = E1 - E0, N1 = N1A + 3 * HL + 4 * IPL, N2 = 3 * HL, N3 = E3 - E1;
    const int nitems = (set == 0) ? E0 : (set == 1) ? N1 : (set == 2) ? N2 : N3;
    auto remap = [&](int v) -> int {
        if (set == 0) return v;
        if (set == 3) return E1 + v;
        if (set == 1) { if (v < N1A) return E0 + v; v -= N1A; if (v < HL) return E3 + v; v -= HL; if (v < HL) return E4 + v; v -= HL; if (v < HL) return E5 + v; v -= HL; return E6 + v; }
        if (v < HL) return E3 + HL + v; v -= HL; if (v < HL) return E4 + HL + v; v -= HL; return E5 + HL + v; };
    auto mk = [&](int v) -> TrItem { const int it = remap(v); TrItem t;
        if (it < E0) t = TrItem{a.in[I_EWIN], 1024, 1280, (bf16_t*)(ws + WS_WIN0), 1, 0, it};
        else if (it < E1) t = TrItem{a.in[I_EWOUT], 1024, 1024, (bf16_t*)(ws + WS_WOUT0), 0, 0, it - E0};
        else if (it < E2) t = TrItem{a.in[I_OWIN], 1024, 2560, (bf16_t*)(ws + WS_WIN1), 0, 0, it - E1};
        else if (it < E3) t = TrItem{a.in[I_OWOUT], 1024, 1024, (bf16_t*)(ws + WS_WOUT1), 0, 0, it - E2};
        else if (it < E4) { const int r = it - E3, le = r / IGU;
            t = TrItem{a.in[I_WG] + (size_t)le * 1024 * 256, 1024, 256, (bf16_t*)(ws + WS_WGU) + (size_t)(le >> 4) * 8192 * 1024, 2, (le & 15) * 512, r % IGU}; }
        else if (it < E5) { const int r = it - E4, le = r / IGU;
            t = TrItem{a.in[I_WU] + (size_t)le * 1024 * 256, 1024, 256, (bf16_t*)(ws + WS_WGU) + (size_t)(le >> 4) * 8192 * 1024, 2, (le & 15) * 512 + 128, r % IGU}; }
        else if (it < E6) { const int r = it - E5, le = r / IDN;
            t = TrItem{a.in[I_WD] + (size_t)le * 256 * 1024, 256, 1024, (bf16_t*)(ws + WS_WDN) + (size_t)(le >> 4) * 16384 * 256, 0, (le & 15) * 1024, r % IDN}; }
        else { const int r = it - E6, g = r / IPL;
            t = TrItem{a.in[I_POOLW] + (size_t)g * 128 * 128, 128, 128, (bf16_t*)(ws + WS_WPOOL), 0, g * 128, r % IPL}; }
        return t; };
    {   float tvA[32], tvB[32];
        int it = worker; TrItem cur{}; if (it < nitems) { cur = mk(it); tr_load(cur, lane, tvA); }
        for (; it < nitems; it += 2 * nworkers) {
            const int itB = it + nworkers, itC = it + 2 * nworkers; TrItem tb{}, tc{};
            if (itB < nitems) { tb = mk(itB); tr_load(tb, lane, tvB); }
            tr_store(cur, lane, tvA, scr);
            if (itC < nitems) { tc = mk(itC); tr_load(tc, lane, tvA); }
            if (itB < nitems) tr_store(tb, lane, tvB, scr);
            cur = tc;
        }
    }
    if (set == 3) {
        for (int idx = worker * 64 + lane; idx < 4 * 128 * 128; idx += nworkers * 64) { const int x = idx & 15; const int q = (x & 3) + 8 * ((x >> 2) & 1) + 4 * (x >> 3);
            const float v = a.in[I_SGW][(idx & ~15) + q]; ((bf16_t*)(ws + WS_WSG))[idx] = (bf16_t)(cvt_pk_bf16(v, 0.f) & 0xffffu); } }
}

__device__ __forceinline__ void load_vec16(const float* p, int lane, f32x4 (&v)[4]) {
#pragma unroll
    for (int j = 0; j < 2; ++j)
#pragma unroll
        for (int q = 0; q < 2; ++q) v[2 * j + q] = *(const f32x4*)(p + 8 * lane + 512 * j + 4 * q);
}
__device__ __forceinline__ void load_vec16_nt(const float* p, int lane, f32x4 (&v)[4]) {
#pragma unroll
    for (int j = 0; j < 2; ++j)
#pragma unroll
        for (int q = 0; q < 2; ++q) v[2 * j + q] = __builtin_nontemporal_load((const f32x4*)(p + 8 * lane + 512 * j + 4 * q));
}
__device__ __forceinline__ void load_row_bf16(const bf16_t* p, int lane, f32x4 (&v)[4]) {
#pragma unroll
    for (int j = 0; j < 2; ++j) { const u32x4 w = *(const u32x4*)(p + 8 * lane + 512 * j);
        v[2 * j] = (f32x4){bf_lo(w.x), bf_hi(w.x), bf_lo(w.y), bf_hi(w.y)}; v[2 * j + 1] = (f32x4){bf_lo(w.z), bf_hi(w.z), bf_lo(w.w), bf_hi(w.w)}; }
}
__device__ __forceinline__ void store_row_bf16(bf16_t* p, int lane, const f32x4 (&v)[4]) {
#pragma unroll
    for (int j = 0; j < 2; ++j) { u32x4 w; w.x = cvt_pk_bf16(v[2 * j][0], v[2 * j][1]); w.y = cvt_pk_bf16(v[2 * j][2], v[2 * j][3]); w.z = cvt_pk_bf16(v[2 * j + 1][0], v[2 * j + 1][1]); w.w = cvt_pk_bf16(v[2 * j + 1][2], v[2 * j + 1][3]);
        *(u32x4*)(p + 8 * lane + 512 * j) = w; }
}
__device__ __forceinline__ float sumsq16(const f32x4 (&v)[4]) { float s = 0.f;
#pragma unroll
    for (int i = 0; i < 4; ++i) s += (v[i][0] * v[i][0] + v[i][1] * v[i][1]) + (v[i][2] * v[i][2] + v[i][3] * v[i][3]);
    return s; }
__device__ __forceinline__ void load_mod(const float* mod, const float* gain, int l, int r, int cs, int lane, f32x4 (&gm)[4], f32x4 (&sh)[4]) {
    const float* mr = mod + (size_t)(l * 9 + r) * 6144 + cs * 1024; f32x4 g[4], s[4];
    load_vec16(gain + l * 1024, lane, g); load_vec16(mr + 1024, lane, s); load_vec16(mr, lane, sh);
#pragma unroll
    for (int i = 0; i < 4; ++i) gm[i] = g[i] * (1.0f + s[i]);
}
__device__ __forceinline__ void p1_ln_rows(const Args& a, const Grp& g, int lane, int wave) {
    const float* mod = (const float*)(a.ws + WS_MOD); bf16_t* AB = (bf16_t*)(a.ws + WS_ABUF);
    const int gwh = g.vh * NWAVES + wave, NGWh = g.Gh * NWAVES, nrows = g.ntok + g.nb * CTX;
    const int rpw = (nrows + NGWh - 1) / NGWh, m0 = gwh * rpw, m1 = (m0 + rpw < nrows) ? m0 + rpw : nrows;
    int curb = -1; f32x4 gm[4], sh[4];
    for (int mm = m0; mm < m1; mm += 4) {
        f32x4 vv[4][4]; int mr[4];
#pragma unroll
        for (int r = 0; r < 4; ++r) { const int ml = (mm + r < m1) ? mm + r : mm; mr[r] = (ml < g.ntok) ? g.tok0 + ml : MT + g.b0 * CTX + (ml - g.ntok);
            load_vec16_nt((mr[r] < MT) ? a.in[I_X] + (size_t)mr[r] * 1024 : a.in[I_CTX] + (size_t)(mr[r] - MT) * 1024, lane, vv[r]); }
#pragma unroll
        for (int r = 0; r < 4; ++r) { const int m = mr[r]; if (r && mm + r >= m1) break;
            const int b = (m < MT) ? (m >> 12) : 8;
            if (b != curb) { load_mod(mod, a.in[I_N1G], 0, b, 0, lane, gm, sh); curb = b; }
            const float rstd = __builtin_amdgcn_rsqf(wave_sum(sumsq16(vv[r])) * (1.0f / 1024.0f) + EPS);
#pragma unroll
            for (int i = 0; i < 4; ++i) vv[r][i] = vv[r][i] * rstd * gm[i] + sh[i];
            store_row_bf16(AB + (size_t)m * 1024, lane, vv[r]); }
    }
}
template <class T> __device__ __forceinline__ void copy_rows(const T* src, float* dst, int lane, int gw, int NGW, int tok0 = 0, int ntok = MT) {
    for (int m = tok0 + gw; m < tok0 + ntok; m += NGW) { f32x4 v[4]; if constexpr (sizeof(T) == 4) load_vec16((const float*)src + (size_t)m * 1024, lane, v); else load_row_bf16((const bf16_t*)src + (size_t)m * 1024, lane, v);
#pragma unroll
        for (int j = 0; j < 2; ++j)
#pragma unroll
            for (int q = 0; q < 2; ++q) *(f32x4*)(dst + (size_t)m * 1024 + 8 * lane + 512 * j + 4 * q) = v[2 * j + q]; }
}

__device__ __forceinline__ void pool_task(int rb, int g, const bf16_t* P, const bf16_t* Wp, const float* pscale, bf16_t* A2, int lane) {
    const int r = lane & 31, hh = lane >> 5;
    const int m0 = rb * 32, b = m0 >> 12, t = (m0 & 4095) + r;
    const int half = 1 << g;
    const int lo = (t - half > 0) ? t - half : 0, hi = (t + half < SEQ) ? t + half : SEQ;
    const float invc = 1.0f / (float)(hi - lo);
    const bf16_t* Pb = P + (size_t)b * SEQ * 512 + g * 128 + 8 * hh;
    float sum[8][8];
#pragma unroll
    for (int s = 0; s < 8; ++s)
#pragma unroll
        for (int j = 0; j < 8; ++j) sum[s][j] = 0.f;
#pragma unroll 2
    for (int d2 = -half; d2 < half; d2 += 2)
#pragma unroll
    for (int dd = 0; dd < 2; ++dd) { const int d = d2 + dd;
        const int tt = t + d; const bool ok = (tt >= 0) && (tt < SEQ); const int tc = ok ? tt : t;
        const float msk = ok ? 1.0f : 0.0f;
#pragma unroll
        for (int s = 0; s < 8; ++s) { const u32x4 w = *(const u32x4*)(Pb + (size_t)tc * 512 + 16 * s);
            sum[s][0] += msk * bf_lo(w.x); sum[s][1] += msk * bf_hi(w.x); sum[s][2] += msk * bf_lo(w.y); sum[s][3] += msk * bf_hi(w.y);
            sum[s][4] += msk * bf_lo(w.z); sum[s][5] += msk * bf_hi(w.z); sum[s][6] += msk * bf_lo(w.w); sum[s][7] += msk * bf_hi(w.w); }
    }
    bf16x8 afrag[8];
#pragma unroll
    for (int s = 0; s < 8; ++s) { const u32x4 w = *(const u32x4*)(Pb + (size_t)t * 512 + 16 * s);
        u32x4 o; o.x = cvt_pk_bf16(sum[s][0] * invc - bf_lo(w.x), sum[s][1] * invc - bf_hi(w.x)); o.y = cvt_pk_bf16(sum[s][2] * invc - bf_lo(w.y), sum[s][3] * invc - bf_hi(w.y));
        o.z = cvt_pk_bf16(sum[s][4] * invc - bf_lo(w.z), sum[s][5] * invc - bf_hi(w.z)); o.w = cvt_pk_bf16(sum[s][6] * invc - bf_lo(w.w), sum[s][7] * invc - bf_hi(w.w));
        afrag[s] = __builtin_bit_cast(bf16x8, o); }
    bf16_t* orow = A2 + (size_t)(m0 + r) * 1024 + 512 + g * 128;
#pragma unroll
    for (int nb = 0; nb < 4; ++nb) {
        f32x16 acc = f32x16{};
#pragma unroll
        for (int s = 0; s < 8; ++s) { const bf16x8 bfr = *(const bf16x8*)(Wp + (size_t)(g * 128 + 32 * nb + r) * 128 + 16 * s + 8 * hh);
            acc = __builtin_amdgcn_mfma_f32_32x32x16_bf16(bfr, afrag[s], acc, 0, 0, 0); }
#pragma unroll
        for (int rg = 0; rg < 4; ++rg) { const int n = 32 * nb + 8 * rg + 4 * hh; const f32x4 ps = *(const f32x4*)(pscale + g * 128 + n);
            u32x2 w; w.x = cvt_pk_bf16(acc[4 * rg] * ps[0], acc[4 * rg + 1] * ps[1]); w.y = cvt_pk_bf16(acc[4 * rg + 2] * ps[2], acc[4 * rg + 3] * ps[3]);
            *(u32x2*)(orow + n) = w; }
    }
}

template <int N, int SZ> __device__ __forceinline__ void halve(float (&v)[SZ], int mask, bool upper) {
#pragma unroll
    for (int i = 0; i < N / 2; ++i) { const float send = upper ? v[i] : v[i + N / 2]; const float keep = upper ? v[i + N / 2] : v[i]; v[i] = keep + __shfl_xor(send, mask); }
}
__device__ __forceinline__ void reduce16(float (&v)[16], int lane, float (&out)[16]) {
    halve<16, 16>(v, 32, (lane & 32) != 0); halve<8, 16>(v, 16, (lane & 16) != 0); halve<4, 16>(v, 8, (lane & 8) != 0); halve<2, 16>(v, 4, (lane & 4) != 0);
    float x = v[0]; x += __shfl_xor(x, 2); x += __shfl_xor(x, 1);
#pragma unroll
    for (int i = 0; i < 16; ++i) out[i] = __builtin_bit_cast(float, __builtin_amdgcn_readlane(__builtin_bit_cast(int, x), 4 * i));
}
__device__ __forceinline__ void router_phase(const Args& a, int l, const Grp& g, LAS unsigned char* lds, int tid, int wave) {
    unsigned char* ws = a.ws;
    const bf16_t* H = (const bf16_t*)(ws + WS_H); bf16_t* T = (bf16_t*)(ws + WS_ABUF); const float* mod = (const float*)(ws + WS_MOD);
    LAS float* WG1 = (LAS float*)lds;
    LAS float* WE = (LAS float*)(lds + 16384);
    LAS int* REC_E = (LAS int*)(lds + 92160); LAS int* REC_P = REC_E + 256; LAS float* REC_W = (LAS float*)(REC_P + 256);
    LAS int* CNT = (LAS int*)(lds + 95232); LAS int* GBASE = CNT + 32;
    const float* rgw = a.in[I_RGW] + (size_t)l * 1024 * 4; const float* rew = a.in[I_REW] + (size_t)l * 1024 * 16;
    {   f32x4 wg[2], we[2][4];
#pragma unroll
        for (int i = 0; i < 2; ++i) { const int col = tid + 512 * i; wg[i] = *(const f32x4*)(rgw + col * 4);
#pragma unroll
            for (int g = 0; g < 4; ++g) we[i][g] = *(const f32x4*)(rew + col * 16 + 4 * g); }
#pragma unroll
        for (int i = 0; i < 2; ++i) { const int col = tid + 512 * i, jp = col >> 9, ln = (col & 511) >> 3, cc = col & 7; const int pos = ((jp * 8 + cc) * 64 + ln) * 4;
            *(LAS f32x4*)(WG1 + pos) = wg[i];
#pragma unroll
            for (int g = 0; g < 4; ++g) *(LAS f32x4*)(WE + g * 4096 + pos) = we[i][g]; } }
    if (tid < NCLS) CNT[tid] = 0;
    __syncthreads();
    unsigned* counts = (unsigned*)(ws + WS_CTL) + CW_CNT + 64 * (l * 2 + g.id);
    int* list = (int*)(ws + RT_LIST) + (size_t)g.id * NCLS * g.ntok; f32x2* wsl = (f32x2*)(ws + RT_WSLOT) + (size_t)g.id * NCLS * g.ntok; const int cap = g.ntok;
    const float* rgb = a.in[I_RGB] + l * 4; const float* reb = a.in[I_REB] + l * 16;
    for (int blk = g.tok0 / 128 + g.vh; blk < (g.tok0 + g.ntok) / 128; blk += g.Gh) {
        const int tok0 = blk * 128 + wave * 16, b = (blk * 128) >> 12;
        f32x4 gm[4], sh[4]; load_mod(mod, a.in[I_N2G], l, b, 3, opaque_tid() & 63, gm, sh);
        u32x4 nx[4][2];
        { const int lane = opaque_tid() & 63;
#pragma unroll
          for (int tk = 0; tk < 4; ++tk)
#pragma unroll
            for (int j = 0; j < 2; ++j) nx[tk][j] = *(const u32x4*)(H + (size_t)(tok0 + tk) * 1024 + 8 * lane + 512 * j); }
#pragma unroll 1
        for (int grp = 0; grp < 4; ++grp) {
            const int lane = opaque_tid() & 63;
            f32x4 hv[4][4];
#pragma unroll
            for (int tk = 0; tk < 4; ++tk)
#pragma unroll
                for (int j = 0; j < 2; ++j) { const u32x4 w = nx[tk][j]; hv[tk][2 * j] = (f32x4){bf_lo(w.x), bf_hi(w.x), bf_lo(w.y), bf_hi(w.y)}; hv[tk][2 * j + 1] = (f32x4){bf_lo(w.z), bf_hi(w.z), bf_lo(w.w), bf_hi(w.w)}; }
            if (grp < 3) {
#pragma unroll
                for (int tk = 0; tk < 4; ++tk)
#pragma unroll
                    for (int j = 0; j < 2; ++j) nx[tk][j] = *(const u32x4*)(H + (size_t)(tok0 + (grp + 1) * 4 + tk) * 1024 + 8 * lane + 512 * j); }
            {
#pragma unroll
                for (int tk = 0; tk < 4; ++tk) { const float rstd = __builtin_amdgcn_rsqf(wave_sum(sumsq16(hv[tk])) * (1.0f / 1024.0f) + EPS);
#pragma unroll
                    for (int i = 0; i < 4; ++i) hv[tk][i] = hv[tk][i] * rstd * gm[i] + sh[i];
                    store_row_bf16(T + (size_t)(tok0 + grp * 4 + tk) * 1024, lane, hv[tk]); } }
            float acc[16], tot[16];
#pragma unroll
            for (int i = 0; i < 16; ++i) acc[i] = 0.f;
#pragma unroll
            for (int jp = 0; jp < 2; ++jp)
#pragma unroll
                for (int cc = 0; cc < 8; ++cc) { const f32x4 w4 = *(const LAS f32x4*)(WG1 + ((jp * 8 + cc) * 64 + lane) * 4);
#pragma unroll
                    for (int tk = 0; tk < 4; ++tk) { const float tv = hv[tk][2 * jp + (cc >> 2)][cc & 3];
#pragma unroll
                        for (int q = 0; q < 4; ++q) acc[tk * 4 + q] += tv * w4[q]; } }
            reduce16(acc, lane, tot);
            int gi[4]; float gp[4];
#pragma unroll
            for (int tk = 0; tk < 4; ++tk) { float gl[4];
#pragma unroll
                for (int q = 0; q < 4; ++q) gl[q] = tot[tk * 4 + q] + rgb[q];
                int g = 0; float gmx = gl[0];
#pragma unroll
                for (int q = 1; q < 4; ++q) if (gl[q] > gmx) { gmx = gl[q]; g = q; }
                float gs = 0.f;
#pragma unroll
                for (int q = 0; q < 4; ++q) gs += __expf(gl[q] - gmx);
                gi[tk] = __builtin_amdgcn_readfirstlane(g); gp[tk] = 1.0f / gs; }
#pragma unroll
            for (int i = 0; i < 16; ++i) acc[i] = 0.f;
#pragma unroll
            for (int tk = 0; tk < 4; ++tk) { const LAS float* we = WE + gi[tk] * 4096 + lane * 4;
#pragma unroll
                for (int jp = 0; jp < 2; ++jp)
#pragma unroll
                    for (int cc = 0; cc < 8; ++cc) { const f32x4 w4 = *(const LAS f32x4*)(we + (jp * 8 + cc) * 256); const float tv = hv[tk][2 * jp + (cc >> 2)][cc & 3];
#pragma unroll
                        for (int q = 0; q < 4; ++q) acc[tk * 4 + q] += tv * w4[q]; } }
            reduce16(acc, lane, tot);
            if (lane == 0) {
#pragma unroll
                for (int tk = 0; tk < 4; ++tk) { float el[4];
#pragma unroll
                    for (int q = 0; q < 4; ++q) el[q] = tot[tk * 4 + q] + reb[gi[tk] * 4 + q];
                    int i1 = 0; float m1 = el[0];
#pragma unroll
                    for (int q = 1; q < 4; ++q) if (el[q] > m1) { m1 = el[q]; i1 = q; }
                    int i2 = -1; float m2 = -3.0e38f;
#pragma unroll
                    for (int q = 0; q < 4; ++q) if (q != i1 && el[q] > m2) { m2 = el[q]; i2 = q; }
                    const float ex = __expf(m2 - m1), den = 1.0f / (1.0f + ex);
                    const float w1 = gp[tk] * den, w2 = gp[tk] * ex * den;
                    const int lo = (i1 < i2) ? i1 : i2, hi = (i1 < i2) ? i2 : i1; const int cls = gi[tk] * 6 + ((lo == 0) ? 0 : (lo == 1) ? 3 : 5) + (hi - lo - 1);
                    const int tl = wave * 16 + grp * 4 + tk;
                    REC_E[tl] = cls; REC_W[tl * 2] = (i1 < i2) ? w1 : w2; REC_W[tl * 2 + 1] = (i1 < i2) ? w2 : w1;
                    REC_P[tl] = __hip_atomic_fetch_add(CNT + cls, 1, __ATOMIC_RELAXED, __HIP_MEMORY_SCOPE_WORKGROUP); } }
        }
        const int tid = opaque_tid();
        __syncthreads();
        if (tid < NCLS) { GBASE[tid] = (int)__hip_atomic_fetch_add(counts + tid, (unsigned)CNT[tid], __ATOMIC_RELAXED, __HIP_MEMORY_SCOPE_AGENT); }
        __syncthreads();
        if (tid < 128) { const int cls = REC_E[tid], pos = GBASE[cls] + REC_P[tid]; const int token = blk * 128 + tid;
            list[cls * cap + pos] = token; wsl[(size_t)cls * cap + pos] = (f32x2){REC_W[tid * 2], REC_W[tid * 2 + 1]}; }
        if (tid < NCLS) CNT[tid] = 0;
        __syncthreads();
    }
}
__device__ __forceinline__ void build_tp(const Args& a, int l, const Grp& g, LAS unsigned char* lds, int tid) {
    volatile LAS int* tp = (volatile LAS int*)(lds + TP_OFF);
    if (tid == 0) { const unsigned* counts = (const unsigned*)(a.ws + WS_CTL) + CW_CNT + 64 * (l * 2 + g.id); int acc = 0;
        volatile LAS int* hp = tp + 2 * NCLS + 1; volatile LAS int* lp = hp + NCLS + 1; int ah = 0, al = 0;
        for (int e = 0; e < NCLS; ++e) { const int c = (int)__hip_atomic_load(counts + e, __ATOMIC_RELAXED, __HIP_MEMORY_SCOPE_AGENT); const int nt_ = (c + 255) >> 8;
            const int light = (nt_ > 0 && c - 256 * (nt_ - 1) <= 128) ? 1 : 0;
            tp[e] = acc; tp[NCLS + 1 + e] = c; hp[e] = ah; lp[e] = al; acc += nt_; ah += nt_ - light; al += light; }
        tp[NCLS] = acc; hp[NCLS] = ah; lp[NCLS] = al; }
    __syncthreads();
}
__device__ __forceinline__ void ln1_phase(const Args& a, const Grp& g, int lane, int wave) {
    unsigned char* ws = a.ws; const float* mod = (const float*)(ws + WS_MOD); const bf16_t* H = (const bf16_t*)(ws + WS_H); bf16_t* AB = (bf16_t*)(ws + WS_ABUF);
    const int gwh = g.vh * NWAVES + wave, NGWh = g.Gh * NWAVES;
    const int rpw = (((g.ntok + NGWh - 1) / NGWh) + 1) & ~1, m0 = g.tok0 + gwh * rpw, mend = g.tok0 + g.ntok, m1 = (m0 + rpw < mend) ? m0 + rpw : mend;
    int curb = -1; f32x4 gm[4], sh[4];
    for (int m = m0; m < m1; m += 2) {
        f32x4 hv[2][4];
#pragma unroll
        for (int r = 0; r < 2; ++r) load_row_bf16(H + (size_t)(m + r) * 1024, lane, hv[r]);
        const int b = m >> 12;
        if (b != curb) { load_mod(mod, a.in[I_N1G], 1, b, 0, lane, gm, sh); curb = b; }
#pragma unroll
        for (int r = 0; r < 2; ++r) { const float rstd = __builtin_amdgcn_rsqf(wave_sum(sumsq16(hv[r])) * (1.0f / 1024.0f) + EPS);
#pragma unroll
            for (int i = 0; i < 4; ++i) hv[r][i] = hv[r][i] * rstd * gm[i] + sh[i];
            store_row_bf16(AB + (size_t)(m + r) * 1024, lane, hv[r]); }
    }
}
__device__ __forceinline__ void sgconv_phase(const Args& a, const Grp& g, const bf16_t* UV, LAS unsigned char* lds, int wave) {
    unsigned char* ws = a.ws; bf16_t* MIX = (bf16_t*)(ws + WS_ABUF); const bf16_t* WSG = (const bf16_t*)(ws + WS_WSG);
    for (int blk = g.tok0 / 128 + g.vh; blk < (g.tok0 + g.ntok) / 128; blk += g.Gh) {
        const int tok0 = blk * 128;
        {
            const int lane = opaque_tid() & 63;
            const int g = wave >> 1, ch = lane & 15; float gn[8];
            u32x4 wv[16];
#pragma unroll
            for (int it = 0; it < 16; ++it) wv[it] = *(const u32x4*)(UV + (size_t)(tok0 + 64 * (wave & 1) + 4 * it + (lane >> 4)) * 2560 + 512 + g * 128 + 8 * ch);
#pragma unroll
            for (int j = 0; j < 8; ++j) gn[j] = a.in[I_SGG][g * 128 + 8 * ch + j];
#pragma unroll
            for (int it = 0; it < 16; ++it) { const int q = 64 * (wave & 1) + 4 * it + (lane >> 4); const u32x4 w = wv[it];
                float v[8] = {bf_lo(w.x), bf_hi(w.x), bf_lo(w.y), bf_hi(w.y), bf_lo(w.z), bf_hi(w.z), bf_lo(w.w), bf_hi(w.w)};
                float ss = 0.f;
#pragma unroll
                for (int j = 0; j < 8; ++j) ss += v[j] * v[j];
                ss += __shfl_xor(ss, 1); ss += __shfl_xor(ss, 2); ss += __shfl_xor(ss, 4); ss += __shfl_xor(ss, 8);
                const float rstd = __builtin_amdgcn_rsqf(ss * (1.0f / 128.0f) + EPS);
                u32x4 o; o.x = cvt_pk_bf16(v[0] * rstd * gn[0], v[1] * rstd * gn[1]); o.y = cvt_pk_bf16(v[2] * rstd * gn[2], v[3] * rstd * gn[3]);
                o.z = cvt_pk_bf16(v[4] * rstd * gn[4], v[5] * rstd * gn[5]); o.w = cvt_pk_bf16(v[6] * rstd * gn[6], v[7] * rstd * gn[7]);
                *(LAS u32x4*)(lds + g * 32768 + (ch >> 2) * 8192 + q * 64 + (ch & 3) * 16) = o; }
        }
        {
            const int lane = opaque_tid() & 63;
            float cw[3][8];
#pragma unroll
            for (int k = 0; k < 3; ++k)
#pragma unroll
                for (int j = 0; j < 8; ++j) cw[k][j] = a.in[I_CONVW][k * 512 + 8 * lane + j];
#pragma unroll 1
            for (int hf = 0; hf < 4; ++hf) { const int t0 = tok0 + wave * 16 + hf * 4;
                u32x4 hx[6], cg[6], bg[4];
#pragma unroll
                for (int i = 0; i < 6; ++i) { const bool ok = !((i == 0 && ((t0 & 4095) == 0)) || (i == 5 && (((t0 + 3) & 4095) == 4095))); const int tok = ok ? t0 - 1 + i : t0;
                    hx[i] = *(const u32x4*)(UV + (size_t)tok * 2560 + 1024 + 8 * lane); cg[i] = *(const u32x4*)(UV + (size_t)tok * 2560 + 2048 + 8 * lane);
                    if (!ok) hx[i] = (u32x4){0u, 0u, 0u, 0u}; }
#pragma unroll
                for (int i = 0; i < 4; ++i) bg[i] = *(const u32x4*)(UV + (size_t)(t0 + i) * 2560 + 1536 + 8 * lane);
                float z[6][8];
#pragma unroll
                for (int i = 0; i < 6; ++i) { z[i][0] = bf_lo(hx[i].x) * bf_lo(cg[i].x); z[i][1] = bf_hi(hx[i].x) * bf_hi(cg[i].x); z[i][2] = bf_lo(hx[i].y) * bf_lo(cg[i].y); z[i][3] = bf_hi(hx[i].y) * bf_hi(cg[i].y);
                    z[i][4] = bf_lo(hx[i].z) * bf_lo(cg[i].z); z[i][5] = bf_hi(hx[i].z) * bf_hi(cg[i].z); z[i][6] = bf_lo(hx[i].w) * bf_lo(cg[i].w); z[i][7] = bf_hi(hx[i].w) * bf_hi(cg[i].w); }
#pragma unroll
                for (int i = 0; i < 4; ++i) { const u32x4 b4 = bg[i];
                    const float bgv[8] = {bf_lo(b4.x), bf_hi(b4.x), bf_lo(b4.y), bf_hi(b4.y), bf_lo(b4.z), bf_hi(b4.z), bf_lo(b4.w), bf_hi(b4.w)};
                    float y[8];
#pragma unroll
                    for (int j = 0; j < 8; ++j) y[j] = bgv[j] * (cw[0][j] * z[i][j] + cw[1][j] * z[i + 1][j] + cw[2][j] * z[i + 2][j]);
                    u32x4 o; o.x = cvt_pk_bf16(y[0], y[1]); o.y = cvt_pk_bf16(y[2], y[3]); o.z = cvt_pk_bf16(y[4], y[5]); o.w = cvt_pk_bf16(y[6], y[7]);
                    *(u32x4*)(MIX + (size_t)(t0 + i) * 1024 + 512 + 8 * lane) = o; } }
        }
        __syncthreads();
        {
            const int lane = opaque_tid() & 63, r32 = lane & 31, hi = lane >> 5;
            const int g = wave >> 1, ph = wave & 1;
            f32x16 acc[2][4];
#pragma unroll
            for (int pb = 0; pb < 2; ++pb)
#pragma unroll
                for (int cb = 0; cb < 4; ++cb) acc[pb][cb] = f32x16{};
            const LAS unsigned char* vbase = lds + g * 32768 + ((lane >> 4) & 1) * 32 + (lane & 3) * 8 + (4 * hi + ((lane & 15) >> 2)) * 64;
#pragma unroll 4
            for (int s = 0; s < 8; ++s) {
                bf16x8 wf[2];
#pragma unroll
                for (int pb = 0; pb < 2; ++pb) wf[pb] = *(const bf16x8*)(WSG + (size_t)(g * 128 + 64 * ph + 32 * pb + r32) * 128 + 16 * s + 8 * hi);
#pragma unroll
                for (int cb = 0; cb < 4; ++cb) {
                    const s16x4 lo = attn_body::vtr((attn_body::lds_cptr)(vbase + cb * 8192 + s * 1024)), hh = attn_body::vtr((attn_body::lds_cptr)(vbase + cb * 8192 + s * 1024 + 512));
                    const bf16x8 vf = (bf16x8){lo[0], lo[1], lo[2], lo[3], hh[0], hh[1], hh[2], hh[3]};
#pragma unroll
                    for (int pb = 0; pb < 2; ++pb) acc[pb][cb] = __builtin_amdgcn_mfma_f32_32x32x16_bf16(vf, wf[pb], acc[pb][cb], 0, 0, 0);
                }
            }
#pragma unroll
            for (int pb = 0; pb < 2; ++pb) { const int p = 64 * ph + 32 * pb + r32; const float bias = a.in[I_SGB][g * 128 + p];
                const bf16_t* urow = UV + (size_t)(tok0 + p) * 2560 + g * 128; bf16_t* orow = MIX + (size_t)(tok0 + p) * 1024 + g * 128;
                u32x2 uu[4][4];
#pragma unroll
                for (int cb = 0; cb < 4; ++cb)
#pragma unroll
                    for (int rg = 0; rg < 4; ++rg) uu[cb][rg] = *(const u32x2*)(urow + 32 * cb + 8 * rg + 4 * hi);
#pragma unroll
                for (int cb = 0; cb < 4; ++cb)
#pragma unroll
                    for (int rg = 0; rg < 4; ++rg) { const int c0 = 32 * cb + 8 * rg + 4 * hi; const u32x2 u2 = uu[cb][rg];
                        u32x2 w; w.x = cvt_pk_bf16(bf_lo(u2.x) * (acc[pb][cb][4 * rg] + bias), bf_hi(u2.x) * (acc[pb][cb][4 * rg + 1] + bias));
                        w.y = cvt_pk_bf16(bf_lo(u2.y) * (acc[pb][cb][4 * rg + 2] + bias), bf_hi(u2.y) * (acc[pb][cb][4 * rg + 3] + bias));
                        *(u32x2*)(orow + c0) = w; } }
        }
        __syncthreads();
    }
}

__global__ void __launch_bounds__(NWAVES * 64, 2) mk_fwd(Args a) {
    extern __shared__ __attribute__((aligned(16))) unsigned char lds_raw[];
    LAS unsigned char* lds = (LAS unsigned char*)lds_raw;
    const int tid0 = threadIdx.x, wave = __builtin_amdgcn_readfirstlane(tid0 >> 6);
#define tid opaque_tid()
#define lane (opaque_tid() & 63)
    const int G = gridDim.x; const int bx = blockIdx.x; const int vcu = (G % 8 == 0) ? (bx % 8) * (G / 8) + bx / 8 : bx;
    const int gw = vcu * NWAVES + wave, NGW = G * NWAVES;
    unsigned char* ws = a.ws;
    for (int u = tid0; u < (LDS_BYTES - LDSCTL_OFF) / 4; u += NWAVES * 64) ((LAS unsigned*)(lds + LDSCTL_OFF))[u] = 0u;
    __syncthreads();
    volatile LAS unsigned* MISC = (volatile LAS unsigned*)(lds + MISC_OFF);
    Grp g; g.NH = (G % 16 == 0) ? 2 : 1; g.Gh = G / g.NH; g.id = vcu % g.NH; g.vh = vcu / g.NH; g.ntok = MT / g.NH; g.tok0 = g.id * g.ntok; g.nb = NB / g.NH; g.b0 = g.id * g.nb;
    const int gwh = g.vh * NWAVES + wave, NGWh = g.Gh * NWAVES;
    XcdBarrier bar0 = xcd_barrier_post((unsigned*)(ws + WS_CTL) + CW_BAR, MISC + 8, (unsigned)G);
    XcdBarrier bar = xcd_barrier_post((unsigned*)(ws + WS_CTL) + CW_BAR + (1 + g.id) * XCD_BAR_WORDS, MISC + 10, (unsigned)g.Gh);
    unsigned long long t_ph = 0; if constexpr (MK_PROBE != 0u) t_ph = __builtin_amdgcn_s_memrealtime();
#define PROBE_IDLE(n) do { if constexpr (MK_PROBE != 0u) { if constexpr (((MK_PROBE) >> (n)) & 1u) { const unsigned long long t1_ = __builtin_amdgcn_s_memrealtime(), d_ = t1_ - t_ph; \
        while (__builtin_amdgcn_s_memrealtime() - t1_ < d_) __builtin_amdgcn_s_sleep(8); } t_ph = __builtin_amdgcn_s_memrealtime(); } } while (0)
#define GRID_BAR(n) do { xcd_barrier(bar); PROBE_IDLE(n); } while (0)
    const float* mod = (const float*)(ws + WS_MOD);
    bf16_t* H = (bf16_t*)(ws + WS_H);
    bf16_t* ABUF = (bf16_t*)(ws + WS_ABUF);
    gu32_t* wflag = (gu32_t*)(ws + WS_CTL) + CW_WFLAG; gu32_t* wflag2 = wflag + 64;
    const bool isLast = (g.id == g.NH - 1), isFirst = (g.id == 0);
    unsigned char* rg = ws + WS_RGN + (size_t)g.id * ((WS_ROUTE - WS_RGN) / 2);
    const size_t qb_ = (size_t)g.ntok * 1024, kvb_ = (size_t)g.nb * 2 * NKV * 128;
    bf16_t* Qp = (bf16_t*)rg - (size_t)g.tok0 * 512;
    bf16_t* Kp = (bf16_t*)(rg + qb_) - (size_t)g.b0 * 2 * NKV * 64;
    bf16_t* Vp = (bf16_t*)(rg + qb_ + kvb_) - (size_t)g.b0 * 2 * NKV * 64;
    bf16_t* Pp = (bf16_t*)(rg + qb_ + 2 * kvb_) - (size_t)g.tok0 * 512;
    bf16_t* A2p = (bf16_t*)(rg + 2 * qb_ + 2 * kvb_) - (size_t)g.tok0 * 1024;
    bf16_t* UVp = (bf16_t*)rg - (size_t)g.tok0 * 2560;
    bf16_t* ACTB = (bf16_t*)rg;

    PH(0) { p0_prologue(a, lds, tid, lane, wave, vcu, G); convert_weights(a, lds, 0, lane, wave, gw, NGW); }
    xcd_barrier(bar0); PROBE_IDLE(0);
#if MK_STAGE == 0
    copy_rows(a.in[I_X], a.out, lane, gw, NGW); return;
#endif
    if (isLast) { PH(0) { convert_weights(a, lds, 1, lane, wave, gwh, NGWh); } }
    PH(1) p1_ln_rows(a, g, lane, wave);
    GRID_BAR(1);
    if (isLast && g.vh == 0 && tid0 == 0) __hip_atomic_store(wflag, 1u, __ATOMIC_RELAXED, __HIP_MEMORY_SCOPE_AGENT);
    PH(2) {   pg8::SchedInProj0 S{g.Gh, g.vh, g.tok0 / 256, g.ntok / 256, g.b0, g.nb};
        pg8::EpiQKV E{Qp, Kp, Vp, Pp, a.in[I_QG], a.in[I_KG]};
        pg8::gemm_phase<pg8::EpiQKV, pg8::SchedInProj0, false>(lds, ABUF, (const bf16_t*)(ws + WS_WIN0), 1024, S, E); }
    if (isFirst) { PH(2) { const int nfull = ((g.ntok / 256) * 5 + g.nb) % g.Gh;
        if (nfull != 0 && g.vh >= nfull) convert_weights(a, lds, 3, lane, wave, (g.vh - nfull) * NWAVES + wave, (g.Gh - nfull) * NWAVES);
        else if (nfull == 0) convert_weights(a, lds, 3, lane, wave, gwh, NGWh); } }
    if (!isLast) { if (tid0 == 0) { unsigned sp_ = 0; while (__hip_atomic_load(wflag, __ATOMIC_RELAXED, __HIP_MEMORY_SCOPE_AGENT) == 0u && ++sp_ < (1u << 22)) __builtin_amdgcn_s_sleep(2); } }
    GRID_BAR(2);
    PH(3) {   float aref; { float mq = fabsf(a.in[I_QG][lane]), mk = fabsf(a.in[I_KG][lane]);
#pragma unroll
            for (int o_ = 1; o_ < 64; o_ <<= 1) { mq = fmaxf(mq, __shfl_xor(mq, o_)); mk = fmaxf(mk, __shfl_xor(mk, o_)); }
            aref = 64.0f * C2 * mq * mk; }
        const int nunits = g.nb * 8 * (SEQ / 256), nper = nunits / g.Gh;
        for (int uidx = g.vh * nper; uidx < (g.vh + 1) * nper; ++uidx) { const int b = g.b0 + (uidx >> 7), rem = uidx & 127, h = rem & 7, qb = rem >> 3;
            attn_body::attn_unit<8>(b, h, qb, Qp, Kp, Vp, A2p, (char*)lds_raw, aref); }
        for (int uidx = nper * g.Gh + g.vh; uidx < nunits; uidx += g.Gh) { const int b = g.b0 + (uidx >> 7), rem = uidx & 127, h = rem & 7, qb = rem >> 3;
            attn_body::attn_unit<8>(b, h, qb, Qp, Kp, Vp, A2p, (char*)lds_raw, aref); }
        for (int p = gwh; p < (g.ntok / 32) * 2; p += NGWh)
#pragma unroll 1
            for (int k = 0; k < 2; ++k) pool_task(g.tok0 / 32 + (p >> 1), (p & 1) ? 1 + k : 3 * k, Pp, (const bf16_t*)(ws + WS_WPOOL), a.in[I_POOLS], A2p, lane); }
    GRID_BAR(3);
    PH(4) {   pg8::SchedGrid S{4, (g.ntok / 256) * 4, g.Gh, g.vh, g.tok0 / 256};
        pg8::EpiResid<true> E{a.in[I_X], H, mod + 2 * 1024};
        pg8::gemm_phase<pg8::EpiResid<true>, pg8::SchedGrid, false>(lds, A2p, (const bf16_t*)(ws + WS_WOUT0), 1024, S, E); }
    GRID_BAR(4);
#if MK_STAGE == 1
    copy_rows(H, a.out, lane, gwh, NGWh, g.tok0, g.ntok); return;
#endif
#if MK_STAGE >= 2
    const int* glist = (const int*)(ws + RT_LIST) + (size_t)g.id * NCLS * g.ntok; const f32x2* gwsl = (const f32x2*)(ws + RT_WSLOT) + (size_t)g.id * NCLS * g.ntok;
    PH(5) router_phase(a, 0, g, lds, tid, wave);
    GRID_BAR(5);
    build_tp(a, 0, g, lds, tid);
    PH(6) {   pg8::SchedMoE S{(const volatile LAS int*)(lds + TP_OFF), glist, g.Gh, g.vh, false, gwsl, lds + SIDE_OFF, g.ntok, 0};
        pg8::EpiGateUp E{ACTB, lds + SIDE_OFF};
        pg8::gemm_phase<pg8::EpiGateUp, pg8::SchedMoE, true>(lds, ABUF, (const bf16_t*)(ws + WS_WGU), 1024, S, E); }
    if (isFirst) { PH(6) { const int nun = ((const volatile LAS int*)(lds + TP_OFF))[NCLS] * 4, nfull = nun % g.Gh;
        if (nfull != 0 && g.vh >= nfull) convert_weights(a, lds, 2, lane, wave, (g.vh - nfull) * NWAVES + wave, (g.Gh - nfull) * NWAVES);
        else if (nfull == 0) convert_weights(a, lds, 2, lane, wave, gwh, NGWh); } }
    GRID_BAR(6);
    if (isFirst && g.vh == 0 && tid0 == 0) __hip_atomic_store(wflag2, 1u, __ATOMIC_RELAXED, __HIP_MEMORY_SCOPE_AGENT);
    PH(7) {   pg8::SchedMoE S{(const volatile LAS int*)(lds + TP_OFF), glist, g.Gh, g.vh, true, gwsl, lds + SIDE_OFF, g.ntok, 0};
        pg8::EpiCombine<false> E{H, a.out, mod + 5 * 1024, lds + SIDE_OFF};
        pg8::gemm_phase<pg8::EpiCombine<false>, pg8::SchedMoE, false, true>(lds, ACTB, (const bf16_t*)(ws + WS_WDN), 512, S, E); }
    GRID_BAR(7);
#endif
#if MK_STAGE == 2
    copy_rows(H, a.out, lane, gwh, NGWh, g.tok0, g.ntok); return;
#endif
#if MK_STAGE >= 3
    PH(8) ln1_phase(a, g, lane, wave);
    if (!isFirst) { if (tid0 == 0) { unsigned sp_ = 0; while (__hip_atomic_load(wflag2, __ATOMIC_RELAXED, __HIP_MEMORY_SCOPE_AGENT) == 0u && ++sp_ < (1u << 22)) __builtin_amdgcn_s_sleep(2); } }
    GRID_BAR(8);
    PH(9) {   pg8::SchedGrid S{10, (g.ntok / 256) * 10, g.Gh, g.vh, g.tok0 / 256};
        pg8::EpiBf16 E{UVp, 2560, false};
        pg8::gemm_phase<pg8::EpiBf16, pg8::SchedGrid, false>(lds, ABUF, (const bf16_t*)(ws + WS_WIN1), 1024, S, E); }
    GRID_BAR(9);
    PH(10) sgconv_phase(a, g, UVp, lds, wave);
    GRID_BAR(10);
    PH(11) {   pg8::SchedGrid S{4, (g.ntok / 256) * 4, g.Gh, g.vh, g.tok0 / 256};
        pg8::EpiResid<false> E{H, H, mod + (size_t)9 * 6144 + 2 * 1024};
        pg8::gemm_phase<pg8::EpiResid<false>, pg8::SchedGrid, false>(lds, ABUF, (const bf16_t*)(ws + WS_WOUT1), 1024, S, E); }
    GRID_BAR(11);
#endif
#if MK_STAGE == 3
    copy_rows(H, a.out, lane, gwh, NGWh, g.tok0, g.ntok); return;
#endif
#if MK_STAGE >= 4
    router_phase(a, 1, g, lds, tid, wave);
    GRID_BAR(12);
    build_tp(a, 1, g, lds, tid);
    {   pg8::SchedMoE S{(const volatile LAS int*)(lds + TP_OFF), glist, g.Gh, g.vh, false, gwsl, lds + SIDE_OFF, g.ntok, 0};
        pg8::EpiGateUp E{ACTB, lds + SIDE_OFF};
        pg8::gemm_phase<pg8::EpiGateUp, pg8::SchedMoE, true>(lds, ABUF, (const bf16_t*)(ws + WS_WGU) + (size_t)8192 * 1024, 1024, S, E); }
    GRID_BAR(13);
    {   pg8::SchedMoE S{(const volatile LAS int*)(lds + TP_OFF), glist, g.Gh, g.vh, true, gwsl, lds + SIDE_OFF, g.ntok, 0};
        pg8::EpiCombine<true> E{H, a.out, mod + (size_t)9 * 6144 + 5 * 1024, lds + SIDE_OFF};
        pg8::gemm_phase<pg8::EpiCombine<true>, pg8::SchedMoE, false, true>(lds, ACTB, (const bf16_t*)(ws + WS_WDN) + (size_t)16384 * 256, 512, S, E); }
    PROBE_IDLE(15);
#endif
#undef tid
#undef lane
}

extern "C" void kernel_launch(void* const* d_in, const int* in_sizes, int n_in, void* d_out, int out_size, void* d_ws, size_t ws_size, hipStream_t stream) {
    static int grid = 0;
    if (grid == 0) {
        if (n_in != 27 || out_size != MT * DM || ws_size < WS_END) { fprintf(stderr, "kernel_launch: unexpected problem (n_in %d, out %d, ws %zu)\n", n_in, out_size, ws_size); grid = -1; return; }
        int dev = 0, cus = 0, per_cu = 0;
        if (hipGetDevice(&dev) != hipSuccess || hipDeviceGetAttribute(&cus, hipDeviceAttributeMultiprocessorCount, dev) != hipSuccess) { grid = -1; return; }
        if (hipFuncSetAttribute((const void*)mk_fwd, hipFuncAttributeMaxDynamicSharedMemorySize, LDS_BYTES) != hipSuccess) { fprintf(stderr, "kernel_launch: hipFuncSetAttribute failed\n"); grid = -1; return; }
        if (hipOccupancyMaxActiveBlocksPerMultiprocessor(&per_cu, (const void*)mk_fwd, NWAVES * 64, LDS_BYTES) != hipSuccess || per_cu < 1) { fprintf(stderr, "kernel_launch: occupancy query says %d blocks per CU\n", per_cu); }
        (void)hipGetLastError();
        grid = cus;
    }
    if (grid < 0) return;
    if (hipMemsetAsync((char*)d_ws + WS_CTL, 0, CTL_ZERO_BYTES, stream) != hipSuccess) return;
    Args a{};
    for (int i = 0; i < 27; ++i) a.in[i] = (const float*)d_in[i];
    a.out = (float*)d_out; a.ws = (unsigned char*)d_ws;
    hipLaunchKernelGGL(mk_fwd, dim3(grid), dim3(NWAVES * 64), LDS_BYTES, stream, a);
}
```
